# Optimizing an MI355X kernel written in HIP

```python
import math
import jax, jax.numpy as jnp
from jax import lax
import numpy as np

D_MODEL = 1024
BATCH = 8
SEQ = 4096
DEPTH = 4

PLE_DIM = 256
N_BRANCH = 4
BRANCH_W = D_MODEL // N_BRANCH
CONV_W = 31
MLA_HEADS = 4
MLA_NOPE = 64
MLA_ROPE = 32
MLA_V = 64
MLA_Q_RANK = D_MODEL // 4
MLA_KV_RANK = D_MODEL // 8
ROPE_THETA = 10000.0
ATTN_BLOCK = 128
SSM_GROUP = 16
SSM_GROUPS = BRANCH_W // SSM_GROUP
SSM_STATE = 64
DT_MIN = 1e-3
DT_MAX = 1e-1
SWA_HEADS = 4
SWA_KV_HEADS = 2
SWA_HEAD_DIM = 64
WINDOW = 128
DEEPNORM_ALPHA = (2.0 * DEPTH) ** 0.25
DEEPNORM_BETA = (8.0 * DEPTH) ** -0.25
LN_EPS = 1e-5
RMS_EPS = 1e-6

IN_SPLITS = (
    BRANCH_W, BRANCH_W, BRANCH_W,
    MLA_Q_RANK, MLA_KV_RANK, MLA_ROPE, BRANCH_W,
    BRANCH_W, BRANCH_W,
    SWA_HEADS * SWA_HEAD_DIM, SWA_KV_HEADS * SWA_HEAD_DIM,
    SWA_KV_HEADS * SWA_HEAD_DIM, BRANCH_W,
)
IN_WIDTH = sum(IN_SPLITS)
IN_OFFSETS = tuple(sum(IN_SPLITS[:i + 1]) for i in range(len(IN_SPLITS) - 1))

kernel_name = 'hybrid_gated_parallel_mixers'


def layer_norm(x, g, b):
    xf = x.astype(jnp.float32)
    mu = jnp.mean(xf, axis=-1, keepdims=True)
    var = jnp.mean(jnp.square(xf - mu), axis=-1, keepdims=True)
    return ((xf - mu) * lax.rsqrt(var + LN_EPS) * g.astype(jnp.float32) + b.astype(jnp.float32)).astype(x.dtype)


def rms_norm(x, g):
    xf = x.astype(jnp.float32)
    ms = jnp.mean(jnp.square(xf), axis=-1, keepdims=True)
    return (xf * lax.rsqrt(ms + RMS_EPS) * g.astype(jnp.float32)).astype(x.dtype)


def rope_tables(seq):
    pos = jnp.arange(seq, dtype=jnp.float32)
    inv_freq = ROPE_THETA ** (-jnp.arange(0, MLA_ROPE, 2, dtype=jnp.float32) / MLA_ROPE)
    ang = pos[:, None] * inv_freq[None, :]
    return jnp.cos(ang), jnp.sin(ang)


def rope(x, cos, sin):
    half = x.shape[-1] // 2
    xf = x.astype(jnp.float32)
    x1, x2 = xf[..., :half], xf[..., half:]
    return jnp.concatenate([x1 * cos - x2 * sin, x2 * cos + x1 * sin], axis=-1).astype(x.dtype)


def conv_module(a_val, a_gate, conv_w, conv_b, norm_g, norm_b, w_pw2):
    h = a_val * jax.nn.sigmoid(a_gate)
    h = jnp.pad(h, ((0, 0), (CONV_W - 1, 0), (0, 0)))
    h = lax.conv_general_dilated(h, conv_w[:, None, :].astype(h.dtype), window_strides=(1,),
                                 padding='VALID', dimension_numbers=('NWC', 'WIO', 'NWC'),
                                 feature_group_count=BRANCH_W) + conv_b
    h = jax.nn.silu(layer_norm(h, norm_g, norm_b))
    return h @ w_pw2


def mla(c_q, c_kv, k_r, q_norm_g, kv_norm_g, w_uq, w_ukv, cos, sin):
    B, S, _ = c_q.shape
    q = (rms_norm(c_q, q_norm_g) @ w_uq).reshape(B, S, MLA_HEADS, MLA_NOPE + MLA_ROPE)
    q_nope = q[..., :MLA_NOPE]
    q_rope = rope(q[..., MLA_NOPE:], cos[:, None, :], sin[:, None, :])
    kv = (rms_norm(c_kv, kv_norm_g) @ w_ukv).reshape(B, S, MLA_HEADS, MLA_NOPE + MLA_V)
    k_nope, v = kv[..., :MLA_NOPE], kv[..., MLA_NOPE:]
    k_rope = rope(k_r, cos, sin)
    scale = (MLA_NOPE + MLA_ROPE) ** -0.5
    nblk = S // ATTN_BLOCK
    qn = q_nope.reshape(B, nblk, ATTN_BLOCK, MLA_HEADS, MLA_NOPE).transpose(1, 0, 2, 3, 4)
    qr = q_rope.reshape(B, nblk, ATTN_BLOCK, MLA_HEADS, MLA_ROPE).transpose(1, 0, 2, 3, 4)
    k_pos = jnp.arange(S)

    def block(args):
        qn_b, qr_b, i = args
        s = (jnp.einsum('bqhd,bkhd->bhqk', qn_b, k_nope)
             + jnp.einsum('bqhr,bkr->bhqk', qr_b, k_rope)).astype(jnp.float32) * scale
        q_pos = i * ATTN_BLOCK + jnp.arange(ATTN_BLOCK)
        s = jnp.where(k_pos[None, :] <= q_pos[:, None], s, -jnp.inf)
        prob = jax.nn.softmax(s, axis=-1).astype(v.dtype)
        return jnp.einsum('bhqk,bkhd->bqhd', prob, v)

    o = lax.map(block, (qn, qr, jnp.arange(nblk)))
    return o.transpose(1, 0, 2, 3, 4).reshape(B, S, MLA_HEADS * MLA_V)


def s5_layer(u, a_re, a_im, log_dt, b_re, b_im, c_re, c_im, d, w_glu):
    B, S, W = u.shape
    f32 = jnp.float32
    uf = u.astype(f32)
    ug = uf.reshape(B, S, SSM_GROUPS, SSM_GROUP)
    dt = jnp.exp(log_dt.astype(f32))[:, None]
    lr, li = a_re.astype(f32), a_im.astype(f32)
    mag = jnp.exp(lr * dt)
    lb_re, lb_im = mag * jnp.cos(li * dt), mag * jnp.sin(li * dt)
    den = lr * lr + li * li
    nr, ni = lb_re - 1.0, lb_im
    f_re = ((nr * lr + ni * li) / den)[..., None]
    f_im = ((ni * lr - nr * li) / den)[..., None]
    br, bi = b_re.astype(f32), b_im.astype(f32)
    bb_re = f_re * br - f_im * bi
    bb_im = f_re * bi + f_im * br
    bu_re = jnp.einsum('bsgh,gph->bsgp', ug, bb_re)
    bu_im = jnp.einsum('bsgh,gph->bsgp', ug, bb_im)
    a_r = jnp.broadcast_to(lb_re[None, None], (1, S, SSM_GROUPS, SSM_STATE))
    a_i = jnp.broadcast_to(lb_im[None, None], (1, S, SSM_GROUPS, SSM_STATE))

    def combine(e1, e2):
        a1r, a1i, x1r, x1i = e1
        a2r, a2i, x2r, x2i = e2
        return (a2r * a1r - a2i * a1i, a2r * a1i + a2i * a1r,
                a2r * x1r - a2i * x1i + x2r, a2r * x1i + a2i * x1r + x2i)

    _, _, h_re, h_im = lax.associative_scan(combine, (a_r, a_i, bu_re, bu_im), axis=1)
    y = (jnp.einsum('bsgp,ghp->bsgh', h_re, c_re.astype(f32))
         - jnp.einsum('bsgp,ghp->bsgh', h_im, c_im.astype(f32))).reshape(B, S, W)
    y = jax.nn.gelu(y + d.astype(f32) * uf).astype(u.dtype)
    g = y @ w_glu
    return g[..., :W] * jax.nn.sigmoid(g[..., W:])


def swa(q, k, v, sinks):
    B, S, _ = q.shape
    nb = S // WINDOW
    G = SWA_HEADS // SWA_KV_HEADS
    q = q.reshape(B, nb, WINDOW, SWA_KV_HEADS, G, SWA_HEAD_DIM)
    k = k.reshape(B, nb, WINDOW, SWA_KV_HEADS, SWA_HEAD_DIM)
    v = v.reshape(B, nb, WINDOW, SWA_KV_HEADS, SWA_HEAD_DIM)
    prev = lambda t: jnp.concatenate([jnp.zeros_like(t[:, :1]), t[:, :-1]], axis=1)
    k2 = jnp.concatenate([prev(k), k], axis=2)
    v2 = jnp.concatenate([prev(v), v], axis=2)
    s = jnp.einsum('bnqhgd,bnkhd->bnhgqk', q, k2).astype(jnp.float32) * (SWA_HEAD_DIM ** -0.5)
    qi = jnp.arange(WINDOW)[:, None] + WINDOW
    kj = jnp.arange(2 * WINDOW)[None, :]
    rel = qi - kj
    band = (rel >= 0) & (rel < WINDOW)
    blk = jnp.arange(nb)[:, None, None]
    valid = band[None] & ((blk > 0) | (kj >= WINDOW)[None])
    s = jnp.where(valid[None, :, None, None], s, -jnp.inf)
    sink = sinks.astype(jnp.float32).reshape(SWA_KV_HEADS, G)
    sink_col = jnp.broadcast_to(sink[None, None, :, :, None, None], s.shape[:-1] + (1,))
    prob = jax.nn.softmax(jnp.concatenate([s, sink_col], axis=-1), axis=-1)[..., :-1]
    o = jnp.einsum('bnhgqk,bnkhd->bnqhgd', prob.astype(v.dtype), v2)
    return o.reshape(B, S, SWA_HEADS * SWA_HEAD_DIM)


def hybrid_layer(x, p_i, cos, sin, w_in, w_merge, b_merge, conv_w, conv_b, conv_norm_g, conv_norm_b,
                 w_pw2, mla_q_norm_g, mla_kv_norm_g, w_uq, w_ukv, ssm_a_re, ssm_a_im, ssm_log_dt,
                 ssm_b_re, ssm_b_im, ssm_c_re, ssm_c_im, ssm_d, w_glu, attn_sinks, w_branch, w_out,
                 ln_g, ln_b, w_ple, w_ple_gate, ple_norm_g):
    B, S, D = x.shape
    h = x @ w_in
    (a_val, a_gate, a_z, c_q, c_kv, k_r, b_z, u, c_z, q, k, v, d_z) = jnp.split(h, IN_OFFSETS, axis=-1)
    y_a = conv_module(a_val, a_gate, conv_w, conv_b, conv_norm_g, conv_norm_b, w_pw2) * jax.nn.silu(a_z)
    y_b = mla(c_q, c_kv, k_r, mla_q_norm_g, mla_kv_norm_g, w_uq, w_ukv, cos, sin) * jax.nn.silu(b_z)
    y_c = s5_layer(u, ssm_a_re, ssm_a_im, ssm_log_dt, ssm_b_re, ssm_b_im, ssm_c_re, ssm_c_im,
                   ssm_d, w_glu) * jax.nn.silu(c_z)
    y_d = swa(q, k, v, attn_sinks) * jax.nn.silu(d_z)
    ys = jnp.stack([y_a, y_b, y_c, y_d], axis=2)
    branch = jnp.einsum('bsnw,nwd->bsnd', ys, w_branch)
    gates = jax.nn.sigmoid(x @ w_merge + b_merge).reshape(B, S, N_BRANCH, D)
    merged = jnp.einsum('bsnd,bsnd->bsd', gates, branch)
    x = layer_norm(DEEPNORM_ALPHA * x + merged @ w_out, ln_g, ln_b)
    e = (p_i @ w_ple) * jax.nn.sigmoid(x @ w_ple_gate)
    return x + rms_norm(e, ple_norm_g)


def setup_inputs(seed: int = 0) -> dict:
    key = jax.random.key(seed)
    ks = jax.random.split(key, 31)
    L, D, W = DEPTH, D_MODEL, BRANCH_W
    G, P, H = SSM_GROUPS, SSM_STATE, SSM_GROUP
    nrm = lambda k, shape, scale: jax.random.normal(k, shape, jnp.float32) * scale
    n_idx = jnp.arange(P, dtype=jnp.float32)
    return {
        'x': nrm(ks[0], (BATCH, SEQ, D), 1.0),
        'p': nrm(ks[1], (DEPTH, BATCH, SEQ, PLE_DIM), 1.0),
        'w_in': nrm(ks[2], (L, D, IN_WIDTH), D ** -0.5),
        'w_merge': nrm(ks[3], (L, D, N_BRANCH * D), D ** -0.5),
        'b_merge': nrm(ks[4], (L, N_BRANCH * D), 0.01),
        'conv_w': nrm(ks[5], (L, CONV_W, W), CONV_W ** -0.5),
        'conv_b': nrm(ks[6], (L, W), 0.01),
        'conv_norm_g': 1.0 + nrm(ks[7], (L, W), 0.01),
        'conv_norm_b': nrm(ks[8], (L, W), 0.01),
        'w_pw2': nrm(ks[9], (L, W, W), W ** -0.5),
        'mla_q_norm_g': 1.0 + nrm(ks[10], (L, MLA_Q_RANK), 0.01),
        'mla_kv_norm_g': 1.0 + nrm(ks[11], (L, MLA_KV_RANK), 0.01),
        'w_uq': nrm(ks[12], (L, MLA_Q_RANK, MLA_HEADS * (MLA_NOPE + MLA_ROPE)), MLA_Q_RANK ** -0.5),
        'w_ukv': nrm(ks[13], (L, MLA_KV_RANK, MLA_HEADS * (MLA_NOPE + MLA_V)), MLA_KV_RANK ** -0.5),
        'ssm_a_re': -0.5 + nrm(ks[14], (L, G, P), 0.01),
        'ssm_a_im': math.pi * n_idx + nrm(ks[15], (L, G, P), 0.01),
        'ssm_log_dt': jax.random.uniform(ks[16], (L, G), jnp.float32, math.log(DT_MIN), math.log(DT_MAX)),
        'ssm_b_re': nrm(ks[17], (L, G, P, H), (2 * H) ** -0.5),
        'ssm_b_im': nrm(ks[18], (L, G, P, H), (2 * H) ** -0.5),
        'ssm_c_re': nrm(ks[19], (L, G, H, P), P ** -0.5),
        'ssm_c_im': nrm(ks[20], (L, G, H, P), P ** -0.5),
        'ssm_d': nrm(ks[21], (L, W), 1.0),
        'w_glu': nrm(ks[22], (L, W, 2 * W), W ** -0.5),
        'attn_sinks': nrm(ks[23], (L, SWA_HEADS), 0.5),
        'w_branch': nrm(ks[24], (L, N_BRANCH, W, D), DEEPNORM_BETA * W ** -0.5),
        'w_out': nrm(ks[25], (L, D, D), DEEPNORM_BETA * D ** -0.5),
        'ln_g': 1.0 + nrm(ks[26], (L, D), 0.01),
        'ln_b': nrm(ks[27], (L, D), 0.01),
        'w_ple': nrm(ks[28], (L, PLE_DIM, D), PLE_DIM ** -0.5),
        'w_ple_gate': nrm(ks[29], (L, D, D), D ** -0.5),
        'ple_norm_g': 1.0 + nrm(ks[30], (L, D), 0.01),
    }


def reference(x, p, w_in, w_merge, b_merge, conv_w, conv_b, conv_norm_g, conv_norm_b, w_pw2,
              mla_q_norm_g, mla_kv_norm_g, w_uq, w_ukv, ssm_a_re, ssm_a_im, ssm_log_dt,
              ssm_b_re, ssm_b_im, ssm_c_re, ssm_c_im, ssm_d, w_glu, attn_sinks, w_branch, w_out,
              ln_g, ln_b, w_ple, w_ple_gate, ple_norm_g):
    cos, sin = rope_tables(x.shape[1])
    for i in range(DEPTH):
        x = hybrid_layer(x, p[i], cos, sin, w_in[i], w_merge[i], b_merge[i], conv_w[i], conv_b[i],
                         conv_norm_g[i], conv_norm_b[i], w_pw2[i], mla_q_norm_g[i], mla_kv_norm_g[i],
                         w_uq[i], w_ukv[i], ssm_a_re[i], ssm_a_im[i], ssm_log_dt[i], ssm_b_re[i],
                         ssm_b_im[i], ssm_c_re[i], ssm_c_im[i], ssm_d[i], w_glu[i], attn_sinks[i],
                         w_branch[i], w_out[i], ln_g[i], ln_b[i], w_ple[i], w_ple_gate[i], ple_norm_g[i])
    return x
```

```cpp
#include <hip/hip_runtime.h>
#include <hip/hip_cooperative_groups.h>
#include <cstdio>
#include <type_traits>
namespace cg = cooperative_groups;

#ifndef MULTI_LAUNCH
#define MULTI_LAUNCH 0
#endif

typedef unsigned short u16;
typedef __attribute__((ext_vector_type(8))) short bf16x8;
typedef __attribute__((ext_vector_type(4))) float f32x4;
typedef __attribute__((ext_vector_type(16))) float f32x16;
typedef __attribute__((ext_vector_type(4))) unsigned u32x4;
typedef __attribute__((ext_vector_type(2))) unsigned u32x2;
#define DI __device__ __forceinline__
DI int tidx() { int t = threadIdx.x & 255; asm volatile("" : "+v"(t)); return t; }
DI int half_() { return __builtin_amdgcn_readfirstlane((int)(threadIdx.x >> 8)); }
DI int vbid() { return (int)blockIdx.x * 2 + half_(); }
DI int vgrid() { return (int)gridDim.x * 2; }

constexpr int T_ = 32768, S_ = 4096, D_ = 1024, HW = 2720, NL = 4;
constexpr int OFF_AVAL = 0, OFF_AGATE = 256, OFF_AZ = 512, OFF_CQ = 768, OFF_CKV = 1024, OFF_KR = 1152, OFF_BZ = 1184,
              OFF_U = 1440, OFF_CZ = 1696, OFF_SQ = 1952, OFF_SK = 2208, OFF_SV = 2336, OFF_DZ = 2464;
constexpr size_t O_WIN = 0, O_WM = O_WIN + 2816 * 1024, O_PW2 = O_WM + 4096 * 1024, O_UQ = O_PW2 + 65536, O_UKV = O_UQ + 98304,
                 O_GLU = O_UKV + 65536, O_BR = O_GLU + 131072, O_OUT = O_BR + 1048576, O_PLE = O_OUT + 1048576,
                 O_PLEG = O_PLE + 262144, WL = O_PLEG + 1048576;
constexpr int LDT = 64;
constexpr int TILE_E = 128 * LDT;
constexpr int CST = 132;
constexpr int LDS_MAIN = 73728;
constexpr int LDS_HALF = LDS_MAIN + 1024;
constexpr int LDS_BYTES = 2 * LDS_HALF;
constexpr float LOG2E = 1.4426950408889634f;
constexpr int NPH_LAYER = 9;

struct Params {
  const float *x, *p, *w_in, *w_merge, *b_merge, *conv_w, *conv_b, *conv_ng, *conv_nb, *w_pw2, *qng, *kvng, *w_uq, *w_ukv,
      *a_re, *a_im, *log_dt, *b_re, *b_im, *c_re, *c_im, *ssm_d, *w_glu, *sinks, *w_branch, *w_out, *ln_g, *ln_b, *w_ple,
      *w_pleg, *ple_ng;
  float* out;
  u16* wts;
  float *lam, *bbre, *bbim, *rcos, *rsin;
  u16 *X, *pb, *hb, *ys, *cA, *Qm, *Km, *Vmt, *Vst, *yss, *mg;
  float *hend, *fbuf;
  unsigned* bar;
};

typedef const __attribute__((address_space(4))) Params& PREF;

DI unsigned pack2(float a, float b) { unsigned r; asm("v_cvt_pk_bf16_f32 %0, %1, %2\n\ts_nop 1" : "=v"(r) : "v"(a), "v"(b)); return r; }
DI u16 f2bf(float x) { return (u16)(pack2(x, x) & 0xffffu); }
DI float bf2f(u16 v) { return __uint_as_float(((unsigned)v) << 16); }
DI float lo2f(unsigned u) { return __uint_as_float(u << 16); }
DI float hi2f(unsigned u) { return __uint_as_float(u & 0xffff0000u); }
DI float sigm(float x) { return 1.f / (1.f + __expf(-x)); }
DI float silu(float x) { return x / (1.f + __expf(-x)); }
DI float gelu_t(float x) { float u = 0.7978845608028654f * (x + 0.044715f * x * x * x); return 0.5f * x * (1.f + tanhf(u)); }
DI void unpack8(u32x4 v, float* f) {
  f[0] = lo2f(v.x); f[1] = hi2f(v.x); f[2] = lo2f(v.y); f[3] = hi2f(v.y);
  f[4] = lo2f(v.z); f[5] = hi2f(v.z); f[6] = lo2f(v.w); f[7] = hi2f(v.w);
}
DI u32x4 pack8(const float* f) { u32x4 o; o.x = pack2(f[0], f[1]); o.y = pack2(f[2], f[3]); o.z = pack2(f[4], f[5]); o.w = pack2(f[6], f[7]); return o; }
DI float wsum(float v) {
#pragma unroll
  for (int o = 32; o >= 1; o >>= 1) v += __shfl_xor(v, o);
  return v;
}
#define MFMA32(a, b, c) __builtin_amdgcn_mfma_f32_32x32x16_bf16((a), (b), (c), 0, 0, 0)
#define MFMA16(a, b, c) __builtin_amdgcn_mfma_f32_16x16x32_bf16((a), (b), (c), 0, 0, 0)

DI void zero_acc(f32x4 (&a)[4][4]) {
#pragma unroll
  for (int i = 0; i < 4; ++i)
#pragma unroll
    for (int j = 0; j < 4; ++j)
#pragma unroll
      for (int k = 0; k < 4; ++k) a[i][j][k] = 0.f;
}

#define GM_LOAD(RA, RB, KT)                                                                 \
  _Pragma("unroll") for (int i = 0; i < 4; ++i) {                                           \
    RA[i] = *(const u32x4*)(ag + (size_t)(32 * i) * lda + (KT) * 64);                       \
    RB[i] = *(const u32x4*)(bg + (size_t)(32 * i) * ldb + (KT) * 64);                       \
  }
#define GM_STORE(RA, RB, STG)                                                               \
  {                                                                                         \
    u16* dA_ = lds + (STG) * 2 * TILE_E;                                                    \
    _Pragma("unroll") for (int i = 0; i < 4; ++i) {                                         \
      *(u32x4*)(dA_ + (lrow + 32 * i) * LDT + lsw) = RA[i];                                 \
      *(u32x4*)(dA_ + TILE_E + (lrow + 32 * i) * LDT + lsw) = RB[i];                        \
    }                                                                                       \
  }
#define GM_COMPUTE(STG)                                                                     \
  {                                                                                         \
    const u16* sA = lds + (STG) * 2 * TILE_E + (wm * 64 + fr) * LDT;                        \
    const u16* sB = lds + (STG) * 2 * TILE_E + TILE_E + (wn * 64 + fr) * LDT;               \
    __builtin_amdgcn_s_setprio(1);                                                          \
    _Pragma("unroll") for (int kk = 0; kk < 2; ++kk) {                                      \
      const int co = (((kk * 4 + fq) ^ (fr & 7)) * 8);                                      \
      bf16x8 af[4];                                                                         \
      _Pragma("unroll") for (int m = 0; m < 4; ++m) af[m] = *(const bf16x8*)(sA + m * 16 * LDT + co);   \
      _Pragma("unroll") for (int n = 0; n < 4; ++n) {                                       \
        const bf16x8 bfr = *(const bf16x8*)(sB + n * 16 * LDT + co);                        \
        _Pragma("unroll") for (int m = 0; m < 4; ++m) acc[m][n] = MFMA16(af[m], bfr, acc[m][n]);        \
      }                                                                                     \
    }                                                                                       \
    __builtin_amdgcn_s_setprio(0);                                                          \
  }
template <bool DEEP = true>
DI void gemm_main(f32x4 (&acc)[4][4], const u16* __restrict__ A, int lda, const u16* __restrict__ B, int ldb, int K, u16* lds) {
  const int tid = tidx(), lane = tid & 63, w = tid >> 6;
  const int wm = w >> 1, wn = w & 1, fr = lane & 15, fq = lane >> 4;
  const int lrow = tid >> 3, lch = (tid & 7) * 8, lsw = ((tid & 7) ^ (lrow & 7)) * 8;
  const u16* ag = A + (size_t)lrow * lda + lch;
  const u16* bg = B + (size_t)lrow * ldb + lch;
  const int nk = K >> 6;
  if (DEEP) {
    u32x4 ra0[4], rb0[4], ra1[4], rb1[4];
    GM_LOAD(ra0, rb0, 0)
    GM_LOAD(ra1, rb1, 1)
    __syncthreads();
    GM_STORE(ra0, rb0, 0)
    __syncthreads();
    for (int kt = 0; kt < nk; kt += 2) {
      if (kt + 2 < nk) { GM_LOAD(ra0, rb0, kt + 2) }
      GM_COMPUTE(0)
      __builtin_amdgcn_sched_barrier(0);
      GM_STORE(ra1, rb1, 1)
      __syncthreads();
      if (kt + 3 < nk) { GM_LOAD(ra1, rb1, kt + 3) }
      GM_COMPUTE(1)
      __builtin_amdgcn_sched_barrier(0);
      if (kt + 2 < nk) { GM_STORE(ra0, rb0, 0) }
      __syncthreads();
    }
  } else {
    u32x4 ra0[4], rb0[4];
    GM_LOAD(ra0, rb0, 0)
    __syncthreads();
    GM_STORE(ra0, rb0, 0)
    __syncthreads();
    for (int kt = 0; kt < nk; kt += 2) {
      GM_LOAD(ra0, rb0, kt + 1)
      GM_COMPUTE(0)
      __builtin_amdgcn_sched_barrier(0);
      GM_STORE(ra0, rb0, 1)
      __syncthreads();
      if (kt + 2 < nk) { GM_LOAD(ra0, rb0, kt + 2) }
      GM_COMPUTE(1)
      __builtin_amdgcn_sched_barrier(0);
      if (kt + 2 < nk) { GM_STORE(ra0, rb0, 0) }
      __syncthreads();
    }
  }
}

DI void stage_c(const f32x4 (&acc)[4][4], float* Cs) {
  const int tid = tidx(), lane = tid & 63, w = tid >> 6;
  const int wm = w >> 1, wn = w & 1, fr = lane & 15, fq = lane >> 4;
#pragma unroll
  for (int m = 0; m < 4; ++m)
#pragma unroll
    for (int n = 0; n < 4; ++n)
#pragma unroll
      for (int j = 0; j < 4; ++j) Cs[(wm * 64 + m * 16 + fq * 4 + j) * CST + wn * 64 + n * 16 + fr] = acc[m][n][j];
  __syncthreads();
}
DI void ld8(const float* Cs, float* v) {
  float4 a = *(const float4*)Cs, b = *(const float4*)(Cs + 4);
  v[0] = a.x; v[1] = a.y; v[2] = a.z; v[3] = a.w; v[4] = b.x; v[5] = b.y; v[6] = b.z; v[7] = b.w;
}

DI void prep_w(const float* __restrict__ src, int K, int N, u16* __restrict__ dst, int Npad, const float* __restrict__ g, int perm,
               u16* T) {
  const int tid = tidx();
  const int ntn = Npad >> 6, ntiles = (K >> 6) * ntn;
  for (int it = vbid(); it < ntiles; it += vgrid()) {
    const int kt = it / ntn, k0 = kt * 64, n0 = (it - kt * ntn) * 64;
    int sn0 = n0;
    if (perm) { int tl = n0 >> 7, rr = n0 & 127; sn0 = (rr < 64) ? (tl * 64 + rr) : (256 + tl * 64 + rr - 64); }
    __syncthreads();
    {
      const int nn = tid & 63, kq = tid >> 6;
      const bool valid = (n0 + nn) < N;
      float v[16];
#pragma unroll
      for (int i = 0; i < 16; ++i) v[i] = valid ? src[(size_t)(k0 + kq + 4 * i) * N + sn0 + nn] : 0.f;
      if (g) {
#pragma unroll
        for (int i = 0; i < 16; ++i) v[i] *= g[k0 + kq + 4 * i];
      }
#pragma unroll
      for (int i = 0; i < 16; ++i) T[(kq + 4 * i) * 72 + nn] = f2bf(v[i]);
    }
    __syncthreads();
    {
      const int nn = tid >> 2, kc = (tid & 3) * 16;
      unsigned w[8];
#pragma unroll
      for (int j = 0; j < 8; ++j) w[j] = (unsigned)T[(kc + 2 * j) * 72 + nn] | ((unsigned)T[(kc + 2 * j + 1) * 72 + nn] << 16);
      u32x4 o0 = {w[0], w[1], w[2], w[3]}, o1 = {w[4], w[5], w[6], w[7]};
      u16* d = dst + (size_t)(n0 + nn) * K + k0 + kc;
      *(u32x4*)d = o0; *(u32x4*)(d + 8) = o1;
    }
  }
}

DI void phase_prep(PREF p, unsigned char* ldsb) {
  u16* T = (u16*)ldsb;
  const int gtid = vbid() * 256 + tidx(), gsz = vgrid() * 256;
  for (int l = 0; l < NL; ++l) {
    u16* W = p.wts + (size_t)l * WL;
    prep_w(p.w_in + (size_t)l * 1024 * HW, 1024, HW, W + O_WIN, 2816, nullptr, 0, T);
    prep_w(p.w_merge + (size_t)l * 1024 * 4096, 1024, 4096, W + O_WM, 4096, nullptr, 0, T);
    prep_w(p.w_pw2 + (size_t)l * 65536, 256, 256, W + O_PW2, 256, nullptr, 0, T);
    prep_w(p.w_uq + (size_t)l * 256 * 384, 256, 384, W + O_UQ, 384, p.qng + l * 256, 0, T);
    prep_w(p.w_ukv + (size_t)l * 128 * 512, 128, 512, W + O_UKV, 512, p.kvng + l * 128, 0, T);
    prep_w(p.w_glu + (size_t)l * 256 * 512, 256, 512, W + O_GLU, 512, nullptr, 1, T);
    for (int nb = 0; nb < 4; ++nb)
      prep_w(p.w_branch + ((size_t)l * 4 + nb) * 256 * 1024, 256, 1024, W + O_BR + (size_t)nb * 1024 * 256, 1024, nullptr, 0, T);
    prep_w(p.w_out + (size_t)l * 1048576, 1024, 1024, W + O_OUT, 1024, nullptr, 0, T);
    prep_w(p.w_ple + (size_t)l * 262144, 256, 1024, W + O_PLE, 1024, nullptr, 0, T);
    prep_w(p.w_pleg + (size_t)l * 1048576, 1024, 1024, W + O_PLEG, 1024, nullptr, 0, T);
  }
  for (int idx = gtid; idx < NL * 16 * 64; idx += gsz) {
    int lg = idx >> 6;
    float dt = expf(p.log_dt[lg]);
    float lr = p.a_re[idx], li = p.a_im[idx];
    float mag = expf(lr * dt);
    float lbr = mag * cosf(li * dt), lbi = mag * sinf(li * dt);
    float den = lr * lr + li * li;
    float nr = lbr - 1.f, ni = lbi;
    float fre = (nr * lr + ni * li) / den, fim = (ni * lr - nr * li) / den;
    p.lam[idx * 2] = lbr; p.lam[idx * 2 + 1] = lbi;
    for (int h = 0; h < 16; ++h) {
      float br = p.b_re[(size_t)idx * 16 + h], bi = p.b_im[(size_t)idx * 16 + h];
      p.bbre[(size_t)idx * 16 + h] = fre * br - fim * bi;
      p.bbim[(size_t)idx * 16 + h] = fre * bi + fim * br;
    }
  }
  for (int idx = gtid; idx < S_ * 16; idx += gsz) {
    int pos = idx >> 4, i = idx & 15;
    float inv = powf(10000.f, -(float)(2 * i) / 32.f);
    float ang = (float)pos * inv;
    p.rcos[idx] = cosf(ang); p.rsin[idx] = sinf(ang);
  }
  for (int idx = gtid; idx < T_ * D_ / 8; idx += gsz) {
    const float4* s = (const float4*)(p.x + (size_t)idx * 8);
    float4 a = s[0], b = s[1];
    float v[8] = {a.x, a.y, a.z, a.w, b.x, b.y, b.z, b.w};
    *(u32x4*)(p.X + (size_t)idx * 8) = pack8(v);
  }
}

constexpr int G_HT = 128 * 64;
DI void lds_barrier() { asm volatile("s_waitcnt lgkmcnt(0)\n\ts_barrier" ::: "memory"); }
DI int tid512() { int t = threadIdx.x; asm volatile("" : "+v"(t)); return t; }
DI void g_stage_rc(int b, int& R, int& C) {
  int st = b >> 10, sb = b & 1023, swz = sb ^ (((sb >> 9) & 1) << 5);
  R = (st >> 1) * 16 + (swz >> 6); C = (st & 1) * 32 + ((swz & 63) >> 1);
}
#define G_SA(b, h) (shm + ((b) * 2 + (h)) * G_HT)
#define G_SB(b, h) (shm + (4 + (b) * 2 + (h)) * G_HT)
#define G_STAGE(P, BASE, O0, O1, LD, br, KOFF)                                                                             \
  do {                                                                                                                    \
    const u16* g_ = (BASE) + (size_t)(br) * (LD) + (KOFF);                                                              \
    __builtin_amdgcn_global_load_lds((const unsigned*)(g_ + (O0)), (unsigned*)((char*)(P) + t * 16), 16, 0, 0);          \
    __builtin_amdgcn_global_load_lds((const unsigned*)(g_ + (O1)), (unsigned*)((char*)(P) + t * 16 + 8192), 16, 0, 0);   \
  } while (0)
#define G_LDA(dst, b, h)                                                                                                  \
  _Pragma("unroll") for (int m = 0; m < 4; ++m) _Pragma("unroll") for (int k = 0; k < 2; ++k)                             \
      dst[m][k] = *(const bf16x8*)((const char*)G_SA(b, h) + ((wr * 4 + m) * 2 + k) * 1024 + rdo)
#define G_LDB(dst, b, h)                                                                                                  \
  _Pragma("unroll") for (int n = 0; n < 2; ++n) _Pragma("unroll") for (int k = 0; k < 2; ++k)                             \
      dst[n][k] = *(const bf16x8*)((const char*)G_SB(b, h) + ((wc * 2 + n) * 2 + k) * 1024 + rdo)
#define G_MMA(ai, bj, At, Bt)                                                                                             \
  do {                                                                                                                    \
    __builtin_amdgcn_s_setprio(1);                                                                                        \
    _Pragma("unroll") for (int m = 0; m < 4; ++m) _Pragma("unroll") for (int n = 0; n < 2; ++n)                           \
        _Pragma("unroll") for (int k = 0; k < 2; ++k) acc[ai][bj][m][n] = MFMA16(At[m][k], Bt[n][k], acc[ai][bj][m][n]);  \
    __builtin_amdgcn_s_setprio(0);                                                                                        \
  } while (0)
#define G_WAIT_V(n) asm volatile("s_waitcnt vmcnt(" #n ")" ::: "memory")
#define G_WAIT_L(n) asm volatile("s_waitcnt lgkmcnt(" #n ")" ::: "memory")
#define G_BAR __builtin_amdgcn_s_barrier()
#define G_SCHED __builtin_amdgcn_sched_barrier(0)

DI void br_flush(PREF p, f32x4 (&acc)[2][2][4][2], int slot);
template <int LDA, int LDB, int K, int MODE = 0>
DI void gemm256(f32x4 (&acc)[2][2][4][2], const u16* __restrict__ A, const u16* __restrict__ B, u16* shm, PREF p) {
#define KA(kt) ((kt) * 64)
#define KB(kt) (MODE ? (((kt) >> 2) * (1024 * LDB) + ((kt) & 3) * 64) : (kt) * 64)
  const int t = tid512();
  const int wid = t >> 6, lane = t & 63, wr = wid >> 2, wc = wid & 3, fr = lane & 15, fq = lane >> 4;
  int r0, c0, r1, c1;
  g_stage_rc(t * 16, r0, c0); g_stage_rc(t * 16 + 8192, r1, c1);
  const int oa0 = r0 * LDA + c0, oa1 = r1 * LDA + c1, ob0 = r0 * LDB + c0, ob1 = r1 * LDB + c1;
  const int obr = fr * 64 + fq * 16, rdo = obr ^ (((obr >> 9) & 1) << 5);
  bf16x8 At[4][2], B0[2][2], B1[2][2];
  constexpr int nt = K / 64;
  lds_barrier();
  G_STAGE(G_SB(0, 0), B, ob0, ob1, LDB, 0, KB(0)); G_STAGE(G_SA(0, 0), A, oa0, oa1, LDA, 0, KA(0));
  G_STAGE(G_SB(0, 1), B, ob0, ob1, LDB, 128, KB(0)); G_STAGE(G_SA(0, 1), A, oa0, oa1, LDA, 128, KA(0));
  if (wr == 1) G_BAR;
  G_WAIT_V(4); G_BAR;
  G_STAGE(G_SB(1, 0), B, ob0, ob1, LDB, 0, KB(1)); G_STAGE(G_SA(1, 0), A, oa0, oa1, LDA, 0, KA(1)); G_STAGE(G_SB(1, 1), B, ob0, ob1, LDB, 128, KB(1));
  G_WAIT_V(6); G_BAR;
  for (int tt = 0; tt < nt - 2; tt += 2) {
    G_LDB(B0, 0, 0); G_SCHED; G_LDA(At, 0, 0); G_STAGE(G_SA(1, 1), A, oa0, oa1, LDA, 128, KA(tt + 1));
    G_WAIT_L(8); G_BAR; G_WAIT_L(0); G_MMA(0, 0, At, B0); G_BAR; G_SCHED;
    G_LDB(B1, 0, 1); G_STAGE(G_SB(0, 0), B, ob0, ob1, LDB, 0, KB(tt + 2));
    G_BAR; G_WAIT_L(0); G_MMA(0, 1, At, B1); G_BAR;
    G_LDA(At, 0, 1); G_STAGE(G_SA(0, 0), A, oa0, oa1, LDA, 0, KA(tt + 2));
    G_BAR; G_WAIT_L(0); G_MMA(1, 0, At, B0); G_BAR; G_SCHED;
    G_STAGE(G_SB(0, 1), B, ob0, ob1, LDB, 128, KB(tt + 2));
    G_WAIT_V(6); G_BAR; G_MMA(1, 1, At, B1); G_BAR;
    G_LDB(B0, 1, 0); G_SCHED; G_LDA(At, 1, 0); G_STAGE(G_SA(0, 1), A, oa0, oa1, LDA, 128, KA(tt + 2));
    G_WAIT_L(8); G_BAR; G_WAIT_L(0); G_MMA(0, 0, At, B0); G_BAR; G_SCHED;
    G_LDB(B1, 1, 1); G_STAGE(G_SB(1, 0), B, ob0, ob1, LDB, 0, KB(tt + 3));
    G_BAR; G_WAIT_L(0); G_MMA(0, 1, At, B1); G_BAR;
    G_LDA(At, 1, 1); G_STAGE(G_SA(1, 0), A, oa0, oa1, LDA, 0, KA(tt + 3));
    G_BAR; G_WAIT_L(0); G_MMA(1, 0, At, B0); G_BAR; G_SCHED;
    G_STAGE(G_SB(1, 1), B, ob0, ob1, LDB, 128, KB(tt + 3));
    G_WAIT_V(6); G_BAR; G_MMA(1, 1, At, B1); G_BAR;
    if (MODE && ((tt + 1) & 3) == 3) br_flush(p, acc, (tt + 1) >> 2);
  }
  {
    G_LDB(B0, 0, 0); G_LDA(At, 0, 0); G_STAGE(G_SA(1, 1), A, oa0, oa1, LDA, 128, KA(nt - 1));
    G_BAR; G_WAIT_L(0); G_MMA(0, 0, At, B0); G_BAR;
    G_LDB(B1, 0, 1); G_BAR; G_WAIT_L(0); G_MMA(0, 1, At, B1); G_BAR;
    G_LDA(At, 0, 1); G_WAIT_V(4); G_BAR; G_WAIT_L(0); G_MMA(1, 0, At, B0); G_MMA(1, 1, At, B1); G_BAR;
  }
  {
    G_LDB(B0, 1, 0); G_LDA(At, 1, 0); G_WAIT_V(2); G_BAR; G_WAIT_L(0); G_MMA(0, 0, At, B0); G_BAR;
    G_LDB(B1, 1, 1); G_WAIT_V(0); G_BAR; G_WAIT_L(0); G_MMA(0, 1, At, B1); G_BAR;
    G_LDA(At, 1, 1); G_BAR; G_WAIT_L(0); G_MMA(1, 0, At, B0); G_MMA(1, 1, At, B1); G_BAR;
  }
  if (wr == 0) G_BAR;
#undef KA
#undef KB
}
DI void zero_acc256(f32x4 (&a)[2][2][4][2]) {
#pragma unroll
  for (int i = 0; i < 2; ++i)
#pragma unroll
    for (int j = 0; j < 2; ++j)
#pragma unroll
      for (int m = 0; m < 4; ++m)
#pragma unroll
        for (int n = 0; n < 2; ++n)
#pragma unroll
          for (int e = 0; e < 4; ++e) a[i][j][m][n][e] = 0.f;
}
template <int AI, int BJ>
DI void stage_q(const f32x4 (&acc)[2][2][4][2], float* Cs) {
  const int t = tid512(), wid = t >> 6, lane = t & 63, wr = wid >> 2, wc = wid & 3, fr = lane & 15, fq = lane >> 4;
  lds_barrier();
#pragma unroll
  for (int m = 0; m < 4; ++m)
#pragma unroll
    for (int n = 0; n < 2; ++n)
#pragma unroll
      for (int j = 0; j < 4; ++j) Cs[(wr * 64 + m * 16 + fq * 4 + j) * CST + wc * 32 + n * 16 + fr] = acc[AI][BJ][m][n][j];
  lds_barrier();
}
DI bool xcd_tile256(int k, int NT, int& m, int& n) {
  const int x = blockIdx.x & 7, slots = gridDim.x >> 3;
  const int idx = (int)(blockIdx.x >> 3) + slots * k;
  if (idx >= 16 * NT) return false;
  const int mg = idx / (8 * NT), rem = idx - mg * 8 * NT;
  n = rem >> 3; m = x * 16 + mg * 8 + (rem & 7);
  return true;
}

DI bool xcd_tile(int k, int NT, int& m, int& n) {
  const int x = (vbid() >> 1) & 7, slots = vgrid() >> 3;
  const int idx = (((vbid() >> 4) << 1) | (vbid() & 1)) + slots * k;
  if (idx >= 32 * NT) return false;
  const int mg = idx / (8 * NT), rem = idx - mg * 8 * NT;
  n = rem >> 3; m = x * 32 + mg * 8 + (rem & 7);
  return true;
}

template <int AI, int BJ>
DI void in_quadrant(PREF p, const f32x4 (&acc)[2][2][4][2], int mt, int nt, float* Cs) {
  const int t = tid512();
  const int row0 = mt * 256 + AI * 128, col0 = nt * 256 + BJ * 128;
  if (col0 >= HW) return;
  stage_q<AI, BJ>(acc, Cs);
#pragma unroll
  for (int q = 0; q < 4; ++q) {
    int r = (t >> 4) + 32 * q, c = (t & 15) * 8;
    if (col0 + c < HW) {
      float v[8]; ld8(Cs + r * CST + c, v);
      *(u32x4*)(p.hb + (size_t)(row0 + r) * HW + col0 + c) = pack8(v);
    }
  }
  if (col0 + 128 > OFF_SV && col0 < OFF_SV + 128) {
    int b = row0 >> 12, s0 = row0 & 4095;
#pragma unroll
    for (int q = 0; q < 4; ++q) {
      int item = t + 512 * q; int c = item & 127, rg = item >> 7;
      int vc = col0 + c - OFF_SV;
      if (vc >= 0 && vc < 128) {
        float v[8];
#pragma unroll
        for (int j = 0; j < 8; ++j) v[j] = Cs[(rg * 8 + j) * CST + c];
        *(u32x4*)(p.Vst + ((size_t)(b * 2 + (vc >> 6)) * 64 + (vc & 63)) * S_ + s0 + rg * 8) = pack8(v);
      }
    }
  }
}
DI void phase_in(PREF p, int l, unsigned char* lds_all) {
  u16* shm = (u16*)lds_all; float* Cs = (float*)lds_all;
  const int tid = tidx();
  const u16* W = p.wts + (size_t)l * WL + O_WIN;
  for (int k = 0;; ++k) {
    int mt, nt;
    if (!xcd_tile256(k, 11, mt, nt)) break;
    f32x4 acc[2][2][4][2]; zero_acc256(acc);
    gemm256<1024, 1024, 1024>(acc, p.X + (size_t)mt * 256 * 1024, W + (size_t)nt * 256 * 1024, shm, p);
    in_quadrant<0, 0>(p, acc, mt, nt, Cs); in_quadrant<0, 1>(p, acc, mt, nt, Cs);
    in_quadrant<1, 0>(p, acc, mt, nt, Cs); in_quadrant<1, 1>(p, acc, mt, nt, Cs);
  }
  __syncthreads();
  const int gtid = vbid() * 256 + tid, gsz = vgrid() * 256;
  const float* ps = p.p + (size_t)l * T_ * 256;
  for (int idx = gtid; idx < T_ * 256 / 8; idx += gsz) {
    const float4* s = (const float4*)(ps + (size_t)idx * 8);
    float4 a = s[0], b = s[1];
    float v[8] = {a.x, a.y, a.z, a.w, b.x, b.y, b.z, b.w};
    *(u32x4*)(p.pb + (size_t)idx * 8) = pack8(v);
  }
}

template <int DQK, bool WIN>
DI void attn_item(const u16* __restrict__ Qb, int ldq, const u16* __restrict__ Kb, int ldk, const u16* __restrict__ Vtb, int qb,
                  float qscale, float sink2, const u16* __restrict__ zb, int ldz, u16* __restrict__ ob, int ldo, u16* lds) {
  constexpr int KST = DQK + 8, NKS = DQK / 16, KCH = DQK / 8;
  constexpr int KBUF = 64 * KST, VBUF = 64 * 72, STG = KBUF + VBUF;
  constexpr int NKL = (64 * KCH) / 256;
  const int tid = tidx(), lane = tid & 63, w = tid >> 6, r = lane & 31, hh = lane >> 5;
  const int q0 = qb * 128 + w * 32;
  const int qrow = q0 + r;
  bf16x8 qf[NKS];
#pragma unroll
  for (int s = 0; s < NKS; ++s) qf[s] = *(const bf16x8*)(Qb + (size_t)qrow * ldq + 16 * s + 8 * hh);
  const int kt_lo = WIN ? (qb > 0 ? 2 * qb - 2 : 0) : 0;
  const int kt_hi = 2 * qb + 1;
  f32x16 o[2];
#pragma unroll
  for (int i = 0; i < 16; ++i) { o[0][i] = 0.f; o[1][i] = 0.f; }
  float m = WIN ? sink2 : -1e30f;
  float lsum = (WIN && hh == 0) ? 1.f : 0.f;
  u32x4 rkA[NKL], rvA[2], rkB[NKL], rvB[2];
  auto gload = [&](u32x4 (&rk)[NKL], u32x4 (&rv)[2], int kt) {
#pragma unroll
    for (int i = 0; i < NKL; ++i) {
      int id = tid + 256 * i; int row = id / KCH, ch = id % KCH;
      rk[i] = *(const u32x4*)(Kb + (size_t)(kt * 64 + row) * ldk + ch * 8);
    }
#pragma unroll
    for (int i = 0; i < 2; ++i) {
      int id = tid + 256 * i; int row = id >> 3, ch = id & 7;
      rv[i] = *(const u32x4*)(Vtb + (size_t)row * S_ + kt * 64 + ch * 8);
    }
  };
  auto swrite = [&](const u32x4 (&rk)[NKL], const u32x4 (&rv)[2], int buf) {
    u16* ks = lds + buf * STG; u16* vs = ks + KBUF;
#pragma unroll
    for (int i = 0; i < NKL; ++i) {
      int id = tid + 256 * i; int row = id / KCH, ch = id % KCH;
      *(u32x4*)(ks + row * KST + ch * 8) = rk[i];
    }
#pragma unroll
    for (int i = 0; i < 2; ++i) {
      int id = tid + 256 * i; int row = id >> 3, ch = id & 7;
      *(u32x4*)(vs + row * 72 + ch * 8) = rv[i];
    }
  };
  auto tile_body = [&](int kt, int buf, auto mask_tag) {
    constexpr bool MASK = decltype(mask_tag)::value;
    const u16* ks = lds + buf * STG; const u16* vs = ks + KBUF;
    const int k0 = kt * 64;
    bool active = (k0 <= q0 + 31);
    if (WIN) active = active && (k0 + 63 >= q0 - 127);
    if (active) {
      f32x16 st[2];
#pragma unroll
      for (int kb = 0; kb < 2; ++kb) {
#pragma unroll
        for (int i = 0; i < 16; ++i) st[kb][i] = 0.f;
#pragma unroll
        for (int s = 0; s < NKS; ++s) {
          bf16x8 a = *(const bf16x8*)(ks + (kb * 32 + r) * KST + 16 * s + 8 * hh);
          st[kb] = MFMA32(a, qf[s], st[kb]);
        }
      }
      float mx = -INFINITY;
#pragma unroll
      for (int kb = 0; kb < 2; ++kb)
#pragma unroll
        for (int i = 0; i < 16; ++i) {
          float v = st[kb][i];
          if (MASK) {
            int kg = k0 + kb * 32 + (i & 3) + 8 * (i >> 2) + 4 * hh;
            bool ok = kg <= qrow;
            if (WIN) ok = ok && (qrow - kg < 128);
            v = ok ? v : -INFINITY;
            st[kb][i] = v;
          }
          mx = fmaxf(mx, v);
        }
      mx = fmaxf(mx, __shfl_xor(mx, 32));
      const float mn = fmaxf(m, mx);
      if (__any(mn != m)) {
        const float alpha = __builtin_amdgcn_exp2f((m - mn) * qscale);
        lsum *= alpha;
#pragma unroll
        for (int i = 0; i < 16; ++i) { o[0][i] *= alpha; o[1][i] *= alpha; }
      }
      m = mn;
      const float nb = -mn * qscale;
      float ps = 0.f;
#pragma unroll
      for (int kb = 0; kb < 2; ++kb)
#pragma unroll
        for (int i = 0; i < 16; ++i) { float pv = __builtin_amdgcn_exp2f(fmaf(st[kb][i], qscale, nb)); st[kb][i] = pv; ps += pv; }
      lsum += ps;
#pragma unroll
      for (int kb = 0; kb < 2; ++kb)
#pragma unroll
        for (int s2 = 0; s2 < 2; ++s2) {
          union { bf16x8 v; unsigned u[4]; } pf;
#pragma unroll
          for (int j = 0; j < 4; ++j) pf.u[j] = pack2(st[kb][8 * s2 + 2 * j], st[kb][8 * s2 + 2 * j + 1]);
          const int kbase = kb * 32 + 16 * s2 + 4 * hh;
#pragma unroll
          for (int vb = 0; vb < 2; ++vb) {
            union { bf16x8 v; u32x2 u[2]; } vf;
            vf.u[0] = *(const u32x2*)(vs + (vb * 32 + r) * 72 + kbase);
            vf.u[1] = *(const u32x2*)(vs + (vb * 32 + r) * 72 + kbase + 8);
            o[vb] = MFMA32(vf.v, pf.v, o[vb]);
          }
        }
    }
  };
  __syncthreads();
  gload(rkA, rvA, kt_lo);
  gload(rkB, rvB, kt_lo + 1);
  swrite(rkA, rvA, 0);
  __syncthreads();
  for (int kt = kt_lo; kt <= kt_hi; kt += 2) {
    if (kt + 2 <= kt_hi) gload(rkA, rvA, kt + 2);
    if (WIN || kt >= 2 * qb) tile_body(kt, 0, std::true_type{}); else tile_body(kt, 0, std::false_type{});
    swrite(rkB, rvB, 1);
    __syncthreads();
    if (kt + 3 <= kt_hi) gload(rkB, rvB, kt + 3);
    if (WIN || kt + 1 >= 2 * qb) tile_body(kt + 1, 1, std::true_type{}); else tile_body(kt + 1, 1, std::false_type{});
    if (kt + 2 <= kt_hi) swrite(rkA, rvA, 0);
    __syncthreads();
  }
  float lt = lsum + __shfl_xor(lsum, 32);
  float inv = 1.f / lt;
  u32x2 zr[8];
#pragma unroll
  for (int e = 0; e < 8; ++e) zr[e] = *(const u32x2*)(zb + (size_t)qrow * ldz + (e >> 2) * 32 + 8 * (e & 3) + 4 * hh);
#pragma unroll
  for (int vb = 0; vb < 2; ++vb)
#pragma unroll
    for (int g4 = 0; g4 < 4; ++g4) {
      int vd0 = vb * 32 + 8 * g4 + 4 * hh;
      u32x2 z = zr[vb * 4 + g4];
      float a0 = o[vb][4 * g4 + 0] * inv * silu(lo2f(z.x));
      float a1 = o[vb][4 * g4 + 1] * inv * silu(hi2f(z.x));
      float a2 = o[vb][4 * g4 + 2] * inv * silu(lo2f(z.y));
      float a3 = o[vb][4 * g4 + 3] * inv * silu(hi2f(z.y));
      u32x2 ov; ov.x = pack2(a0, a1); ov.y = pack2(a2, a3);
      *(u32x2*)(ob + (size_t)qrow * ldo + vd0) = ov;
    }
}

DI void conv_item(PREF p, int l, int tile, unsigned char* ldsb) {
  float* Gs = (float*)ldsb;
  const int tid = tidx(), lane = tid & 63, w = tid >> 6;
  const int t0 = tile * 32, s0 = t0 & 4095;
  __syncthreads();
  for (int id = tid; id < 62 * 32; id += 256) {
    int rr = id >> 5, ch = (id & 31) * 8;
    int s = s0 - 30 + rr;
    float v[8];
#pragma unroll
    for (int j = 0; j < 8; ++j) v[j] = 0.f;
    if (s >= 0) {
      const u16* src = p.hb + (size_t)(t0 - 30 + rr) * HW + ch;
      float a[8], g[8];
      unpack8(*(const u32x4*)(src + OFF_AVAL), a);
      unpack8(*(const u32x4*)(src + OFF_AGATE), g);
#pragma unroll
      for (int j = 0; j < 8; ++j) v[j] = a[j] * sigm(g[j]);
    }
    *(float4*)(Gs + rr * 256 + ch) = make_float4(v[0], v[1], v[2], v[3]);
    *(float4*)(Gs + rr * 256 + ch + 4) = make_float4(v[4], v[5], v[6], v[7]);
  }
  __syncthreads();
  {
    const int c = tid;
    float wv[31];
#pragma unroll
    for (int j = 0; j < 31; ++j) wv[j] = p.conv_w[((size_t)l * 31 + j) * 256 + c];
    const float bias = p.conv_b[l * 256 + c];
    for (int tt = 0; tt < 32; ++tt) {
      float acc = bias;
#pragma unroll
      for (int j = 0; j < 31; ++j) acc += wv[j] * Gs[(tt + j) * 256 + c];
      Gs[tt * 256 + c] = acc;
    }
  }
  __syncthreads();
  const float4 gg = *(const float4*)(p.conv_ng + l * 256 + lane * 4);
  const float4 bb = *(const float4*)(p.conv_nb + l * 256 + lane * 4);
  for (int q = 0; q < 8; ++q) {
    int tt = w * 8 + q;
    float4 v = *(const float4*)(Gs + tt * 256 + lane * 4);
    float mu = wsum(v.x + v.y + v.z + v.w) * (1.f / 256.f);
    float d0 = v.x - mu, d1 = v.y - mu, d2 = v.z - mu, d3 = v.w - mu;
    float var = wsum(d0 * d0 + d1 * d1 + d2 * d2 + d3 * d3) * (1.f / 256.f);
    float rs = rsqrtf(var + 1e-5f);
    float y0 = silu(d0 * rs * gg.x + bb.x), y1 = silu(d1 * rs * gg.y + bb.y);
    float y2 = silu(d2 * rs * gg.z + bb.z), y3 = silu(d3 * rs * gg.w + bb.w);
    u32x2 ov; ov.x = pack2(y0, y1); ov.y = pack2(y2, y3);
    *(u32x2*)(p.cA + (size_t)(t0 + tt) * 256 + lane * 4) = ov;
  }
}

DI void ssm_stage_u(PREF p, int b, int c, int gq, float* uS) {
  const int tid = tidx();
  int row = tid >> 2, cc = (tid & 3) * 16;
  const u16* src = p.hb + (size_t)(b * S_ + c * 64 + row) * HW + OFF_U + gq * 64 + cc;
  float f[16];
  unpack8(*(const u32x4*)src, f); unpack8(*(const u32x4*)(src + 8), f + 8);
#pragma unroll
  for (int j = 0; j < 4; ++j) *(float4*)(uS + row * 64 + cc + 4 * j) = make_float4(f[4 * j], f[4 * j + 1], f[4 * j + 2], f[4 * j + 3]);
}
#define SSM_STEP(t)                                                                                                        \
  {                                                                                                                        \
    const float4* up = (const float4*)(uS + (t) * 64 + w * 16);                                                            \
    float4 u0 = up[0], u1 = up[1], u2 = up[2], u3 = up[3];                                                                 \
    float uu[16] = {u0.x, u0.y, u0.z, u0.w, u1.x, u1.y, u1.z, u1.w, u2.x, u2.y, u2.z, u2.w, u3.x, u3.y, u3.z, u3.w};       \
    float bur = 0.f, bui = 0.f;                                                                                            \
    _Pragma("unroll") for (int j = 0; j < 16; ++j) { bur += bre[j] * uu[j]; bui += bim[j] * uu[j]; }                       \
    float nr = lr * hr - li * hi + bur, ni = lr * hi + li * hr + bui;                                                      \
    hr = nr; hi = ni;                                                                                                      \
  }

DI void ssm1_item(PREF p, int l, int item, unsigned char* ldsb) {
  const int gq = item & 3, c = (item >> 2) & 63, b = item >> 8;
  const int tid = tidx(), w = tid >> 6, lane = tid & 63;
  const int g = gq * 4 + w;
  float* uS = (float*)ldsb;
  __syncthreads();
  ssm_stage_u(p, b, c, gq, uS);
  __syncthreads();
  const size_t pi = (size_t)(l * 16 + g) * 64 + lane;
  float bre[16], bim[16];
#pragma unroll
  for (int j = 0; j < 16; ++j) { bre[j] = p.bbre[pi * 16 + j]; bim[j] = p.bbim[pi * 16 + j]; }
  const float lr = p.lam[pi * 2], li = p.lam[pi * 2 + 1];
  float hr = 0.f, hi = 0.f;
  for (int t = 0; t < 64; ++t) SSM_STEP(t)
  ((float2*)p.hend)[((size_t)(b * 16 + g) * 64 + c) * 64 + lane] = make_float2(hr, hi);
}

DI void ssm2_item(PREF p, int l, int item, unsigned char* ldsb) {
  const int gq = item & 3, c = (item >> 2) & 63, b = item >> 8;
  const int tid = tidx(), w = tid >> 6, lane = tid & 63;
  const int g = gq * 4 + w;
  float* uS = (float*)ldsb;
  u16* Hs = (u16*)(ldsb + 16384) + w * (16 * 136);
  __syncthreads();
  ssm_stage_u(p, b, c, gq, uS);
  __syncthreads();
  const size_t pi = (size_t)(l * 16 + g) * 64 + lane;
  float bre[16], bim[16];
#pragma unroll
  for (int j = 0; j < 16; ++j) { bre[j] = p.bbre[pi * 16 + j]; bim[j] = p.bbim[pi * 16 + j]; }
  const float lr = p.lam[pi * 2], li = p.lam[pi * 2 + 1];
  float pr = lr, pim = li;
#pragma unroll
  for (int q = 0; q < 6; ++q) { float a = pr * pr - pim * pim, bq = 2.f * pr * pim; pr = a; pim = bq; }
  float hr = 0.f, hi = 0.f;
  const float2* he = (const float2*)p.hend + ((size_t)(b * 16 + g) * 64) * 64 + lane;
  for (int cc = 0; cc < c; ++cc) {
    float2 e = he[(size_t)cc * 64];
    float nr = pr * hr - pim * hi + e.x, ni = pr * hi + pim * hr + e.y;
    hr = nr; hi = ni;
  }
  const int hcol = lane & 15, q4 = lane >> 4;
  bf16x8 cf[4];
  {
    const float* cre = p.c_re + ((size_t)(l * 16 + g) * 16 + hcol) * 64;
    const float* cim = p.c_im + ((size_t)(l * 16 + g) * 16 + hcol) * 64;
#pragma unroll
    for (int ks = 0; ks < 4; ++ks) {
      float v[8];
#pragma unroll
      for (int j = 0; j < 8; ++j) {
        int k = 32 * ks + 8 * q4 + j;
        v[j] = (ks < 2) ? cre[k] : -cim[k - 64];
      }
      union { bf16x8 v8; u32x4 u; } cv; cv.u = pack8(v); cf[ks] = cv.v8;
    }
  }
  const float dch = p.ssm_d[l * 256 + g * 16 + hcol];
  for (int sub = 0; sub < 4; ++sub) {
    for (int tt = 0; tt < 16; ++tt) {
      SSM_STEP(sub * 16 + tt)
      Hs[tt * 136 + lane] = f2bf(hr);
      Hs[tt * 136 + 64 + lane] = f2bf(hi);
    }
    __syncthreads();
    f32x4 acc = {0.f, 0.f, 0.f, 0.f};
#pragma unroll
    for (int ks = 0; ks < 4; ++ks) {
      bf16x8 a = *(const bf16x8*)(Hs + hcol * 136 + 32 * ks + 8 * q4);
      acc = MFMA16(a, cf[ks], acc);
    }
#pragma unroll
    for (int j = 0; j < 4; ++j) {
      int t = sub * 16 + 4 * q4 + j;
      float uu = uS[t * 64 + w * 16 + hcol];
      float yv = gelu_t(acc[j] + dch * uu);
      p.yss[(size_t)(b * S_ + c * 64 + t) * 256 + g * 16 + hcol] = f2bf(yv);
    }
    __syncthreads();
  }
}

DI void q_tile(PREF p, int l, int idx, unsigned char* ldsb) {
  u16* lds = (u16*)ldsb; float* Cs = (float*)ldsb; float* aux = (float*)(ldsb + LDS_MAIN);
  const int tid = tidx();
  const int mt = idx / 3, nt = idx % 3;
  const int row0 = mt * 128, col0 = nt * 128;
  __syncthreads();
  if (tid < 128) {
    const u16* src = p.hb + (size_t)(row0 + tid) * HW + OFF_CQ;
    float ss = 0.f;
    for (int i = 0; i < 32; ++i) { float f[8]; unpack8(*(const u32x4*)(src + i * 8), f);
#pragma unroll
      for (int j = 0; j < 8; ++j) ss += f[j] * f[j]; }
    aux[tid] = rsqrtf(ss * (1.f / 256.f) + 1e-6f);
  }
  f32x4 acc[4][4]; zero_acc(acc);
  gemm_main(acc, p.hb + (size_t)row0 * HW + OFF_CQ, HW, p.wts + (size_t)l * WL + O_UQ + (size_t)col0 * 256, 256, 256, lds);
  stage_c(acc, Cs);
#pragma unroll
  for (int q = 0; q < 8; ++q) {
    int r = (tid >> 4) + 16 * q, c = (tid & 15) * 8;
    int n = col0 + c; int dd = n % 96;
    float rs = aux[r];
    float v[8]; ld8(Cs + r * CST + c, v);
#pragma unroll
    for (int j = 0; j < 8; ++j) v[j] *= rs;
    if (dd >= 64) {
      int ri0 = dd - 64; int s = (row0 + r) & 4095;
      float pv[8];
      if (ri0 < 16) {
        ld8(Cs + r * CST + c + 16, pv);
        const float* cs = p.rcos + s * 16 + ri0; const float* sn = p.rsin + s * 16 + ri0;
#pragma unroll
        for (int j = 0; j < 8; ++j) v[j] = v[j] * cs[j] - pv[j] * rs * sn[j];
      } else {
        ld8(Cs + r * CST + c - 16, pv);
        const float* cs = p.rcos + s * 16 + ri0 - 16; const float* sn = p.rsin + s * 16 + ri0 - 16;
#pragma unroll
        for (int j = 0; j < 8; ++j) v[j] = v[j] * cs[j] + pv[j] * rs * sn[j];
      }
    }
    *(u32x4*)(p.Qm + (size_t)(row0 + r) * 384 + n) = pack8(v);
  }
}

DI void kv_tile(PREF p, int l, int idx, unsigned char* ldsb) {
  u16* lds = (u16*)ldsb; float* Cs = (float*)ldsb; float* aux = (float*)(ldsb + LDS_MAIN);
  const int tid = tidx();
  const int mt = idx >> 2, head = idx & 3;
  const int row0 = mt * 128;
  __syncthreads();
  if (tid < 128) {
    const u16* src = p.hb + (size_t)(row0 + tid) * HW + OFF_CKV;
    float ss = 0.f;
    for (int i = 0; i < 16; ++i) { float f[8]; unpack8(*(const u32x4*)(src + i * 8), f);
#pragma unroll
      for (int j = 0; j < 8; ++j) ss += f[j] * f[j]; }
    aux[tid] = rsqrtf(ss * (1.f / 128.f) + 1e-6f);
  }
  f32x4 acc[4][4]; zero_acc(acc);
  gemm_main(acc, p.hb + (size_t)row0 * HW + OFF_CKV, HW, p.wts + (size_t)l * WL + O_UKV + (size_t)head * 128 * 128, 128, 128, lds);
  stage_c(acc, Cs);
#pragma unroll
  for (int q = 0; q < 4; ++q) {
    int r = (tid >> 3) + 32 * q, c = (tid & 7) * 8;
    float rs = aux[r];
    float v[8]; ld8(Cs + r * CST + c, v);
#pragma unroll
    for (int j = 0; j < 8; ++j) v[j] *= rs;
    *(u32x4*)(p.Km + (size_t)(row0 + r) * 384 + head * 96 + c) = pack8(v);
  }
  {
    int b = row0 >> 12, s0 = row0 & 4095;
#pragma unroll
    for (int q = 0; q < 4; ++q) {
      int item = tid + 256 * q; int c = item & 63, rg = item >> 6;
      float v[8];
#pragma unroll
      for (int j = 0; j < 8; ++j) v[j] = Cs[(rg * 8 + j) * CST + 64 + c] * aux[rg * 8 + j];
      *(u32x4*)(p.Vmt + ((size_t)(b * 4 + head) * 64 + c) * S_ + s0 + rg * 8) = pack8(v);
    }
  }
  {
    int r = tid >> 1, half = tid & 1;
    int t = row0 + r, s = t & 4095;
    const u16* src = p.hb + (size_t)t * HW + OFF_KR;
    float x1[16], x2[16];
    unpack8(*(const u32x4*)(src), x1); unpack8(*(const u32x4*)(src + 8), x1 + 8);
    unpack8(*(const u32x4*)(src + 16), x2); unpack8(*(const u32x4*)(src + 24), x2 + 8);
    const float* cs = p.rcos + s * 16; const float* sn = p.rsin + s * 16;
    float ov[16];
#pragma unroll
    for (int i = 0; i < 16; ++i) ov[i] = half ? (x2[i] * cs[i] + x1[i] * sn[i]) : (x1[i] * cs[i] - x2[i] * sn[i]);
    u16* dst = p.Km + (size_t)t * 384 + head * 96 + 64 + half * 16;
    *(u32x4*)dst = pack8(ov); *(u32x4*)(dst + 8) = pack8(ov + 8);
  }
}

DI void pw2_tile(PREF p, int l, int idx, unsigned char* ldsb) {
  u16* lds = (u16*)ldsb; float* Cs = (float*)ldsb;
  const int tid = tidx();
  const int mt = idx >> 1, nt = idx & 1;
  const int row0 = mt * 128, col0 = nt * 128;
  f32x4 acc[4][4]; zero_acc(acc);
  gemm_main(acc, p.cA + (size_t)row0 * 256, 256, p.wts + (size_t)l * WL + O_PW2 + (size_t)col0 * 256, 256, 256, lds);
  stage_c(acc, Cs);
  u32x4 zr[8];
#pragma unroll
  for (int q = 0; q < 8; ++q) zr[q] = *(const u32x4*)(p.hb + (size_t)(row0 + (tid >> 4) + 16 * q) * HW + OFF_AZ + col0 + (tid & 15) * 8);
#pragma unroll
  for (int q = 0; q < 8; ++q) {
    int r = (tid >> 4) + 16 * q, c = (tid & 15) * 8;
    float v[8]; ld8(Cs + r * CST + c, v);
    float z[8]; unpack8(zr[q], z);
#pragma unroll
    for (int j = 0; j < 8; ++j) v[j] *= silu(z[j]);
    *(u32x4*)(p.ys + (size_t)(row0 + r) * 1024 + col0 + c) = pack8(v);
  }
}

DI void glu_tile(PREF p, int l, int idx, unsigned char* ldsb) {
  u16* lds = (u16*)ldsb; float* Cs = (float*)ldsb;
  const int tid = tidx();
  const int mt = idx >> 2, nt = idx & 3;
  const int row0 = mt * 128;
  f32x4 acc[4][4]; zero_acc(acc);
  gemm_main(acc, p.yss + (size_t)row0 * 256, 256, p.wts + (size_t)l * WL + O_GLU + (size_t)nt * 128 * 256, 256, 256, lds);
  stage_c(acc, Cs);
  u32x4 zr[4];
#pragma unroll
  for (int q = 0; q < 4; ++q) zr[q] = *(const u32x4*)(p.hb + (size_t)(row0 + (tid >> 3) + 32 * q) * HW + OFF_CZ + nt * 64 + (tid & 7) * 8);
#pragma unroll
  for (int q = 0; q < 4; ++q) {
    int r = (tid >> 3) + 32 * q, c = (tid & 7) * 8;
    float v[8], g[8]; ld8(Cs + r * CST + c, v); ld8(Cs + r * CST + 64 + c, g);
    float z[8]; unpack8(zr[q], z);
#pragma unroll
    for (int j = 0; j < 8; ++j) v[j] = v[j] * sigm(g[j]) * silu(z[j]);
    *(u32x4*)(p.ys + (size_t)(row0 + r) * 1024 + 512 + nt * 64 + c) = pack8(v);
  }
}

template <int AI, int BJ>
DI void glu_quadrant(PREF p, const f32x4 (&acc)[2][2][4][2], int mt, int nt, float* Cs) {
  const int t = tid512();
  const int row0 = mt * 256 + AI * 128, oc0 = (nt * 2 + BJ) * 64, c = (t & 7) * 8;
  u32x4 zr[2];
#pragma unroll
  for (int q = 0; q < 2; ++q) zr[q] = *(const u32x4*)(p.hb + (size_t)(row0 + (t >> 3) + 64 * q) * HW + OFF_CZ + oc0 + c);
  stage_q<AI, BJ>(acc, Cs);
#pragma unroll
  for (int q = 0; q < 2; ++q) {
    const int r = (t >> 3) + 64 * q;
    float v[8], g[8]; ld8(Cs + r * CST + c, v); ld8(Cs + r * CST + 64 + c, g);
    float z[8]; unpack8(zr[q], z);
#pragma unroll
    for (int j = 0; j < 8; ++j) v[j] = v[j] * sigm(g[j]) * silu(z[j]);
    *(u32x4*)(p.ys + (size_t)(row0 + r) * 1024 + 512 + oc0 + c) = pack8(v);
  }
}
DI void glu_phase(PREF p, int l, unsigned char* lds_all) {
  u16* shm = (u16*)lds_all; float* Cs = (float*)lds_all;
  for (int it = blockIdx.x; it < 256; it += gridDim.x) {
    const int mt = it >> 1, nt = it & 1;
    f32x4 acc[2][2][4][2]; zero_acc256(acc);
    gemm256<256, 256, 256>(acc, p.yss + (size_t)mt * 256 * 256, p.wts + (size_t)l * WL + O_GLU + (size_t)nt * 256 * 256, shm, p);
    glu_quadrant<0, 0>(p, acc, mt, nt, Cs); glu_quadrant<0, 1>(p, acc, mt, nt, Cs);
    glu_quadrant<1, 0>(p, acc, mt, nt, Cs); glu_quadrant<1, 1>(p, acc, mt, nt, Cs);
  }
  __syncthreads();
}

DI u32x4* merge_scratch(PREF p, int region) { const int t = tid512(); return (u32x4*)p.fbuf + (size_t)blockIdx.x * 40960 + region * 8192 + (t >> 6) * 1024 + (t & 63); }
DI void br_store(PREF p, const f32x4 (&acc)[2][2][4][2], int slot) {
  u32x4* sb = merge_scratch(p, slot);
#pragma unroll
  for (int ai = 0; ai < 2; ++ai)
#pragma unroll
    for (int bj = 0; bj < 2; ++bj)
#pragma unroll
      for (int m = 0; m < 4; ++m) {
        u32x4 o;
        o.x = pack2(acc[ai][bj][m][0][0], acc[ai][bj][m][0][1]); o.y = pack2(acc[ai][bj][m][0][2], acc[ai][bj][m][0][3]);
        o.z = pack2(acc[ai][bj][m][1][0], acc[ai][bj][m][1][1]); o.w = pack2(acc[ai][bj][m][1][2], acc[ai][bj][m][1][3]);
        sb[((ai * 2 + bj) * 4 + m) * 64] = o;
      }
}
DI void br_flush(PREF p, f32x4 (&acc)[2][2][4][2], int slot) { br_store(p, acc, slot); zero_acc256(acc); }
DI void gate_reg(PREF p, int l, int n, f32x4 (&acc)[2][2][4][2], int dt) {
  const u32x4* sbn = merge_scratch(p, n);
  u32x4* ssum = merge_scratch(p, 4);
  const int t = tid512(), wid = t >> 6, lane = t & 63, wc = wid & 3, fr = lane & 15;
  const float* bm = p.b_merge + (size_t)l * 4096 + n * 1024 + dt * 256 + wc * 32 + fr;
  float bias[2][2];
#pragma unroll
  for (int bj = 0; bj < 2; ++bj)
#pragma unroll
    for (int nn = 0; nn < 2; ++nn) bias[bj][nn] = bm[bj * 128 + nn * 16];
#pragma unroll
  for (int ai = 0; ai < 2; ++ai)
#pragma unroll
    for (int bj = 0; bj < 2; ++bj) {
      __builtin_amdgcn_sched_barrier(0);
      u32x4 bn[4], pv[4];
#pragma unroll
      for (int m = 0; m < 4; ++m) {
        bn[m] = sbn[((ai * 2 + bj) * 4 + m) * 64];
        if (n > 0) pv[m] = ssum[((ai * 2 + bj) * 4 + m) * 64];
      }
#pragma unroll
      for (int m = 0; m < 4; ++m) {
        float b[8]; unpack8(bn[m], b);
        float v[8];
#pragma unroll
        for (int nn = 0; nn < 2; ++nn)
#pragma unroll
          for (int j = 0; j < 4; ++j) v[nn * 4 + j] = sigm(acc[ai][bj][m][nn][j] + bias[bj][nn]) * b[nn * 4 + j];
        if (n > 0) {
          float o[8]; unpack8(pv[m], o);
#pragma unroll
          for (int e = 0; e < 8; ++e) v[e] += o[e];
        }
        if (n < 3) ssum[((ai * 2 + bj) * 4 + m) * 64] = pack8(v);
#pragma unroll
        for (int nn = 0; nn < 2; ++nn)
#pragma unroll
          for (int j = 0; j < 4; ++j) acc[ai][bj][m][nn][j] = v[nn * 4 + j];
      }
    }
}
template <int AI, int BJ>
DI void mg_quadrant(PREF p, const f32x4 (&acc)[2][2][4][2], int mt, int dt, float* Cs) {
  const int t = tid512();
  const int row0 = mt * 256 + AI * 128, col0 = dt * 256 + BJ * 128;
  stage_q<AI, BJ>(acc, Cs);
#pragma unroll
  for (int q = 0; q < 4; ++q) {
    int r = (t >> 4) + 32 * q, c = (t & 15) * 8;
    float v[8]; ld8(Cs + r * CST + c, v);
    *(u32x4*)(p.mg + (size_t)(row0 + r) * 1024 + col0 + c) = pack8(v);
  }
}
DI void merge_phase(PREF p, int l, unsigned char* lds_all) {
  u16* shm = (u16*)lds_all; float* Cs = (float*)lds_all;
  const u16* W = p.wts + (size_t)l * WL;
  for (int k = 0;; ++k) {
    int mt, dt;
    if (!xcd_tile256(k, 4, mt, dt)) break;
    {
      f32x4 acc[2][2][4][2]; zero_acc256(acc);
      gemm256<1024, 256, 1024, 1>(acc, p.ys + (size_t)mt * 256 * 1024, W + O_BR + (size_t)dt * 256 * 256, shm, p);
      br_store(p, acc, 3);
    }
#pragma unroll 1
    for (int n = 0; n < 4; ++n) {
      f32x4 acc[2][2][4][2]; zero_acc256(acc);
      gemm256<1024, 1024, 1024>(acc, p.X + (size_t)mt * 256 * 1024, W + O_WM + ((size_t)n * 1024 + dt * 256) * 1024, shm, p);
      gate_reg(p, l, n, acc, dt);
      if (n == 3) {
        mg_quadrant<0, 0>(p, acc, mt, dt, Cs); mg_quadrant<0, 1>(p, acc, mt, dt, Cs);
        mg_quadrant<1, 0>(p, acc, mt, dt, Cs); mg_quadrant<1, 1>(p, acc, mt, dt, Cs);
      }
    }
  }
  __syncthreads();
}

template <int AI, int BJ>
DI void f1_load(PREF p, int l, int mt, int dt, float4 (&xa)[4], float4 (&xb)[4]) {
  const int t = tid512();
  const int row0 = mt * 256 + AI * 128, col0 = dt * 256 + BJ * 128, c = (t & 15) * 8;
  if (l == 0) {
#pragma unroll
    for (int q = 0; q < 4; ++q) {
      const float4* xs = (const float4*)(p.x + (size_t)(row0 + (t >> 4) + 32 * q) * 1024 + col0 + c);
      xa[q] = xs[0]; xb[q] = xs[1];
    }
  } else {
#pragma unroll
    for (int q = 0; q < 4; ++q) {
      float f[8]; unpack8(*(const u32x4*)(p.X + (size_t)(row0 + (t >> 4) + 32 * q) * 1024 + col0 + c), f);
      xa[q] = make_float4(f[0], f[1], f[2], f[3]); xb[q] = make_float4(f[4], f[5], f[6], f[7]);
    }
  }
}
template <int AI, int BJ>
DI void f1_proc(PREF p, const f32x4 (&acc)[2][2][4][2], int mt, int dt, float* Cs, const float4 (&xa)[4], const float4 (&xb)[4]) {
  const int t = tid512();
  const int row0 = mt * 256 + AI * 128, col0 = dt * 256 + BJ * 128, c = (t & 15) * 8;
  const float alpha = 1.681792830507429f;
  stage_q<AI, BJ>(acc, Cs);
#pragma unroll
  for (int q = 0; q < 4; ++q) {
    int r = (t >> 4) + 32 * q;
    float v[8]; ld8(Cs + r * CST + c, v);
    float4 a = xa[q], b = xb[q];
    float y[8] = {alpha * a.x + v[0], alpha * a.y + v[1], alpha * a.z + v[2], alpha * a.w + v[3],
                  alpha * b.x + v[4], alpha * b.y + v[5], alpha * b.z + v[6], alpha * b.w + v[7]};
    *(u32x4*)((u16*)p.fbuf + (size_t)(row0 + r) * 1024 + col0 + c) = pack8(y);
  }
}
DI void f1_phase(PREF p, int l, unsigned char* lds_all) {
  u16* shm = (u16*)lds_all; float* Cs = (float*)lds_all;
  for (int k = 0;; ++k) {
    int mt, dt;
    if (!xcd_tile256(k, 4, mt, dt)) break;
    f32x4 acc[2][2][4][2]; zero_acc256(acc);
    gemm256<1024, 1024, 1024>(acc, p.mg + (size_t)mt * 256 * 1024, p.wts + (size_t)l * WL + O_OUT + (size_t)dt * 256 * 1024, shm, p);
    {
      float4 aA[4], bA[4];
      f1_load<0, 0>(p, l, mt, dt, aA, bA); f1_proc<0, 0>(p, acc, mt, dt, Cs, aA, bA);
      f1_load<0, 1>(p, l, mt, dt, aA, bA); f1_proc<0, 1>(p, acc, mt, dt, Cs, aA, bA);
      f1_load<1, 0>(p, l, mt, dt, aA, bA); f1_proc<1, 0>(p, acc, mt, dt, Cs, aA, bA);
      f1_load<1, 1>(p, l, mt, dt, aA, bA); f1_proc<1, 1>(p, acc, mt, dt, Cs, aA, bA);
    }
  }
  __syncthreads();
}

template <int AI, int BJ>
DI void f3_load(PREF p, int mt, int dt, u32x4 (&g)[4]) {
  const int t = tid512();
  const int row0 = mt * 256 + AI * 128, col0 = dt * 256 + BJ * 128, c = (t & 15) * 8;
#pragma unroll
  for (int q = 0; q < 4; ++q) g[q] = *(const u32x4*)((const u16*)p.fbuf + (size_t)(row0 + (t >> 4) + 32 * q) * 1024 + col0 + c);
}
template <int AI, int BJ, int PASS>
DI void f3_proc(PREF p, const f32x4 (&acc)[2][2][4][2], int mt, int dt, float* Cs, const u32x4 (&g)[4]) {
  const int t = tid512();
  const int row0 = mt * 256 + AI * 128, col0 = dt * 256 + BJ * 128;
  const int c = (t & 15) * 8;
  stage_q<AI, BJ>(acc, Cs);
#pragma unroll
  for (int q = 0; q < 4; ++q) {
    int r = (t >> 4) + 32 * q;
    float v[8]; ld8(Cs + r * CST + c, v);
    if (PASS == 0) {
#pragma unroll
      for (int j = 0; j < 8; ++j) v[j] = sigm(v[j]);
    } else {
      float gf[8]; unpack8(g[q], gf);
#pragma unroll
      for (int j = 0; j < 8; ++j) v[j] *= gf[j];
    }
    *(u32x4*)((u16*)p.fbuf + (size_t)(row0 + r) * 1024 + col0 + c) = pack8(v);
  }
}
DI void f3_phase(PREF p, int l, unsigned char* lds_all) {
  u16* shm = (u16*)lds_all; float* Cs = (float*)lds_all;
  const u16* W = p.wts + (size_t)l * WL;
  for (int k = 0;; ++k) {
    int mt, dt;
    if (!xcd_tile256(k, 4, mt, dt)) break;
    {
      f32x4 acc[2][2][4][2]; zero_acc256(acc);
      gemm256<1024, 1024, 1024>(acc, p.X + (size_t)mt * 256 * 1024, W + O_PLEG + (size_t)dt * 256 * 1024, shm, p);
      u32x4 gd[4];
      f3_proc<0, 0, 0>(p, acc, mt, dt, Cs, gd); f3_proc<0, 1, 0>(p, acc, mt, dt, Cs, gd);
      f3_proc<1, 0, 0>(p, acc, mt, dt, Cs, gd); f3_proc<1, 1, 0>(p, acc, mt, dt, Cs, gd);
    }
    f32x4 acc[2][2][4][2]; zero_acc256(acc);
    gemm256<256, 256, 256>(acc, p.pb + (size_t)mt * 256 * 256, W + O_PLE + (size_t)dt * 256 * 256, shm, p);
    {
      u32x4 gA[4], gB[4];
      f3_load<0, 0>(p, mt, dt, gA);
      f3_load<0, 1>(p, mt, dt, gB); f3_proc<0, 0, 1>(p, acc, mt, dt, Cs, gA);
      f3_load<1, 0>(p, mt, dt, gA); f3_proc<0, 1, 1>(p, acc, mt, dt, Cs, gB);
      f3_load<1, 1>(p, mt, dt, gB); f3_proc<1, 0, 1>(p, acc, mt, dt, Cs, gA);
      f3_proc<1, 1, 1>(p, acc, mt, dt, Cs, gB);
    }
  }
  __syncthreads();
}

DI void rows_ln(PREF p, int l) {
  const int tid = tidx(), lane = tid & 63, w = tid >> 6;
  float gg[16], bb[16];
#pragma unroll
  for (int h = 0; h < 2; ++h) {
    const int c = h * 512 + lane * 8;
    const float4 g0 = *(const float4*)(p.ln_g + l * 1024 + c), g1 = *(const float4*)(p.ln_g + l * 1024 + c + 4);
    const float4 b0 = *(const float4*)(p.ln_b + l * 1024 + c), b1 = *(const float4*)(p.ln_b + l * 1024 + c + 4);
    gg[h * 8 + 0] = g0.x; gg[h * 8 + 1] = g0.y; gg[h * 8 + 2] = g0.z; gg[h * 8 + 3] = g0.w;
    gg[h * 8 + 4] = g1.x; gg[h * 8 + 5] = g1.y; gg[h * 8 + 6] = g1.z; gg[h * 8 + 7] = g1.w;
    bb[h * 8 + 0] = b0.x; bb[h * 8 + 1] = b0.y; bb[h * 8 + 2] = b0.z; bb[h * 8 + 3] = b0.w;
    bb[h * 8 + 4] = b1.x; bb[h * 8 + 5] = b1.y; bb[h * 8 + 6] = b1.z; bb[h * 8 + 7] = b1.w;
  }
  for (int row = vbid() * 4 + w; row < T_ / 2; row += vgrid() * 4) {
    u32x4 raw[2][2];
#pragma unroll
    for (int k = 0; k < 2; ++k) {
      const u16* src = (const u16*)p.fbuf + (size_t)(row + k * (T_ / 2)) * 1024;
      raw[k][0] = *(const u32x4*)(src + lane * 8);
      raw[k][1] = *(const u32x4*)(src + 512 + lane * 8);
    }
#pragma unroll
    for (int k = 0; k < 2; ++k) {
      float v[16];
      unpack8(raw[k][0], v); unpack8(raw[k][1], v + 8);
      float s = 0.f;
#pragma unroll
      for (int i = 0; i < 16; ++i) s += v[i];
      const float mu = wsum(s) * (1.f / 1024.f);
      float sq = 0.f;
#pragma unroll
      for (int i = 0; i < 16; ++i) { v[i] -= mu; sq += v[i] * v[i]; }
      const float rs = rsqrtf(wsum(sq) * (1.f / 1024.f) + 1e-5f);
#pragma unroll
      for (int h = 0; h < 2; ++h) {
        float y[8];
#pragma unroll
        for (int j = 0; j < 8; ++j) y[j] = v[h * 8 + j] * rs * gg[h * 8 + j] + bb[h * 8 + j];
        *(u32x4*)(p.X + (size_t)(row + k * (T_ / 2)) * 1024 + h * 512 + lane * 8) = pack8(y);
      }
    }
  }
}

DI void rows_ple(PREF p, int l) {
  const int tid = tidx(), lane = tid & 63, w = tid >> 6;
  float gg[16];
#pragma unroll
  for (int h = 0; h < 2; ++h) {
    const int c = h * 512 + lane * 8;
    const float4 g0 = *(const float4*)(p.ple_ng + l * 1024 + c), g1 = *(const float4*)(p.ple_ng + l * 1024 + c + 4);
    gg[h * 8 + 0] = g0.x; gg[h * 8 + 1] = g0.y; gg[h * 8 + 2] = g0.z; gg[h * 8 + 3] = g0.w;
    gg[h * 8 + 4] = g1.x; gg[h * 8 + 5] = g1.y; gg[h * 8 + 6] = g1.z; gg[h * 8 + 7] = g1.w;
  }
  for (int row = vbid() * 4 + w; row < T_ / 2; row += vgrid() * 4) {
    u32x4 re[2][2], rx[2][2];
#pragma unroll
    for (int k = 0; k < 2; ++k) {
      const size_t ro = (size_t)(row + k * (T_ / 2)) * 1024;
      re[k][0] = *(const u32x4*)((const u16*)p.fbuf + ro + lane * 8);
      re[k][1] = *(const u32x4*)((const u16*)p.fbuf + ro + 512 + lane * 8);
      rx[k][0] = *(const u32x4*)(p.X + ro + lane * 8);
      rx[k][1] = *(const u32x4*)(p.X + ro + 512 + lane * 8);
    }
#pragma unroll
    for (int k = 0; k < 2; ++k) {
      const size_t ro = (size_t)(row + k * (T_ / 2)) * 1024;
      float v[16], xv[16];
      unpack8(re[k][0], v); unpack8(re[k][1], v + 8);
      unpack8(rx[k][0], xv); unpack8(rx[k][1], xv + 8);
      float sq = 0.f;
#pragma unroll
      for (int i = 0; i < 16; ++i) sq += v[i] * v[i];
      const float rs = rsqrtf(wsum(sq) * (1.f / 1024.f) + 1e-6f);
#pragma unroll
      for (int h = 0; h < 2; ++h) {
        const int c = h * 512 + lane * 8;
        float y[8];
#pragma unroll
        for (int j = 0; j < 8; ++j) y[j] = xv[h * 8 + j] + v[h * 8 + j] * rs * gg[h * 8 + j];
        if (l == NL - 1) {
          float4* od = (float4*)(p.out + ro + c);
          od[0] = make_float4(y[0], y[1], y[2], y[3]); od[1] = make_float4(y[4], y[5], y[6], y[7]);
        } else {
          *(u32x4*)(p.X + ro + c) = pack8(y);
        }
      }
    }
  }
}

DI void phase_mix1(PREF p, int l, unsigned char* ldsb) {
  for (int it = vbid(); it < 1024; it += vgrid()) {
    int pi = it >> 1, b = pi >> 6, hq = ((pi >> 5) & 1) * 2 + (it & 1), qb = pi & 31;
    const u16* hbb = p.hb + (size_t)b * S_ * HW;
    attn_item<64, true>(hbb + OFF_SQ + hq * 64, HW, hbb + OFF_SK + (hq >> 1) * 64, HW,
                        p.Vst + (size_t)(b * 2 + (hq >> 1)) * 64 * S_, qb, 0.125f * LOG2E, p.sinks[l * 4 + hq] * 8.0f,
                        hbb + OFF_DZ + hq * 64, HW, p.ys + (size_t)b * S_ * 1024 + 768 + hq * 64, 1024, (u16*)ldsb);
  }
  for (int it = vbid(); it < 1024; it += vgrid()) kv_tile(p, l, it, ldsb);
  for (int it = vbid(); it < 768; it += vgrid()) q_tile(p, l, it, ldsb);
  for (int it = vbid(); it < 1024; it += vgrid()) conv_item(p, l, it, ldsb);
  for (int it = vbid(); it < 2048; it += vgrid()) ssm1_item(p, l, it, ldsb);
}
DI void phase_mix2(PREF p, int l, unsigned char* ldsb) {
  for (int it = vbid(); it < 1024; it += vgrid()) {
    int qb = (it < 512) ? 31 - (it >> 5) : ((it - 512) >> 5);
    int bh = it & 31, b = bh >> 2, head = bh & 3;
    attn_item<96, false>(p.Qm + (size_t)b * S_ * 384 + head * 96, 384, p.Km + (size_t)b * S_ * 384 + head * 96, 384,
                         p.Vmt + (size_t)(b * 4 + head) * 64 * S_, qb, 0.10206207261596577f * LOG2E, 0.f,
                         p.hb + (size_t)b * S_ * HW + OFF_BZ + head * 64, HW, p.ys + (size_t)b * S_ * 1024 + 256 + head * 64, 1024,
                         (u16*)ldsb);
  }
  for (int it = vbid(); it < 512; it += vgrid()) pw2_tile(p, l, it, ldsb);
  for (int it = vbid(); it < 2048; it += vgrid()) ssm2_item(p, l, it, ldsb);
}

DI void grid_barrier(unsigned* bar, unsigned gen) {
  asm volatile("s_waitcnt vmcnt(0)" ::: "memory");
  __syncthreads();
  if (threadIdx.x == 0) {
    __builtin_amdgcn_fence(__ATOMIC_RELEASE, "agent");
    const unsigned grp = blockIdx.x & 15u;
    const unsigned nblk = (gridDim.x + 15u - grp) >> 4;
    unsigned old = __hip_atomic_fetch_add(bar + 64 * (1 + grp), 1u, __ATOMIC_RELAXED, __HIP_MEMORY_SCOPE_AGENT);
    if (old + 1u == nblk * gen) {
      unsigned g = __hip_atomic_fetch_add(bar, 1u, __ATOMIC_RELAXED, __HIP_MEMORY_SCOPE_AGENT);
      if (g + 1u == 16u * gen) {
        for (int i = 0; i < 16; ++i) __hip_atomic_store(bar + 64 * (17 + i), gen, __ATOMIC_RELAXED, __HIP_MEMORY_SCOPE_AGENT);
      }
    }
    while (__hip_atomic_load(bar + 64 * (17 + grp), __ATOMIC_RELAXED, __HIP_MEMORY_SCOPE_AGENT) < gen) __builtin_amdgcn_s_sleep(4);
    __builtin_amdgcn_fence(__ATOMIC_ACQUIRE, "agent");
  }
  __syncthreads();
}

template <int J>
DI void run_phase(PREF p, int l, unsigned char* ldsb, unsigned char* lds_all) {
  if (J == 0) phase_in(p, l, lds_all);
  else if (J == 1) phase_mix1(p, l, ldsb);
  else if (J == 2) phase_mix2(p, l, ldsb);
  else if (J == 3) glu_phase(p, l, lds_all);
  else if (J == 4) merge_phase(p, l, lds_all);
  else if (J == 5) f1_phase(p, l, lds_all);
  else if (J == 6) rows_ln(p, l);
  else if (J == 7) f3_phase(p, l, lds_all);
  else if (J == 8) rows_ple(p, l);
  else phase_prep(p, ldsb);
}

#if MULTI_LAUNCH
template <int J>
__global__ void __launch_bounds__(256, 2) phk(Params p, int l) {
  __shared__ __attribute__((aligned(16))) unsigned char ldsb[LDS_BYTES];
  run_phase<J>(p, l, ldsb);
}
#else
__global__ void __launch_bounds__(512, 2) mega(Params p_unused, int ph0, int ph1) {
  __shared__ __attribute__((aligned(16))) unsigned char lds_all[LDS_BYTES];
  unsigned char* ldsb = lds_all + half_() * LDS_HALF;
  cg::grid_group grid = cg::this_grid();
  for (int ph = ph0; ph < ph1; ++ph) {
    const __attribute__((address_space(4))) Params* pp = (const __attribute__((address_space(4))) Params*)__builtin_amdgcn_kernarg_segment_ptr();
    asm volatile("" : "+s"(pp));
    PREF p = *pp;
    if (ph == ph0 + 1) grid.sync();
    else if (ph > ph0) grid_barrier(p.bar, (unsigned)(ph - ph0 - 1));
    if (ph == 0) { run_phase<9>(p, 0, ldsb, lds_all); continue; }
    int l = (ph - 1) / NPH_LAYER; const int j = (ph - 1) % NPH_LAYER;
    asm volatile("" : "+s"(l));
    if (j == 0) run_phase<0>(p, l, ldsb, lds_all);
    else if (j == 1) run_phase<1>(p, l, ldsb, lds_all);
    else if (j == 2) run_phase<2>(p, l, ldsb, lds_all);
    else if (j == 3) run_phase<3>(p, l, ldsb, lds_all);
    else if (j == 4) run_phase<4>(p, l, ldsb, lds_all);
    else if (j == 5) run_phase<5>(p, l, ldsb, lds_all);
    else if (j == 6) run_phase<6>(p, l, ldsb, lds_all);
    else if (j == 7) run_phase<7>(p, l, ldsb, lds_all);
    else run_phase<8>(p, l, ldsb, lds_all);
  }
}
#endif

extern "C" void kernel_launch(void* const* d_in, const int* in_sizes, int n_in, void* d_out, int out_size, void* d_ws,
                              size_t ws_size, hipStream_t stream) {
  static int grid_blocks = 0;
  if (!grid_blocks) {
    int dev = 0, cus = 0, per_cu = 2;
    (void)hipGetDevice(&dev);
    (void)hipDeviceGetAttribute(&cus, hipDeviceAttributeMultiprocessorCount, dev);
#if !MULTI_LAUNCH
    (void)hipOccupancyMaxActiveBlocksPerMultiprocessor(&per_cu, mega, 512, 0);
    per_cu = 1;
#endif
    if (cus < 1) cus = 256;
    grid_blocks = cus * per_cu;
  }
  Params p{};
  const float** f = (const float**)&p;
  for (int i = 0; i < 31; ++i) f[i] = (const float*)d_in[i];
  p.out = (float*)d_out;
  unsigned char* ws = (unsigned char*)d_ws;
  size_t off = 0;
  auto take = [&](size_t bytes) { unsigned char* r = ws + off; off += (bytes + 255) & ~(size_t)255; return r; };
  p.wts = (u16*)take(WL * NL * 2);
  p.lam = (float*)take((size_t)NL * 16 * 64 * 2 * 4);
  p.bbre = (float*)take((size_t)NL * 16 * 64 * 16 * 4);
  p.bbim = (float*)take((size_t)NL * 16 * 64 * 16 * 4);
  p.rcos = (float*)take((size_t)S_ * 16 * 4);
  p.rsin = (float*)take((size_t)S_ * 16 * 4);
  p.X = (u16*)take((size_t)T_ * 1024 * 2);
  p.pb = (u16*)take((size_t)T_ * 256 * 2);
  p.hb = (u16*)take((size_t)T_ * HW * 2);
  p.ys = (u16*)take((size_t)T_ * 1024 * 2);
  p.cA = (u16*)take((size_t)T_ * 256 * 2);
  p.Qm = (u16*)take((size_t)T_ * 384 * 2);
  p.Km = (u16*)take((size_t)T_ * 384 * 2);
  p.Vmt = (u16*)take((size_t)T_ * 256 * 2);
  p.Vst = (u16*)take((size_t)T_ * 128 * 2);
  p.yss = (u16*)take((size_t)T_ * 256 * 2);
  p.hend = (float*)take((size_t)8 * 16 * 64 * 64 * 2 * 4);
  p.bar = (unsigned*)take(16384);
  p.mg = p.cA;
  p.fbuf = (float*)p.hb;
  if (off > ws_size) fprintf(stderr, "workspace too small: need %zu have %zu\n", off, ws_size);
  const int NPH = 1 + NPH_LAYER * NL;
#if MULTI_LAUNCH
  (void)NPH;
  const dim3 g(grid_blocks), b(256);
  hipLaunchKernelGGL(phk<9>, g, b, 0, stream, p, 0);
  for (int l = 0; l < NL; ++l) {
    hipLaunchKernelGGL(phk<0>, g, b, 0, stream, p, l);
    hipLaunchKernelGGL(phk<1>, g, b, 0, stream, p, l);
    hipLaunchKernelGGL(phk<2>, g, b, 0, stream, p, l);
    hipLaunchKernelGGL(phk<3>, g, b, 0, stream, p, l);
    hipLaunchKernelGGL(phk<4>, g, b, 0, stream, p, l);
    hipLaunchKernelGGL(phk<5>, g, b, 0, stream, p, l);
    hipLaunchKernelGGL(phk<6>, g, b, 0, stream, p, l);
    hipLaunchKernelGGL(phk<7>, g, b, 0, stream, p, l);
    hipLaunchKernelGGL(phk<8>, g, b, 0, stream, p, l);
  }
#else
  int ph0 = 0, ph1 = NPH;
  (void)hipMemsetAsync(p.bar, 0, 16384, stream);
  void* args[] = {&p, &ph0, &ph1};
  hipError_t e = hipLaunchCooperativeKernel((void*)mega, dim3(grid_blocks), dim3(512), args, 0, stream);
  if (e != hipSuccess) fprintf(stderr, "cooperative launch failed: %s (grid %d)\n", hipGetErrorString(e), grid_blocks);
#endif
}
```

```cpp
#include <hip/hip_runtime.h>
#include <hip/hip_cooperative_groups.h>
#include <cstdio>
#include <type_traits>
namespace cg = cooperative_groups;

#ifndef MULTI_LAUNCH
#define MULTI_LAUNCH 0
#endif

typedef unsigned short u16;
typedef __attribute__((ext_vector_type(8))) short bf16x8;
typedef __attribute__((ext_vector_type(4))) float f32x4;
typedef __attribute__((ext_vector_type(16))) float f32x16;
typedef __attribute__((ext_vector_type(4))) unsigned u32x4;
typedef __attribute__((ext_vector_type(2))) unsigned u32x2;
#define DI __device__ __forceinline__
DI int tidx() { int t = threadIdx.x & 255; asm volatile("" : "+v"(t)); return t; }
DI int half_() { return __builtin_amdgcn_readfirstlane((int)(threadIdx.x >> 8)); }
DI int vbid() { return (int)blockIdx.x * 2 + half_(); }
DI int vgrid() { return (int)gridDim.x * 2; }

constexpr int T_ = 32768, S_ = 4096, D_ = 1024, HW = 2720, NL = 4;
constexpr int OFF_AVAL = 0, OFF_AGATE = 256, OFF_AZ = 512, OFF_CQ = 768, OFF_CKV = 1024, OFF_KR = 1152, OFF_BZ = 1184,
              OFF_U = 1440, OFF_CZ = 1696, OFF_SQ = 1952, OFF_SK = 2208, OFF_SV = 2336, OFF_DZ = 2464;
constexpr size_t O_WIN = 0, O_WM = O_WIN + 2816 * 1024, O_PW2 = O_WM + 4096 * 1024, O_UQ = O_PW2 + 65536, O_UKV = O_UQ + 98304,
                 O_GLU = O_UKV + 65536, O_BR = O_GLU + 131072, O_OUT = O_BR + 1048576, O_PLE = O_OUT + 1048576,
                 O_PLEG = O_PLE + 262144, WL = O_PLEG + 1048576;
constexpr int LDT = 64;
constexpr int TILE_E = 128 * LDT;
constexpr int CST = 132;
constexpr int LDS_MAIN = 73728;
constexpr int LDS_HALF = LDS_MAIN + 1024;
constexpr int LDS_BYTES = 2 * LDS_HALF;
constexpr float LOG2E = 1.4426950408889634f;
constexpr int NPH_LAYER = 9;

struct Params {
  const float *x, *p, *w_in, *w_merge, *b_merge, *conv_w, *conv_b, *conv_ng, *conv_nb, *w_pw2, *qng, *kvng, *w_uq, *w_ukv,
      *a_re, *a_im, *log_dt, *b_re, *b_im, *c_re, *c_im, *ssm_d, *w_glu, *sinks, *w_branch, *w_out, *ln_g, *ln_b, *w_ple,
      *w_pleg, *ple_ng;
  float* out;
  u16* wts;
  float *lam, *bbre, *bbim, *rcos, *rsin;
  u16 *X, *pb, *hb, *ys, *cA, *Qm, *Km, *Vmt, *Vst, *yss, *mg;
  float *hend, *fbuf;
  unsigned* bar;
};

typedef const __attribute__((address_space(4))) Params& PREF;

DI unsigned pack2(float a, float b) { unsigned r; asm("v_cvt_pk_bf16_f32 %0, %1, %2\n\ts_nop 1" : "=v"(r) : "v"(a), "v"(b)); return r; }
DI u16 f2bf(float x) { return (u16)(pack2(x, x) & 0xffffu); }
DI float bf2f(u16 v) { return __uint_as_float(((unsigned)v) << 16); }
DI float lo2f(unsigned u) { return __uint_as_float(u << 16); }
DI float hi2f(unsigned u) { return __uint_as_float(u & 0xffff0000u); }
DI float sigm(float x) { return 1.f / (1.f + __expf(-x)); }
DI float silu(float x) { return x / (1.f + __expf(-x)); }
DI float gelu_t(float x) { float u = 0.7978845608028654f * (x + 0.044715f * x * x * x); return 0.5f * x * (1.f + tanhf(u)); }
DI void unpack8(u32x4 v, float* f) {
  f[0] = lo2f(v.x); f[1] = hi2f(v.x); f[2] = lo2f(v.y); f[3] = hi2f(v.y);
  f[4] = lo2f(v.z); f[5] = hi2f(v.z); f[6] = lo2f(v.w); f[7] = hi2f(v.w);
}
DI u32x4 pack8(const float* f) { u32x4 o; o.x = pack2(f[0], f[1]); o.y = pack2(f[2], f[3]); o.z = pack2(f[4], f[5]); o.w = pack2(f[6], f[7]); return o; }
DI float wsum(float v) {
#pragma unroll
  for (int o = 32; o >= 1; o >>= 1) v += __shfl_xor(v, o);
  return v;
}
#define MFMA32(a, b, c) __builtin_amdgcn_mfma_f32_32x32x16_bf16((a), (b), (c), 0, 0, 0)
#define MFMA16(a, b, c) __builtin_amdgcn_mfma_f32_16x16x32_bf16((a), (b), (c), 0, 0, 0)

DI void zero_acc(f32x4 (&a)[4][4]) {
#pragma unroll
  for (int i = 0; i < 4; ++i)
#pragma unroll
    for (int j = 0; j < 4; ++j)
#pragma unroll
      for (int k = 0; k < 4; ++k) a[i][j][k] = 0.f;
}

#define GM_LOAD(RA, RB, KT)                                                                 \
  _Pragma("unroll") for (int i = 0; i < 4; ++i) {                                           \
    RA[i] = *(const u32x4*)(ag + (size_t)(32 * i) * lda + (KT) * 64);                       \
    RB[i] = *(const u32x4*)(bg + (size_t)(32 * i) * ldb + (KT) * 64);                       \
  }
#define GM_STORE(RA, RB, STG)                                                               \
  {                                                                                         \
    u16* dA_ = lds + (STG) * 2 * TILE_E;                                                    \
    _Pragma("unroll") for (int i = 0; i < 4; ++i) {                                         \
      *(u32x4*)(dA_ + (lrow + 32 * i) * LDT + lsw) = RA[i];                                 \
      *(u32x4*)(dA_ + TILE_E + (lrow + 32 * i) * LDT + lsw) = RB[i];                        \
    }                                                                                       \
  }
#define GM_COMPUTE(STG)                                                                     \
  {                                                                                         \
    const u16* sA = lds + (STG) * 2 * TILE_E + (wm * 64 + fr) * LDT;                        \
    const u16* sB = lds + (STG) * 2 * TILE_E + TILE_E + (wn * 64 + fr) * LDT;               \
    __builtin_amdgcn_s_setprio(1);                                                          \
    _Pragma("unroll") for (int kk = 0; kk < 2; ++kk) {                                      \
      const int co = (((kk * 4 + fq) ^ (fr & 7)) * 8);                                      \
      bf16x8 af[4];                                                                         \
      _Pragma("unroll") for (int m = 0; m < 4; ++m) af[m] = *(const bf16x8*)(sA + m * 16 * LDT + co);   \
      _Pragma("unroll") for (int n = 0; n < 4; ++n) {                                       \
        const bf16x8 bfr = *(const bf16x8*)(sB + n * 16 * LDT + co);                        \
        _Pragma("unroll") for (int m = 0; m < 4; ++m) acc[m][n] = MFMA16(af[m], bfr, acc[m][n]);        \
      }                                                                                     \
    }                                                                                       \
    __builtin_amdgcn_s_setprio(0);                                                          \
  }
template <bool DEEP = true>
DI void gemm_main(f32x4 (&acc)[4][4], const u16* __restrict__ A, int lda, const u16* __restrict__ B, int ldb, int K, u16* lds) {
  const int tid = tidx(), lane = tid & 63, w = tid >> 6;
  const int wm = w >> 1, wn = w & 1, fr = lane & 15, fq = lane >> 4;
  const int lrow = tid >> 3, lch = (tid & 7) * 8, lsw = ((tid & 7) ^ (lrow & 7)) * 8;
  const u16* ag = A + (size_t)lrow * lda + lch;
  const u16* bg = B + (size_t)lrow * ldb + lch;
  const int nk = K >> 6;
  if (DEEP) {
    u32x4 ra0[4], rb0[4], ra1[4], rb1[4];
    GM_LOAD(ra0, rb0, 0)
    GM_LOAD(ra1, rb1, 1)
    __syncthreads();
    GM_STORE(ra0, rb0, 0)
    __syncthreads();
    for (int kt = 0; kt < nk; kt += 2) {
      if (kt + 2 < nk) { GM_LOAD(ra0, rb0, kt + 2) }
      GM_COMPUTE(0)
      __builtin_amdgcn_sched_barrier(0);
      GM_STORE(ra1, rb1, 1)
      __syncthreads();
      if (kt + 3 < nk) { GM_LOAD(ra1, rb1, kt + 3) }
      GM_COMPUTE(1)
      __builtin_amdgcn_sched_barrier(0);
      if (kt + 2 < nk) { GM_STORE(ra0, rb0, 0) }
      __syncthreads();
    }
  } else {
    u32x4 ra0[4], rb0[4];
    GM_LOAD(ra0, rb0, 0)
    __syncthreads();
    GM_STORE(ra0, rb0, 0)
    __syncthreads();
    for (int kt = 0; kt < nk; kt += 2) {
      GM_LOAD(ra0, rb0, kt + 1)
      GM_COMPUTE(0)
      __builtin_amdgcn_sched_barrier(0);
      GM_STORE(ra0, rb0, 1)
      __syncthreads();
      if (kt + 2 < nk) { GM_LOAD(ra0, rb0, kt + 2) }
      GM_COMPUTE(1)
      __builtin_amdgcn_sched_barrier(0);
      if (kt + 2 < nk) { GM_STORE(ra0, rb0, 0) }
      __syncthreads();
    }
  }
}

DI void stage_c(const f32x4 (&acc)[4][4], float* Cs) {
  const int tid = tidx(), lane = tid & 63, w = tid >> 6;
  const int wm = w >> 1, wn = w & 1, fr = lane & 15, fq = lane >> 4;
#pragma unroll
  for (int m = 0; m < 4; ++m)
#pragma unroll
    for (int n = 0; n < 4; ++n)
#pragma unroll
      for (int j = 0; j < 4; ++j) Cs[(wm * 64 + m * 16 + fq * 4 + j) * CST + wn * 64 + n * 16 + fr] = acc[m][n][j];
  __syncthreads();
}
DI void ld8(const float* Cs, float* v) {
  float4 a = *(const float4*)Cs, b = *(const float4*)(Cs + 4);
  v[0] = a.x; v[1] = a.y; v[2] = a.z; v[3] = a.w; v[4] = b.x; v[5] = b.y; v[6] = b.z; v[7] = b.w;
}

DI void prep_w(const float* __restrict__ src, int K, int N, u16* __restrict__ dst, int Npad, const float* __restrict__ g, int perm,
               u16* T) {
  const int tid = tidx();
  const int ntn = Npad >> 6, ntiles = (K >> 6) * ntn;
  for (int it = vbid(); it < ntiles; it += vgrid()) {
    const int kt = it / ntn, k0 = kt * 64, n0 = (it - kt * ntn) * 64;
    int sn0 = n0;
    if (perm) { int tl = n0 >> 7, rr = n0 & 127; sn0 = (rr < 64) ? (tl * 64 + rr) : (256 + tl * 64 + rr - 64); }
    __syncthreads();
    {
      const int nn = tid & 63, kq = tid >> 6;
      const bool valid = (n0 + nn) < N;
      float v[16];
#pragma unroll
      for (int i = 0; i < 16; ++i) v[i] = valid ? src[(size_t)(k0 + kq + 4 * i) * N + sn0 + nn] : 0.f;
      if (g) {
#pragma unroll
        for (int i = 0; i < 16; ++i) v[i] *= g[k0 + kq + 4 * i];
      }
#pragma unroll
      for (int i = 0; i < 16; ++i) T[(kq + 4 * i) * 72 + nn] = f2bf(v[i]);
    }
    __syncthreads();
    {
      const int nn = tid >> 2, kc = (tid & 3) * 16;
      unsigned w[8];
#pragma unroll
      for (int j = 0; j < 8; ++j) w[j] = (unsigned)T[(kc + 2 * j) * 72 + nn] | ((unsigned)T[(kc + 2 * j + 1) * 72 + nn] << 16);
      u32x4 o0 = {w[0], w[1], w[2], w[3]}, o1 = {w[4], w[5], w[6], w[7]};
      u16* d = dst + (size_t)(n0 + nn) * K + k0 + kc;
      *(u32x4*)d = o0; *(u32x4*)(d + 8) = o1;
    }
  }
}

DI void phase_prep(PREF p, unsigned char* ldsb) {
  u16* T = (u16*)ldsb;
  const int gtid = vbid() * 256 + tidx(), gsz = vgrid() * 256;
  for (int l = 0; l < NL; ++l) {
    u16* W = p.wts + (size_t)l * WL;
    prep_w(p.w_in + (size_t)l * 1024 * HW, 1024, HW, W + O_WIN, 2816, nullptr, 0, T);
    prep_w(p.w_merge + (size_t)l * 1024 * 4096, 1024, 4096, W + O_WM, 4096, nullptr, 0, T);
    prep_w(p.w_pw2 + (size_t)l * 65536, 256, 256, W + O_PW2, 256, nullptr, 0, T);
    prep_w(p.w_uq + (size_t)l * 256 * 384, 256, 384, W + O_UQ, 384, p.qng + l * 256, 0, T);
    prep_w(p.w_ukv + (size_t)l * 128 * 512, 128, 512, W + O_UKV, 512, p.kvng + l * 128, 0, T);
    prep_w(p.w_glu + (size_t)l * 256 * 512, 256, 512, W + O_GLU, 512, nullptr, 1, T);
    for (int nb = 0; nb < 4; ++nb)
      prep_w(p.w_branch + ((size_t)l * 4 + nb) * 256 * 1024, 256, 1024, W + O_BR + (size_t)nb * 1024 * 256, 1024, nullptr, 0, T);
    prep_w(p.w_out + (size_t)l * 1048576, 1024, 1024, W + O_OUT, 1024, nullptr, 0, T);
    prep_w(p.w_ple + (size_t)l * 262144, 256, 1024, W + O_PLE, 1024, nullptr, 0, T);
    prep_w(p.w_pleg + (size_t)l * 1048576, 1024, 1024, W + O_PLEG, 1024, nullptr, 0, T);
  }
  for (int idx = gtid; idx < NL * 16 * 64; idx += gsz) {
    int lg = idx >> 6;
    float dt = expf(p.log_dt[lg]);
    float lr = p.a_re[idx], li = p.a_im[idx];
    float mag = expf(lr * dt);
    float lbr = mag * cosf(li * dt), lbi = mag * sinf(li * dt);
    float den = lr * lr + li * li;
    float nr = lbr - 1.f, ni = lbi;
    float fre = (nr * lr + ni * li) / den, fim = (ni * lr - nr * li) / den;
    p.lam[idx * 2] = lbr; p.lam[idx * 2 + 1] = lbi;
    for (int h = 0; h < 16; ++h) {
      float br = p.b_re[(size_t)idx * 16 + h], bi = p.b_im[(size_t)idx * 16 + h];
      p.bbre[(size_t)idx * 16 + h] = fre * br - fim * bi;
      p.bbim[(size_t)idx * 16 + h] = fre * bi + fim * br;
    }
  }
  for (int idx = gtid; idx < S_ * 16; idx += gsz) {
    int pos = idx >> 4, i = idx & 15;
    float inv = powf(10000.f, -(float)(2 * i) / 32.f);
    float ang = (float)pos * inv;
    p.rcos[idx] = cosf(ang); p.rsin[idx] = sinf(ang);
  }
  for (int idx = gtid; idx < T_ * D_ / 8; idx += gsz) {
    const float4* s = (const float4*)(p.x + (size_t)idx * 8);
    float4 a = s[0], b = s[1];
    float v[8] = {a.x, a.y, a.z, a.w, b.x, b.y, b.z, b.w};
    *(u32x4*)(p.X + (size_t)idx * 8) = pack8(v);
  }
}

constexpr int G_HT = 128 * 64;
DI void lds_barrier() { asm volatile("s_waitcnt lgkmcnt(0)\n\ts_barrier" ::: "memory"); }
DI int tid512() { int t = threadIdx.x; asm volatile("" : "+v"(t)); return t; }
DI void g_stage_rc(int b, int& R, int& C) {
  int st = b >> 10, sb = b & 1023, swz = sb ^ (((sb >> 9) & 1) << 5);
  R = (st >> 1) * 16 + (swz >> 6); C = (st & 1) * 32 + ((swz & 63) >> 1);
}
#define G_SA(b, h) (shm + ((b) * 2 + (h)) * G_HT)
#define G_SB(b, h) (shm + (4 + (b) * 2 + (h)) * G_HT)
#define G_STAGE(P, BASE, O0, O1, LD, br, KOFF)                                                                             \
  do {                                                                                                                    \
    const u16* g_ = (BASE) + (size_t)(br) * (LD) + (KOFF);                                                              \
    __builtin_amdgcn_global_load_lds((const unsigned*)(g_ + (O0)), (unsigned*)((char*)(P) + t * 16), 16, 0, 0);          \
    __builtin_amdgcn_global_load_lds((const unsigned*)(g_ + (O1)), (unsigned*)((char*)(P) + t * 16 + 8192), 16, 0, 0);   \
  } while (0)
#define G_LDA(dst, b, h)                                                                                                  \
  _Pragma("unroll") for (int m = 0; m < 4; ++m) _Pragma("unroll") for (int k = 0; k < 2; ++k)                             \
      dst[m][k] = *(const bf16x8*)((const char*)G_SA(b, h) + ((wr * 4 + m) * 2 + k) * 1024 + rdo)
#define G_LDB(dst, b, h)                                                                                                  \
  _Pragma("unroll") for (int n = 0; n < 2; ++n) _Pragma("unroll") for (int k = 0; k < 2; ++k)                             \
      dst[n][k] = *(const bf16x8*)((const char*)G_SB(b, h) + ((wc * 2 + n) * 2 + k) * 1024 + rdo)
#define G_MMA(ai, bj, At, Bt)                                                                                             \
  do {                                                                                                                    \
    __builtin_amdgcn_s_setprio(1);                                                                                        \
    _Pragma("unroll") for (int m = 0; m < 4; ++m) _Pragma("unroll") for (int n = 0; n < 2; ++n)                           \
        _Pragma("unroll") for (int k = 0; k < 2; ++k) acc[ai][bj][m][n] = MFMA16(At[m][k], Bt[n][k], acc[ai][bj][m][n]);  \
    __builtin_amdgcn_s_setprio(0);                                                                                        \
  } while (0)
#define G_WAIT_V(n) asm volatile("s_waitcnt vmcnt(" #n ")" ::: "memory")
#define G_WAIT_L(n) asm volatile("s_waitcnt lgkmcnt(" #n ")" ::: "memory")
#define G_BAR __builtin_amdgcn_s_barrier()
#define G_SCHED __builtin_amdgcn_sched_barrier(0)

DI void br_flush(PREF p, f32x4 (&acc)[2][2][4][2], int slot);
template <int LDA, int LDB, int K, int MODE = 0>
DI void gemm256(f32x4 (&acc)[2][2][4][2], const u16* __restrict__ A, const u16* __restrict__ B, u16* shm, PREF p) {
#define KA(kt) ((kt) * 64)
#define KB(kt) (MODE ? (((kt) >> 2) * (1024 * LDB) + ((kt) & 3) * 64) : (kt) * 64)
  const int t = tid512();
  const int wid = t >> 6, lane = t & 63, wr = wid >> 2, wc = wid & 3, fr = lane & 15, fq = lane >> 4;
  int r0, c0, r1, c1;
  g_stage_rc(t * 16, r0, c0); g_stage_rc(t * 16 + 8192, r1, c1);
  const int oa0 = r0 * LDA + c0, oa1 = r1 * LDA + c1, ob0 = r0 * LDB + c0, ob1 = r1 * LDB + c1;
  const int obr = fr * 64 + fq * 16, rdo = obr ^ (((obr >> 9) & 1) << 5);
  bf16x8 At[4][2], B0[2][2], B1[2][2];
  constexpr int nt = K / 64;
  lds_barrier();
  G_STAGE(G_SB(0, 0), B, ob0, ob1, LDB, 0, KB(0)); G_STAGE(G_SA(0, 0), A, oa0, oa1, LDA, 0, KA(0));
  G_STAGE(G_SB(0, 1), B, ob0, ob1, LDB, 128, KB(0)); G_STAGE(G_SA(0, 1), A, oa0, oa1, LDA, 128, KA(0));
  if (wr == 1) G_BAR;
  G_WAIT_V(4); G_BAR;
  G_STAGE(G_SB(1, 0), B, ob0, ob1, LDB, 0, KB(1)); G_STAGE(G_SA(1, 0), A, oa0, oa1, LDA, 0, KA(1)); G_STAGE(G_SB(1, 1), B, ob0, ob1, LDB, 128, KB(1));
  G_WAIT_V(6); G_BAR;
  for (int tt = 0; tt < nt - 2; tt += 2) {
    G_LDB(B0, 0, 0); G_SCHED; G_LDA(At, 0, 0); G_STAGE(G_SA(1, 1), A, oa0, oa1, LDA, 128, KA(tt + 1));
    G_WAIT_L(8); G_BAR; G_WAIT_L(0); G_MMA(0, 0, At, B0); G_BAR; G_SCHED;
    G_LDB(B1, 0, 1); G_STAGE(G_SB(0, 0), B, ob0, ob1, LDB, 0, KB(tt + 2));
    G_BAR; G_WAIT_L(0); G_MMA(0, 1, At, B1); G_BAR;
    G_LDA(At, 0, 1); G_STAGE(G_SA(0, 0), A, oa0, oa1, LDA, 0, KA(tt + 2));
    G_BAR; G_WAIT_L(0); G_MMA(1, 0, At, B0); G_BAR; G_SCHED;
    G_STAGE(G_SB(0, 1), B, ob0, ob1, LDB, 128, KB(tt + 2));
    G_WAIT_V(6); G_BAR; G_MMA(1, 1, At, B1); G_BAR;
    G_LDB(B0, 1, 0); G_SCHED; G_LDA(At, 1, 0); G_STAGE(G_SA(0, 1), A, oa0, oa1, LDA, 128, KA(tt + 2));
    G_WAIT_L(8); G_BAR; G_WAIT_L(0); G_MMA(0, 0, At, B0); G_BAR; G_SCHED;
    G_LDB(B1, 1, 1); G_STAGE(G_SB(1, 0), B, ob0, ob1, LDB, 0, KB(tt + 3));
    G_BAR; G_WAIT_L(0); G_MMA(0, 1, At, B1); G_BAR;
    G_LDA(At, 1, 1); G_STAGE(G_SA(1, 0), A, oa0, oa1, LDA, 0, KA(tt + 3));
    G_BAR; G_WAIT_L(0); G_MMA(1, 0, At, B0); G_BAR; G_SCHED;
    G_STAGE(G_SB(1, 1), B, ob0, ob1, LDB, 128, KB(tt + 3));
    G_WAIT_V(6); G_BAR; G_MMA(1, 1, At, B1); G_BAR;
    if (MODE && ((tt + 1) & 3) == 3) br_flush(p, acc, (tt + 1) >> 2);
  }
  {
    G_LDB(B0, 0, 0); G_LDA(At, 0, 0); G_STAGE(G_SA(1, 1), A, oa0, oa1, LDA, 128, KA(nt - 1));
    G_BAR; G_WAIT_L(0); G_MMA(0, 0, At, B0); G_BAR;
    G_LDB(B1, 0, 1); G_BAR; G_WAIT_L(0); G_MMA(0, 1, At, B1); G_BAR;
    G_LDA(At, 0, 1); G_WAIT_V(4); G_BAR; G_WAIT_L(0); G_MMA(1, 0, At, B0); G_MMA(1, 1, At, B1); G_BAR;
  }
  {
    G_LDB(B0, 1, 0); G_LDA(At, 1, 0); G_WAIT_V(2); G_BAR; G_WAIT_L(0); G_MMA(0, 0, At, B0); G_BAR;
    G_LDB(B1, 1, 1); G_WAIT_V(0); G_BAR; G_WAIT_L(0); G_MMA(0, 1, At, B1); G_BAR;
    G_LDA(At, 1, 1); G_BAR; G_WAIT_L(0); G_MMA(1, 0, At, B0); G_MMA(1, 1, At, B1); G_BAR;
  }
  if (wr == 0) G_BAR;
#undef KA
#undef KB
}
DI void zero_acc256(f32x4 (&a)[2][2][4][2]) {
#pragma unroll
  for (int i = 0; i < 2; ++i)
#pragma unroll
    for (int j = 0; j < 2; ++j)
#pragma unroll
      for (int m = 0; m < 4; ++m)
#pragma unroll
        for (int n = 0; n < 2; ++n)
#pragma unroll
          for (int e = 0; e < 4; ++e) a[i][j][m][n][e] = 0.f;
}
template <int AI, int BJ>
DI void stage_q(const f32x4 (&acc)[2][2][4][2], float* Cs) {
  const int t = tid512(), wid = t >> 6, lane = t & 63, wr = wid >> 2, wc = wid & 3, fr = lane & 15, fq = lane >> 4;
  lds_barrier();
#pragma unroll
  for (int m = 0; m < 4; ++m)
#pragma unroll
    for (int n = 0; n < 2; ++n)
#pragma unroll
      for (int j = 0; j < 4; ++j) Cs[(wr * 64 + m * 16 + fq * 4 + j) * CST + wc * 32 + n * 16 + fr] = acc[AI][BJ][m][n][j];
  lds_barrier();
}
DI bool xcd_tile256(int k, int NT, int& m, int& n) {
  const int x = blockIdx.x & 7, slots = gridDim.x >> 3;
  const int idx = (int)(blockIdx.x >> 3) + slots * k;
  if (idx >= 16 * NT) return false;
  const int mg = idx / (8 * NT), rem = idx - mg * 8 * NT;
  n = rem >> 3; m = x * 16 + mg * 8 + (rem & 7);
  return true;
}

DI bool xcd_tile(int k, int NT, int& m, int& n) {
  const int x = (vbid() >> 1) & 7, slots = vgrid() >> 3;
  const int idx = (((vbid() >> 4) << 1) | (vbid() & 1)) + slots * k;
  if (idx >= 32 * NT) return false;
  const int mg = idx / (8 * NT), rem = idx - mg * 8 * NT;
  n = rem >> 3; m = x * 32 + mg * 8 + (rem & 7);
  return true;
}

template <int AI, int BJ>
DI void in_quadrant(PREF p, const f32x4 (&acc)[2][2][4][2], int mt, int nt, float* Cs) {
  const int t = tid512();
  const int row0 = mt * 256 + AI * 128, col0 = nt * 256 + BJ * 128;
  if (col0 >= HW) return;
  stage_q<AI, BJ>(acc, Cs);
#pragma unroll
  for (int q = 0; q < 4; ++q) {
    int r = (t >> 4) + 32 * q, c = (t & 15) * 8;
    if (col0 + c < HW) {
      float v[8]; ld8(Cs + r * CST + c, v);
      *(u32x4*)(p.hb + (size_t)(row0 + r) * HW + col0 + c) = pack8(v);
    }
  }
  if (col0 + 128 > OFF_SV && col0 < OFF_SV + 128) {
    int b = row0 >> 12, s0 = row0 & 4095;
#pragma unroll
    for (int q = 0; q < 4; ++q) {
      int item = t + 512 * q; int c = item & 127, rg = item >> 7;
      int vc = col0 + c - OFF_SV;
      if (vc >= 0 && vc < 128) {
        float v[8];
#pragma unroll
        for (int j = 0; j < 8; ++j) v[j] = Cs[(rg * 8 + j) * CST + c];
        *(u32x4*)(p.Vst + ((size_t)(b * 2 + (vc >> 6)) * 64 + (vc & 63)) * S_ + s0 + rg * 8) = pack8(v);
      }
    }
  }
}
DI void phase_in(PREF p, int l, unsigned char* lds_all) {
  u16* shm = (u16*)lds_all; float* Cs = (float*)lds_all;
  const int tid = tidx();
  const u16* W = p.wts + (size_t)l * WL + O_WIN;
  for (int k = 0;; ++k) {
    int mt, nt;
    if (!xcd_tile256(k, 11, mt, nt)) break;
    f32x4 acc[2][2][4][2]; zero_acc256(acc);
    gemm256<1024, 1024, 1024>(acc, p.X + (size_t)mt * 256 * 1024, W + (size_t)nt * 256 * 1024, shm, p);
    in_quadrant<0, 0>(p, acc, mt, nt, Cs); in_quadrant<0, 1>(p, acc, mt, nt, Cs);
    in_quadrant<1, 0>(p, acc, mt, nt, Cs); in_quadrant<1, 1>(p, acc, mt, nt, Cs);
  }
  __syncthreads();
  const int gtid = vbid() * 256 + tid, gsz = vgrid() * 256;
  const float* ps = p.p + (size_t)l * T_ * 256;
  for (int idx = gtid; idx < T_ * 256 / 8; idx += gsz) {
    const float4* s = (const float4*)(ps + (size_t)idx * 8);
    float4 a = s[0], b = s[1];
    float v[8] = {a.x, a.y, a.z, a.w, b.x, b.y, b.z, b.w};
    *(u32x4*)(p.pb + (size_t)idx * 8) = pack8(v);
  }
}

template <int DQK, bool WIN>
DI void attn_item(const u16* __restrict__ Qb, int ldq, const u16* __restrict__ Kb, int ldk, const u16* __restrict__ Vtb, int qb,
                  float qscale, float sink2, const u16* __restrict__ zb, int ldz, u16* __restrict__ ob, int ldo, u16* lds) {
  constexpr int KST = DQK + 8, NKS = DQK / 16, KCH = DQK / 8;
  constexpr int KBUF = 64 * KST, VBUF = 64 * 72, STG = KBUF + VBUF;
  constexpr int NKL = (64 * KCH) / 256;
  const int tid = tidx(), lane = tid & 63, w = tid >> 6, r = lane & 31, hh = lane >> 5;
  const int q0 = qb * 128 + w * 32;
  const int qrow = q0 + r;
  bf16x8 qf[NKS];
#pragma unroll
  for (int s = 0; s < NKS; ++s) qf[s] = *(const bf16x8*)(Qb + (size_t)qrow * ldq + 16 * s + 8 * hh);
  const int kt_lo = WIN ? (qb > 0 ? 2 * qb - 2 : 0) : 0;
  const int kt_hi = 2 * qb + 1;
  f32x16 o[2];
#pragma unroll
  for (int i = 0; i < 16; ++i) { o[0][i] = 0.f; o[1][i] = 0.f; }
  float m = WIN ? sink2 : -1e30f;
  float lsum = (WIN && hh == 0) ? 1.f : 0.f;
  u32x4 rkA[NKL], rvA[2], rkB[NKL], rvB[2];
  auto gload = [&](u32x4 (&rk)[NKL], u32x4 (&rv)[2], int kt) {
#pragma unroll
    for (int i = 0; i < NKL; ++i) {
      int id = tid + 256 * i; int row = id / KCH, ch = id % KCH;
      rk[i] = *(const u32x4*)(Kb + (size_t)(kt * 64 + row) * ldk + ch * 8);
    }
#pragma unroll
    for (int i = 0; i < 2; ++i) {
      int id = tid + 256 * i; int row = id >> 3, ch = id & 7;
      rv[i] = *(const u32x4*)(Vtb + (size_t)row * S_ + kt * 64 + ch * 8);
    }
  };
  auto swrite = [&](const u32x4 (&rk)[NKL], const u32x4 (&rv)[2], int buf) {
    u16* ks = lds + buf * STG; u16* vs = ks + KBUF;
#pragma unroll
    for (int i = 0; i < NKL; ++i) {
      int id = tid + 256 * i; int row = id / KCH, ch = id % KCH;
      *(u32x4*)(ks + row * KST + ch * 8) = rk[i];
    }
#pragma unroll
    for (int i = 0; i < 2; ++i) {
      int id = tid + 256 * i; int row = id >> 3, ch = id & 7;
      *(u32x4*)(vs + row * 72 + ch * 8) = rv[i];
    }
  };
  auto tile_body = [&](int kt, int buf, auto mask_tag) {
    constexpr bool MASK = decltype(mask_tag)::value;
    const u16* ks = lds + buf * STG; const u16* vs = ks + KBUF;
    const int k0 = kt * 64;
    bool active = (k0 <= q0 + 31);
    if (WIN) active = active && (k0 + 63 >= q0 - 127);
    if (active) {
      f32x16 st[2];
#pragma unroll
      for (int kb = 0; kb < 2; ++kb) {
#pragma unroll
        for (int i = 0; i < 16; ++i) st[kb][i] = 0.f;
#pragma unroll
        for (int s = 0; s < NKS; ++s) {
          bf16x8 a = *(const bf16x8*)(ks + (kb * 32 + r) * KST + 16 * s + 8 * hh);
          st[kb] = MFMA32(a, qf[s], st[kb]);
        }
      }
      float mx = -INFINITY;
#pragma unroll
      for (int kb = 0; kb < 2; ++kb)
#pragma unroll
        for (int i = 0; i < 16; ++i) {
          float v = st[kb][i];
          if (MASK) {
            int kg = k0 + kb * 32 + (i & 3) + 8 * (i >> 2) + 4 * hh;
            bool ok = kg <= qrow;
            if (WIN) ok = ok && (qrow - kg < 128);
            v = ok ? v : -INFINITY;
            st[kb][i] = v;
          }
          mx = fmaxf(mx, v);
        }
      mx = fmaxf(mx, __shfl_xor(mx, 32));
      const float mn = fmaxf(m, mx);
      if (__any(mn != m)) {
        const float alpha = __builtin_amdgcn_exp2f((m - mn) * qscale);
        lsum *= alpha;
#pragma unroll
        for (int i = 0; i < 16; ++i) { o[0][i] *= alpha; o[1][i] *= alpha; }
      }
      m = mn;
      const float nb = -mn * qscale;
      float ps = 0.f;
#pragma unroll
      for (int kb = 0; kb < 2; ++kb)
#pragma unroll
        for (int i = 0; i < 16; ++i) { float pv = __builtin_amdgcn_exp2f(fmaf(st[kb][i], qscale, nb)); st[kb][i] = pv; ps += pv; }
      lsum += ps;
#pragma unroll
      for (int kb = 0; kb < 2; ++kb)
#pragma unroll
        for (int s2 = 0; s2 < 2; ++s2) {
          union { bf16x8 v; unsigned u[4]; } pf;
#pragma unroll
          for (int j = 0; j < 4; ++j) pf.u[j] = pack2(st[kb][8 * s2 + 2 * j], st[kb][8 * s2 + 2 * j + 1]);
          const int kbase = kb * 32 + 16 * s2 + 4 * hh;
#pragma unroll
          for (int vb = 0; vb < 2; ++vb) {
            union { bf16x8 v; u32x2 u[2]; } vf;
            vf.u[0] = *(const u32x2*)(vs + (vb * 32 + r) * 72 + kbase);
            vf.u[1] = *(const u32x2*)(vs + (vb * 32 + r) * 72 + kbase + 8);
            o[vb] = MFMA32(vf.v, pf.v, o[vb]);
          }
        }
    }
  };
  __syncthreads();
  gload(rkA, rvA, kt_lo);
  gload(rkB, rvB, kt_lo + 1);
  swrite(rkA, rvA, 0);
  __syncthreads();
  for (int kt = kt_lo; kt <= kt_hi; kt += 2) {
    if (kt + 2 <= kt_hi) gload(rkA, rvA, kt + 2);
    if (WIN || kt >= 2 * qb) tile_body(kt, 0, std::true_type{}); else tile_body(kt, 0, std::false_type{});
    swrite(rkB, rvB, 1);
    __syncthreads();
    if (kt + 3 <= kt_hi) gload(rkB, rvB, kt + 3);
    if (WIN || kt + 1 >= 2 * qb) tile_body(kt + 1, 1, std::true_type{}); else tile_body(kt + 1, 1, std::false_type{});
    if (kt + 2 <= kt_hi) swrite(rkA, rvA, 0);
    __syncthreads();
  }
  float lt = lsum + __shfl_xor(lsum, 32);
  float inv = 1.f / lt;
  u32x2 zr[8];
#pragma unroll
  for (int e = 0; e < 8; ++e) zr[e] = *(const u32x2*)(zb + (size_t)qrow * ldz + (e >> 2) * 32 + 8 * (e & 3) + 4 * hh);
#pragma unroll
  for (int vb = 0; vb < 2; ++vb)
#pragma unroll
    for (int g4 = 0; g4 < 4; ++g4) {
      int vd0 = vb * 32 + 8 * g4 + 4 * hh;
      u32x2 z = zr[vb * 4 + g4];
      float a0 = o[vb][4 * g4 + 0] * inv * silu(lo2f(z.x));
      float a1 = o[vb][4 * g4 + 1] * inv * silu(hi2f(z.x));
      float a2 = o[vb][4 * g4 + 2] * inv * silu(lo2f(z.y));
      float a3 = o[vb][4 * g4 + 3] * inv * silu(hi2f(z.y));
      u32x2 ov; ov.x = pack2(a0, a1); ov.y = pack2(a2, a3);
      *(u32x2*)(ob + (size_t)qrow * ldo + vd0) = ov;
    }
}

DI void conv_item(PREF p, int l, int tile, unsigned char* ldsb) {
  float* Gs = (float*)ldsb;
  const int tid = tidx(), lane = tid & 63, w = tid >> 6;
  const int t0 = tile * 32, s0 = t0 & 4095;
  __syncthreads();
  for (int id = tid; id < 62 * 32; id += 256) {
    int rr = id >> 5, ch = (id & 31) * 8;
    int s = s0 - 30 + rr;
    float v[8];
#pragma unroll
    for (int j = 0; j < 8; ++j) v[j] = 0.f;
    if (s >= 0) {
      const u16* src = p.hb + (size_t)(t0 - 30 + rr) * HW + ch;
      float a[8], g[8];
      unpack8(*(const u32x4*)(src + OFF_AVAL), a);
      unpack8(*(const u32x4*)(src + OFF_AGATE), g);
#pragma unroll
      for (int j = 0; j < 8; ++j) v[j] = a[j] * sigm(g[j]);
    }
    *(float4*)(Gs + rr * 256 + ch) = make_float4(v[0], v[1], v[2], v[3]);
    *(float4*)(Gs + rr * 256 + ch + 4) = make_float4(v[4], v[5], v[6], v[7]);
  }
  __syncthreads();
  {
    const int c = tid;
    float wv[31];
#pragma unroll
    for (int j = 0; j < 31; ++j) wv[j] = p.conv_w[((size_t)l * 31 + j) * 256 + c];
    const float bias = p.conv_b[l * 256 + c];
    for (int tt = 0; tt < 32; ++tt) {
      float acc = bias;
#pragma unroll
      for (int j = 0; j < 31; ++j) acc += wv[j] * Gs[(tt + j) * 256 + c];
      Gs[tt * 256 + c] = acc;
    }
  }
  __syncthreads();
  const float4 gg = *(const float4*)(p.conv_ng + l * 256 + lane * 4);
  const float4 bb = *(const float4*)(p.conv_nb + l * 256 + lane * 4);
  for (int q = 0; q < 8; ++q) {
    int tt = w * 8 + q;
    float4 v = *(const float4*)(Gs + tt * 256 + lane * 4);
    float mu = wsum(v.x + v.y + v.z + v.w) * (1.f / 256.f);
    float d0 = v.x - mu, d1 = v.y - mu, d2 = v.z - mu, d3 = v.w - mu;
    float var = wsum(d0 * d0 + d1 * d1 + d2 * d2 + d3 * d3) * (1.f / 256.f);
    float rs = rsqrtf(var + 1e-5f);
    float y0 = silu(d0 * rs * gg.x + bb.x), y1 = silu(d1 * rs * gg.y + bb.y);
    float y2 = silu(d2 * rs * gg.z + bb.z), y3 = silu(d3 * rs * gg.w + bb.w);
    u32x2 ov; ov.x = pack2(y0, y1); ov.y = pack2(y2, y3);
    *(u32x2*)(p.cA + (size_t)(t0 + tt) * 256 + lane * 4) = ov;
  }
}

DI void ssm_stage_u(PREF p, int b, int c, int gq, float* uS) {
  const int tid = tidx();
  int row = tid >> 2, cc = (tid & 3) * 16;
  const u16* src = p.hb + (size_t)(b * S_ + c * 64 + row) * HW + OFF_U + gq * 64 + cc;
  float f[16];
  unpack8(*(const u32x4*)src, f); unpack8(*(const u32x4*)(src + 8), f + 8);
#pragma unroll
  for (int j = 0; j < 4; ++j) *(float4*)(uS + row * 64 + cc + 4 * j) = make_float4(f[4 * j], f[4 * j + 1], f[4 * j + 2], f[4 * j + 3]);
}
#define SSM_STEP(t)                                                                                                        \
  {                                                                                                                        \
    const float4* up = (const float4*)(uS + (t) * 64 + w * 16);                                                            \
    float4 u0 = up[0], u1 = up[1], u2 = up[2], u3 = up[3];                                                                 \
    float uu[16] = {u0.x, u0.y, u0.z, u0.w, u1.x, u1.y, u1.z, u1.w, u2.x, u2.y, u2.z, u2.w, u3.x, u3.y, u3.z, u3.w};       \
    float bur = 0.f, bui = 0.f;                                                                                            \
    _Pragma("unroll") for (int j = 0; j < 16; ++j) { bur += bre[j] * uu[j]; bui += bim[j] * uu[j]; }                       \
    float nr = lr * hr - li * hi + bur, ni = lr * hi + li * hr + bui;                                                      \
    hr = nr; hi = ni;                                                                                                      \
  }

DI void ssm1_item(PREF p, int l, int item, unsigned char* ldsb) {
  const int gq = item & 3, c = (item >> 2) & 63, b = item >> 8;
  const int tid = tidx(), w = tid >> 6, lane = tid & 63;
  const int g = gq * 4 + w;
  float* uS = (float*)ldsb;
  __syncthreads();
  ssm_stage_u(p, b, c, gq, uS);
  __syncthreads();
  const size_t pi = (size_t)(l * 16 + g) * 64 + lane;
  float bre[16], bim[16];
#pragma unroll
  for (int j = 0; j < 16; ++j) { bre[j] = p.bbre[pi * 16 + j]; bim[j] = p.bbim[pi * 16 + j]; }
  const float lr = p.lam[pi * 2], li = p.lam[pi * 2 + 1];
  float hr = 0.f, hi = 0.f;
  for (int t = 0; t < 64; ++t) SSM_STEP(t)
  ((float2*)p.hend)[((size_t)(b * 16 + g) * 64 + c) * 64 + lane] = make_float2(hr, hi);
}

DI void ssm2_item(PREF p, int l, int item, unsigned char* ldsb) {
  const int gq = item & 3, c = (item >> 2) & 63, b = item >> 8;
  const int tid = tidx(), w = tid >> 6, lane = tid & 63;
  const int g = gq * 4 + w;
  float* uS = (float*)ldsb;
  u16* Hs = (u16*)(ldsb + 16384) + w * (16 * 136);
  __syncthreads();
  ssm_stage_u(p, b, c, gq, uS);
  __syncthreads();
  const size_t pi = (size_t)(l * 16 + g) * 64 + lane;
  float bre[16], bim[16];
#pragma unroll
  for (int j = 0; j < 16; ++j) { bre[j] = p.bbre[pi * 16 + j]; bim[j] = p.bbim[pi * 16 + j]; }
  const float lr = p.lam[pi * 2], li = p.lam[pi * 2 + 1];
  float pr = lr, pim = li;
#pragma unroll
  for (int q = 0; q < 6; ++q) { float a = pr * pr - pim * pim, bq = 2.f * pr * pim; pr = a; pim = bq; }
  float hr = 0.f, hi = 0.f;
  const float2* he = (const float2*)p.hend + ((size_t)(b * 16 + g) * 64) * 64 + lane;
  for (int cc = 0; cc < c; ++cc) {
    float2 e = he[(size_t)cc * 64];
    float nr = pr * hr - pim * hi + e.x, ni = pr * hi + pim * hr + e.y;
    hr = nr; hi = ni;
  }
  const int hcol = lane & 15, q4 = lane >> 4;
  bf16x8 cf[4];
  {
    const float* cre = p.c_re + ((size_t)(l * 16 + g) * 16 + hcol) * 64;
    const float* cim = p.c_im + ((size_t)(l * 16 + g) * 16 + hcol) * 64;
#pragma unroll
    for (int ks = 0; ks < 4; ++ks) {
      float v[8];
#pragma unroll
      for (int j = 0; j < 8; ++j) {
        int k = 32 * ks + 8 * q4 + j;
        v[j] = (ks < 2) ? cre[k] : -cim[k - 64];
      }
      union { bf16x8 v8; u32x4 u; } cv; cv.u = pack8(v); cf[ks] = cv.v8;
    }
  }
  const float dch = p.ssm_d[l * 256 + g * 16 + hcol];
  for (int sub = 0; sub < 4; ++sub) {
    for (int tt = 0; tt < 16; ++tt) {
      SSM_STEP(sub * 16 + tt)
      Hs[tt * 136 + lane] = f2bf(hr);
      Hs[tt * 136 + 64 + lane] = f2bf(hi);
    }
    __syncthreads();
    f32x4 acc = {0.f, 0.f, 0.f, 0.f};
#pragma unroll
    for (int ks = 0; ks < 4; ++ks) {
      bf16x8 a = *(const bf16x8*)(Hs + hcol * 136 + 32 * ks + 8 * q4);
      acc = MFMA16(a, cf[ks], acc);
    }
#pragma unroll
    for (int j = 0; j < 4; ++j) {
      int t = sub * 16 + 4 * q4 + j;
      float uu = uS[t * 64 + w * 16 + hcol];
      float yv = gelu_t(acc[j] + dch * uu);
      p.yss[(size_t)(b * S_ + c * 64 + t) * 256 + g * 16 + hcol] = f2bf(yv);
    }
    __syncthreads();
  }
}

DI void q_tile(PREF p, int l, int idx, unsigned char* ldsb) {
  u16* lds = (u16*)ldsb; float* Cs = (float*)ldsb; float* aux = (float*)(ldsb + LDS_MAIN);
  const int tid = tidx();
  const int mt = idx / 3, nt = idx % 3;
  const int row0 = mt * 128, col0 = nt * 128;
  __syncthreads();
  if (tid < 128) {
    const u16* src = p.hb + (size_t)(row0 + tid) * HW + OFF_CQ;
    float ss = 0.f;
    for (int i = 0; i < 32; ++i) { float f[8]; unpack8(*(const u32x4*)(src + i * 8), f);
#pragma unroll
      for (int j = 0; j < 8; ++j) ss += f[j] * f[j]; }
    aux[tid] = rsqrtf(ss * (1.f / 256.f) + 1e-6f);
  }
  f32x4 acc[4][4]; zero_acc(acc);
  gemm_main(acc, p.hb + (size_t)row0 * HW + OFF_CQ, HW, p.wts + (size_t)l * WL + O_UQ + (size_t)col0 * 256, 256, 256, lds);
  stage_c(acc, Cs);
#pragma unroll
  for (int q = 0; q < 8; ++q) {
    int r = (tid >> 4) + 16 * q, c = (tid & 15) * 8;
    int n = col0 + c; int dd = n % 96;
    float rs = aux[r];
    float v[8]; ld8(Cs + r * CST + c, v);
#pragma unroll
    for (int j = 0; j < 8; ++j) v[j] *= rs;
    if (dd >= 64) {
      int ri0 = dd - 64; int s = (row0 + r) & 4095;
      float pv[8];
      if (ri0 < 16) {
        ld8(Cs + r * CST + c + 16, pv);
        const float* cs = p.rcos + s * 16 + ri0; const float* sn = p.rsin + s * 16 + ri0;
#pragma unroll
        for (int j = 0; j < 8; ++j) v[j] = v[j] * cs[j] - pv[j] * rs * sn[j];
      } else {
        ld8(Cs + r * CST + c - 16, pv);
        const float* cs = p.rcos + s * 16 + ri0 - 16; const float* sn = p.rsin + s * 16 + ri0 - 16;
#pragma unroll
        for (int j = 0; j < 8; ++j) v[j] = v[j] * cs[j] + pv[j] * rs * sn[j];
      }
    }
    *(u32x4*)(p.Qm + (size_t)(row0 + r) * 384 + n) = pack8(v);
  }
}

DI void kv_tile(PREF p, int l, int idx, unsigned char* ldsb) {
  u16* lds = (u16*)ldsb; float* Cs = (float*)ldsb; float* aux = (float*)(ldsb + LDS_MAIN);
  const int tid = tidx();
  const int mt = idx >> 2, head = idx & 3;
  const int row0 = mt * 128;
  __syncthreads();
  if (tid < 128) {
    const u16* src = p.hb + (size_t)(row0 + tid) * HW + OFF_CKV;
    float ss = 0.f;
    for (int i = 0; i < 16; ++i) { float f[8]; unpack8(*(const u32x4*)(src + i * 8), f);
#pragma unroll
      for (int j = 0; j < 8; ++j) ss += f[j] * f[j]; }
    aux[tid] = rsqrtf(ss * (1.f / 128.f) + 1e-6f);
  }
  f32x4 acc[4][4]; zero_acc(acc);
  gemm_main(acc, p.hb + (size_t)row0 * HW + OFF_CKV, HW, p.wts + (size_t)l * WL + O_UKV + (size_t)head * 128 * 128, 128, 128, lds);
  stage_c(acc, Cs);
#pragma unroll
  for (int q = 0; q < 4; ++q) {
    int r = (tid >> 3) + 32 * q, c = (tid & 7) * 8;
    float rs = aux[r];
    float v[8]; ld8(Cs + r * CST + c, v);
#pragma unroll
    for (int j = 0; j < 8; ++j) v[j] *= rs;
    *(u32x4*)(p.Km + (size_t)(row0 + r) * 384 + head * 96 + c) = pack8(v);
  }
  {
    int b = row0 >> 12, s0 = row0 & 4095;
#pragma unroll
    for (int q = 0; q < 4; ++q) {
      int item = tid + 256 * q; int c = item & 63, rg = item >> 6;
      float v[8];
#pragma unroll
      for (int j = 0; j < 8; ++j) v[j] = Cs[(rg * 8 + j) * CST + 64 + c] * aux[rg * 8 + j];
      *(u32x4*)(p.Vmt + ((size_t)(b * 4 + head) * 64 + c) * S_ + s0 + rg * 8) = pack8(v);
    }
  }
  {
    int r = tid >> 1, half = tid & 1;
    int t = row0 + r, s = t & 4095;
    const u16* src = p.hb + (size_t)t * HW + OFF_KR;
    float x1[16], x2[16];
    unpack8(*(const u32x4*)(src), x1); unpack8(*(const u32x4*)(src + 8), x1 + 8);
    unpack8(*(const u32x4*)(src + 16), x2); unpack8(*(const u32x4*)(src + 24), x2 + 8);
    const float* cs = p.rcos + s * 16; const float* sn = p.rsin + s * 16;
    float ov[16];
#pragma unroll
    for (int i = 0; i < 16; ++i) ov[i] = half ? (x2[i] * cs[i] + x1[i] * sn[i]) : (x1[i] * cs[i] - x2[i] * sn[i]);
    u16* dst = p.Km + (size_t)t * 384 + head * 96 + 64 + half * 16;
    *(u32x4*)dst = pack8(ov); *(u32x4*)(dst + 8) = pack8(ov + 8);
  }
}

DI void pw2_tile(PREF p, int l, int idx, unsigned char* ldsb) {
  u16* lds = (u16*)ldsb; float* Cs = (float*)ldsb;
  const int tid = tidx();
  const int mt = idx >> 1, nt = idx & 1;
  const int row0 = mt * 128, col0 = nt * 128;
  f32x4 acc[4][4]; zero_acc(acc);
  gemm_main(acc, p.cA + (size_t)row0 * 256, 256, p.wts + (size_t)l * WL + O_PW2 + (size_t)col0 * 256, 256, 256, lds);
  stage_c(acc, Cs);
  u32x4 zr[8];
#pragma unroll
  for (int q = 0; q < 8; ++q) zr[q] = *(const u32x4*)(p.hb + (size_t)(row0 + (tid >> 4) + 16 * q) * HW + OFF_AZ + col0 + (tid & 15) * 8);
#pragma unroll
  for (int q = 0; q < 8; ++q) {
    int r = (tid >> 4) + 16 * q, c = (tid & 15) * 8;
    float v[8]; ld8(Cs + r * CST + c, v);
    float z[8]; unpack8(zr[q], z);
#pragma unroll
    for (int j = 0; j < 8; ++j) v[j] *= silu(z[j]);
    *(u32x4*)(p.ys + (size_t)(row0 + r) * 1024 + col0 + c) = pack8(v);
  }
}

DI void glu_tile(PREF p, int l, int idx, unsigned char* ldsb) {
  u16* lds = (u16*)ldsb; float* Cs = (float*)ldsb;
  const int tid = tidx();
  const int mt = idx >> 2, nt = idx & 3;
  const int row0 = mt * 128;
  f32x4 acc[4][4]; zero_acc(acc);
  gemm_main(acc, p.yss + (size_t)row0 * 256, 256, p.wts + (size_t)l * WL + O_GLU + (size_t)nt * 128 * 256, 256, 256, lds);
  stage_c(acc, Cs);
  u32x4 zr[4];
#pragma unroll
  for (int q = 0; q < 4; ++q) zr[q] = *(const u32x4*)(p.hb + (size_t)(row0 + (tid >> 3) + 32 * q) * HW + OFF_CZ + nt * 64 + (tid & 7) * 8);
#pragma unroll
  for (int q = 0; q < 4; ++q) {
    int r = (tid >> 3) + 32 * q, c = (tid & 7) * 8;
    float v[8], g[8]; ld8(Cs + r * CST + c, v); ld8(Cs + r * CST + 64 + c, g);
    float z[8]; unpack8(zr[q], z);
#pragma unroll
    for (int j = 0; j < 8; ++j) v[j] = v[j] * sigm(g[j]) * silu(z[j]);
    *(u32x4*)(p.ys + (size_t)(row0 + r) * 1024 + 512 + nt * 64 + c) = pack8(v);
  }
}

template <int AI, int BJ>
DI void glu_quadrant(PREF p, const f32x4 (&acc)[2][2][4][2], int mt, int nt, float* Cs) {
  const int t = tid512();
  const int row0 = mt * 256 + AI * 128, oc0 = (nt * 2 + BJ) * 64, c = (t & 7) * 8;
  u32x4 zr[2];
#pragma unroll
  for (int q = 0; q < 2; ++q) zr[q] = *(const u32x4*)(p.hb + (size_t)(row0 + (t >> 3) + 64 * q) * HW + OFF_CZ + oc0 + c);
  stage_q<AI, BJ>(acc, Cs);
#pragma unroll
  for (int q = 0; q < 2; ++q) {
    const int r = (t >> 3) + 64 * q;
    float v[8], g[8]; ld8(Cs + r * CST + c, v); ld8(Cs + r * CST + 64 + c, g);
    float z[8]; unpack8(zr[q], z);
#pragma unroll
    for (int j = 0; j < 8; ++j) v[j] = v[j] * sigm(g[j]) * silu(z[j]);
    *(u32x4*)(p.ys + (size_t)(row0 + r) * 1024 + 512 + oc0 + c) = pack8(v);
  }
}
DI void glu_phase(PREF p, int l, unsigned char* lds_all) {
  u16* shm = (u16*)lds_all; float* Cs = (float*)lds_all;
  for (int it = blockIdx.x; it < 256; it += gridDim.x) {
    const int mt = it >> 1, nt = it & 1;
    f32x4 acc[2][2][4][2]; zero_acc256(acc);
    gemm256<256, 256, 256>(acc, p.yss + (size_t)mt * 256 * 256, p.wts + (size_t)l * WL + O_GLU + (size_t)nt * 256 * 256, shm, p);
    glu_quadrant<0, 0>(p, acc, mt, nt, Cs); glu_quadrant<0, 1>(p, acc, mt, nt, Cs);
    glu_quadrant<1, 0>(p, acc, mt, nt, Cs); glu_quadrant<1, 1>(p, acc, mt, nt, Cs);
  }
  __syncthreads();
}

DI u32x4* merge_scratch(PREF p, int region) { const int t = tid512(); return (u32x4*)p.fbuf + (size_t)blockIdx.x * 40960 + region * 8192 + (t >> 6) * 1024 + (t & 63); }
DI void br_store(PREF p, const f32x4 (&acc)[2][2][4][2], int slot) {
  u32x4* sb = merge_scratch(p, slot);
#pragma unroll
  for (int ai = 0; ai < 2; ++ai)
#pragma unroll
    for (int bj = 0; bj < 2; ++bj)
#pragma unroll
      for (int m = 0; m < 4; ++m) {
        u32x4 o;
        o.x = pack2(acc[ai][bj][m][0][0], acc[ai][bj][m][0][1]); o.y = pack2(acc[ai][bj][m][0][2], acc[ai][bj][m][0][3]);
        o.z = pack2(acc[ai][bj][m][1][0], acc[ai][bj][m][1][1]); o.w = pack2(acc[ai][bj][m][1][2], acc[ai][bj][m][1][3]);
        sb[((ai * 2 + bj) * 4 + m) * 64] = o;
      }
}
DI void br_flush(PREF p, f32x4 (&acc)[2][2][4][2], int slot) { br_store(p, acc, slot); zero_acc256(acc); }
DI void gate_reg(PREF p, int l, int n, f32x4 (&acc)[2][2][4][2], int dt) {
  const u32x4* sbn = merge_scratch(p, n);
  u32x4* ssum = merge_scratch(p, 4);
  const int t = tid512(), wid = t >> 6, lane = t & 63, wc = wid & 3, fr = lane & 15;
  const float* bm = p.b_merge + (size_t)l * 4096 + n * 1024 + dt * 256 + wc * 32 + fr;
  float bias[2][2];
#pragma unroll
  for (int bj = 0; bj < 2; ++bj)
#pragma unroll
    for (int nn = 0; nn < 2; ++nn) bias[bj][nn] = bm[bj * 128 + nn * 16];
#pragma unroll
  for (int ai = 0; ai < 2; ++ai)
#pragma unroll
    for (int bj = 0; bj < 2; ++bj) {
      __builtin_amdgcn_sched_barrier(0);
      u32x4 bn[4], pv[4];
#pragma unroll
      for (int m = 0; m < 4; ++m) {
        bn[m] = sbn[((ai * 2 + bj) * 4 + m) * 64];
        if (n > 0) pv[m] = ssum[((ai * 2 + bj) * 4 + m) * 64];
      }
#pragma unroll
      for (int m = 0; m < 4; ++m) {
        float b[8]; unpack8(bn[m], b);
        float v[8];
#pragma unroll
        for (int nn = 0; nn < 2; ++nn)
#pragma unroll
          for (int j = 0; j < 4; ++j) v[nn * 4 + j] = sigm(acc[ai][bj][m][nn][j] + bias[bj][nn]) * b[nn * 4 + j];
        if (n > 0) {
          float o[8]; unpack8(pv[m], o);
#pragma unroll
          for (int e = 0; e < 8; ++e) v[e] += o[e];
        }
        if (n < 3) ssum[((ai * 2 + bj) * 4 + m) * 64] = pack8(v);
#pragma unroll
        for (int nn = 0; nn < 2; ++nn)
#pragma unroll
          for (int j = 0; j < 4; ++j) acc[ai][bj][m][nn][j] = v[nn * 4 + j];
      }
    }
}
template <int AI, int BJ>
DI void mg_quadrant(PREF p, const f32x4 (&acc)[2][2][4][2], int mt, int dt, float* Cs) {
  const int t = tid512();
  const int row0 = mt * 256 + AI * 128, col0 = dt * 256 + BJ * 128;
  stage_q<AI, BJ>(acc, Cs);
#pragma unroll
  for (int q = 0; q < 4; ++q) {
    int r = (t >> 4) + 32 * q, c = (t & 15) * 8;
    float v[8]; ld8(Cs + r * CST + c, v);
    *(u32x4*)(p.mg + (size_t)(row0 + r) * 1024 + col0 + c) = pack8(v);
  }
}
DI void merge_phase(PREF p, int l, unsigned char* lds_all) {
  u16* shm = (u16*)lds_all; float* Cs = (float*)lds_all;
  const u16* W = p.wts + (size_t)l * WL;
  for (int k = 0;; ++k) {
    int mt, dt;
    if (!xcd_tile256(k, 4, mt, dt)) break;
    {
      f32x4 acc[2][2][4][2]; zero_acc256(acc);
      gemm256<1024, 256, 1024, 1>(acc, p.ys + (size_t)mt * 256 * 1024, W + O_BR + (size_t)dt * 256 * 256, shm, p);
      br_store(p, acc, 3);
    }
#pragma unroll 1
    for (int n = 0; n < 4; ++n) {
      f32x4 acc[2][2][4][2]; zero_acc256(acc);
      gemm256<1024, 1024, 1024>(acc, p.X + (size_t)mt * 256 * 1024, W + O_WM + ((size_t)n * 1024 + dt * 256) * 1024, shm, p);
      gate_reg(p, l, n, acc, dt);
      if (n == 3) {
        mg_quadrant<0, 0>(p, acc, mt, dt, Cs); mg_quadrant<0, 1>(p, acc, mt, dt, Cs);
        mg_quadrant<1, 0>(p, acc, mt, dt, Cs); mg_quadrant<1, 1>(p, acc, mt, dt, Cs);
      }
    }
  }
  __syncthreads();
}

template <int AI, int BJ>
DI void f1_load(PREF p, int l, int mt, int dt, float4 (&xa)[4], float4 (&xb)[4]) {
  const int t = tid512();
  const int row0 = mt * 256 + AI * 128, col0 = dt * 256 + BJ * 128, c = (t & 15) * 8;
  if (l == 0) {
#pragma unroll
    for (int q = 0; q < 4; ++q) {
      const float4* xs = (const float4*)(p.x + (size_t)(row0 + (t >> 4) + 32 * q) * 1024 + col0 + c);
      xa[q] = xs[0]; xb[q] = xs[1];
    }
  } else {
#pragma unroll
    for (int q = 0; q < 4; ++q) {
      float f[8]; unpack8(*(const u32x4*)(p.X + (size_t)(row0 + (t >> 4) + 32 * q) * 1024 + col0 + c), f);
      xa[q] = make_float4(f[0], f[1], f[2], f[3]); xb[q] = make_float4(f[4], f[5], f[6], f[7]);
    }
  }
}
template <int AI, int BJ>
DI void f1_proc(PREF p, const f32x4 (&acc)[2][2][4][2], int mt, int dt, float* Cs, const float4 (&xa)[4], const float4 (&xb)[4]) {
  const int t = tid512();
  const int row0 = mt * 256 + AI * 128, col0 = dt * 256 + BJ * 128, c = (t & 15) * 8;
  const float alpha = 1.681792830507429f;
  stage_q<AI, BJ>(acc, Cs);
#pragma unroll
  for (int q = 0; q < 4; ++q) {
    int r = (t >> 4) + 32 * q;
    float v[8]; ld8(Cs + r * CST + c, v);
    float4 a = xa[q], b = xb[q];
    float y[8] = {alpha * a.x + v[0], alpha * a.y + v[1], alpha * a.z + v[2], alpha * a.w + v[3],
                  alpha * b.x + v[4], alpha * b.y + v[5], alpha * b.z + v[6], alpha * b.w + v[7]};
    *(u32x4*)((u16*)p.fbuf + (size_t)(row0 + r) * 1024 + col0 + c) = pack8(y);
  }
}
DI void f1_phase(PREF p, int l, unsigned char* lds_all) {
  u16* shm = (u16*)lds_all; float* Cs = (float*)lds_all;
  for (int k = 0;; ++k) {
    int mt, dt;
    if (!xcd_tile256(k, 4, mt, dt)) break;
    f32x4 acc[2][2][4][2]; zero_acc256(acc);
    gemm256<1024, 1024, 1024>(acc, p.mg + (size_t)mt * 256 * 1024, p.wts + (size_t)l * WL + O_OUT + (size_t)dt * 256 * 1024, shm, p);
    {
      float4 aA[4], bA[4];
      f1_load<0, 0>(p, l, mt, dt, aA, bA); f1_proc<0, 0>(p, acc, mt, dt, Cs, aA, bA);
      f1_load<0, 1>(p, l, mt, dt, aA, bA); f1_proc<0, 1>(p, acc, mt, dt, Cs, aA, bA);
      f1_load<1, 0>(p, l, mt, dt, aA, bA); f1_proc<1, 0>(p, acc, mt, dt, Cs, aA, bA);
      f1_load<1, 1>(p, l, mt, dt, aA, bA); f1_proc<1, 1>(p, acc, mt, dt, Cs, aA, bA);
    }
  }
  __syncthreads();
}

template <int AI, int BJ>
DI void f3_load(PREF p, int mt, int dt, u32x4 (&g)[4]) {
  const int t = tid512();
  const int row0 = mt * 256 + AI * 128, col0 = dt * 256 + BJ * 128, c = (t & 15) * 8;
#pragma unroll
  for (int q = 0; q < 4; ++q) g[q] = *(const u32x4*)((const u16*)p.fbuf + (size_t)(row0 + (t >> 4) + 32 * q) * 1024 + col0 + c);
}
template <int AI, int BJ, int PASS>
DI void f3_proc(PREF p, const f32x4 (&acc)[2][2][4][2], int mt, int dt, float* Cs, const u32x4 (&g)[4]) {
  const int t = tid512();
  const int row0 = mt * 256 + AI * 128, col0 = dt * 256 + BJ * 128;
  const int c = (t & 15) * 8;
  stage_q<AI, BJ>(acc, Cs);
#pragma unroll
  for (int q = 0; q < 4; ++q) {
    int r = (t >> 4) + 32 * q;
    float v[8]; ld8(Cs + r * CST + c, v);
    if (PASS == 0) {
#pragma unroll
      for (int j = 0; j < 8; ++j) v[j] = sigm(v[j]);
    } else {
      float gf[8]; unpack8(g[q], gf);
#pragma unroll
      for (int j = 0; j < 8; ++j) v[j] *= gf[j];
    }
    *(u32x4*)((u16*)p.fbuf + (size_t)(row0 + r) * 1024 + col0 + c) = pack8(v);
  }
}
DI void f3_phase(PREF p, int l, unsigned char* lds_all) {
  u16* shm = (u16*)lds_all; float* Cs = (float*)lds_all;
  const u16* W = p.wts + (size_t)l * WL;
  for (int k = 0;; ++k) {
    int mt, dt;
    if (!xcd_tile256(k, 4, mt, dt)) break;
    {
      f32x4 acc[2][2][4][2]; zero_acc256(acc);
      gemm256<1024, 1024, 1024>(acc, p.X + (size_t)mt * 256 * 1024, W + O_PLEG + (size_t)dt * 256 * 1024, shm, p);
      u32x4 gd[4];
      f3_proc<0, 0, 0>(p, acc, mt, dt, Cs, gd); f3_proc<0, 1, 0>(p, acc, mt, dt, Cs, gd);
      f3_proc<1, 0, 0>(p, acc, mt, dt, Cs, gd); f3_proc<1, 1, 0>(p, acc, mt, dt, Cs, gd);
    }
    f32x4 acc[2][2][4][2]; zero_acc256(acc);
    gemm256<256, 256, 256>(acc, p.pb + (size_t)mt * 256 * 256, W + O_PLE + (size_t)dt * 256 * 256, shm, p);
    {
      u32x4 gA[4], gB[4];
      f3_load<0, 0>(p, mt, dt, gA);
      f3_load<0, 1>(p, mt, dt, gB); f3_proc<0, 0, 1>(p, acc, mt, dt, Cs, gA);
      f3_load<1, 0>(p, mt, dt, gA); f3_proc<0, 1, 1>(p, acc, mt, dt, Cs, gB);
      f3_load<1, 1>(p, mt, dt, gB); f3_proc<1, 0, 1>(p, acc, mt, dt, Cs, gA);
      f3_proc<1, 1, 1>(p, acc, mt, dt, Cs, gB);
    }
  }
  __syncthreads();
}

DI void rows_ln(PREF p, int l) {
  const int tid = tidx(), lane = tid & 63, w = tid >> 6;
  float gg[16], bb[16];
#pragma unroll
  for (int h = 0; h < 2; ++h) {
    const int c = h * 512 + lane * 8;
    const float4 g0 = *(const float4*)(p.ln_g + l * 1024 + c), g1 = *(const float4*)(p.ln_g + l * 1024 + c + 4);
    const float4 b0 = *(const float4*)(p.ln_b + l * 1024 + c), b1 = *(const float4*)(p.ln_b + l * 1024 + c + 4);
    gg[h * 8 + 0] = g0.x; gg[h * 8 + 1] = g0.y; gg[h * 8 + 2] = g0.z; gg[h * 8 + 3] = g0.w;
    gg[h * 8 + 4] = g1.x; gg[h * 8 + 5] = g1.y; gg[h * 8 + 6] = g1.z; gg[h * 8 + 7] = g1.w;
    bb[h * 8 + 0] = b0.x; bb[h * 8 + 1] = b0.y; bb[h * 8 + 2] = b0.z; bb[h * 8 + 3] = b0.w;
    bb[h * 8 + 4] = b1.x; bb[h * 8 + 5] = b1.y; bb[h * 8 + 6] = b1.z; bb[h * 8 + 7] = b1.w;
  }
  for (int row = vbid() * 4 + w; row < T_ / 2; row += vgrid() * 4) {
    u32x4 raw[2][2];
#pragma unroll
    for (int k = 0; k < 2; ++k) {
      const u16* src = (const u16*)p.fbuf + (size_t)(row + k * (T_ / 2)) * 1024;
      raw[k][0] = *(const u32x4*)(src + lane * 8);
      raw[k][1] = *(const u32x4*)(src + 512 + lane * 8);
    }
#pragma unroll
    for (int k = 0; k < 2; ++k) {
      float v[16];
      unpack8(raw[k][0], v); unpack8(raw[k][1], v + 8);
      float s = 0.f;
#pragma unroll
      for (int i = 0; i < 16; ++i) s += v[i];
      const float mu = wsum(s) * (1.f / 1024.f);
      float sq = 0.f;
#pragma unroll
      for (int i = 0; i < 16; ++i) { v[i] -= mu; sq += v[i] * v[i]; }
      const float rs = rsqrtf(wsum(sq) * (1.f / 1024.f) + 1e-5f);
#pragma unroll
      for (int h = 0; h < 2; ++h) {
        float y[8];
#pragma unroll
        for (int j = 0; j < 8; ++j) y[j] = v[h * 8 + j] * rs * gg[h * 8 + j] + bb[h * 8 + j];
        *(u32x4*)(p.X + (size_t)(row + k * (T_ / 2)) * 1024 + h * 512 + lane * 8) = pack8(y);
      }
    }
  }
}

DI void rows_ple(PREF p, int l) {
  const int tid = tidx(), lane = tid & 63, w = tid >> 6;
  for (int row = vbid() * 4 + w; row < T_; row += vgrid() * 4) {
    const u16* src = (const u16*)p.fbuf + (size_t)row * 1024;
    float v[16];
    unpack8(*(const u32x4*)(src + lane * 8), v);
    unpack8(*(const u32x4*)(src + 512 + lane * 8), v + 8);
    float xv[16];
    unpack8(*(const u32x4*)(p.X + (size_t)row * 1024 + lane * 8), xv);
    unpack8(*(const u32x4*)(p.X + (size_t)row * 1024 + 512 + lane * 8), xv + 8);
    float sq = 0.f;
#pragma unroll
    for (int i = 0; i < 16; ++i) sq += v[i] * v[i];
    const float rs = rsqrtf(wsum(sq) * (1.f / 1024.f) + 1e-6f);
#pragma unroll
    for (int h = 0; h < 2; ++h) {
      const int c = h * 512 + lane * 8;
      const float4 g0 = *(const float4*)(p.ple_ng + l * 1024 + c), g1 = *(const float4*)(p.ple_ng + l * 1024 + c + 4);
      float y[8];
      y[0] = xv[h * 8 + 0] + v[h * 8 + 0] * rs * g0.x; y[1] = xv[h * 8 + 1] + v[h * 8 + 1] * rs * g0.y;
      y[2] = xv[h * 8 + 2] + v[h * 8 + 2] * rs * g0.z; y[3] = xv[h * 8 + 3] + v[h * 8 + 3] * rs * g0.w;
      y[4] = xv[h * 8 + 4] + v[h * 8 + 4] * rs * g1.x; y[5] = xv[h * 8 + 5] + v[h * 8 + 5] * rs * g1.y;
      y[6] = xv[h * 8 + 6] + v[h * 8 + 6] * rs * g1.z; y[7] = xv[h * 8 + 7] + v[h * 8 + 7] * rs * g1.w;
      if (l == NL - 1) {
        float4* od = (float4*)(p.out + (size_t)row * 1024 + c);
        od[0] = make_float4(y[0], y[1], y[2], y[3]); od[1] = make_float4(y[4], y[5], y[6], y[7]);
      } else {
        *(u32x4*)(p.X + (size_t)row * 1024 + c) = pack8(y);
      }
    }
  }
}

DI void phase_mix1(PREF p, int l, unsigned char* ldsb) {
  for (int it = vbid(); it < 1024; it += vgrid()) {
    int pi = it >> 1, b = pi >> 6, hq = ((pi >> 5) & 1) * 2 + (it & 1), qb = pi & 31;
    const u16* hbb = p.hb + (size_t)b * S_ * HW;
    attn_item<64, true>(hbb + OFF_SQ + hq * 64, HW, hbb + OFF_SK + (hq >> 1) * 64, HW,
                        p.Vst + (size_t)(b * 2 + (hq >> 1)) * 64 * S_, qb, 0.125f * LOG2E, p.sinks[l * 4 + hq] * 8.0f,
                        hbb + OFF_DZ + hq * 64, HW, p.ys + (size_t)b * S_ * 1024 + 768 + hq * 64, 1024, (u16*)ldsb);
  }
  for (int it = vbid(); it < 1024; it += vgrid()) kv_tile(p, l, it, ldsb);
  for (int it = vbid(); it < 768; it += vgrid()) q_tile(p, l, it, ldsb);
  for (int it = vbid(); it < 1024; it += vgrid()) conv_item(p, l, it, ldsb);
  for (int it = vbid(); it < 2048; it += vgrid()) ssm1_item(p, l, it, ldsb);
}
DI void phase_mix2(PREF p, int l, unsigned char* ldsb) {
  for (int it = vbid(); it < 1024; it += vgrid()) {
    int qb = (it < 512) ? 31 - (it >> 5) : ((it - 512) >> 5);
    int bh = it & 31, b = bh >> 2, head = bh & 3;
    attn_item<96, false>(p.Qm + (size_t)b * S_ * 384 + head * 96, 384, p.Km + (size_t)b * S_ * 384 + head * 96, 384,
                         p.Vmt + (size_t)(b * 4 + head) * 64 * S_, qb, 0.10206207261596577f * LOG2E, 0.f,
                         p.hb + (size_t)b * S_ * HW + OFF_BZ + head * 64, HW, p.ys + (size_t)b * S_ * 1024 + 256 + head * 64, 1024,
                         (u16*)ldsb);
  }
  for (int it = vbid(); it < 512; it += vgrid()) pw2_tile(p, l, it, ldsb);
  for (int it = vbid(); it < 2048; it += vgrid()) ssm2_item(p, l, it, ldsb);
}

DI void grid_barrier(unsigned* bar, unsigned gen) {
  asm volatile("s_waitcnt vmcnt(0)" ::: "memory");
  __syncthreads();
  if (threadIdx.x == 0) {
    __builtin_amdgcn_fence(__ATOMIC_RELEASE, "agent");
    const unsigned grp = blockIdx.x & 15u;
    const unsigned nblk = (gridDim.x + 15u - grp) >> 4;
    unsigned old = __hip_atomic_fetch_add(bar + 64 * (1 + grp), 1u, __ATOMIC_RELAXED, __HIP_MEMORY_SCOPE_AGENT);
    if (old + 1u == nblk * gen) {
      unsigned g = __hip_atomic_fetch_add(bar, 1u, __ATOMIC_RELAXED, __HIP_MEMORY_SCOPE_AGENT);
      if (g + 1u == 16u * gen) {
        for (int i = 0; i < 16; ++i) __hip_atomic_store(bar + 64 * (17 + i), gen, __ATOMIC_RELAXED, __HIP_MEMORY_SCOPE_AGENT);
      }
    }
    while (__hip_atomic_load(bar + 64 * (17 + grp), __ATOMIC_RELAXED, __HIP_MEMORY_SCOPE_AGENT) < gen) __builtin_amdgcn_s_sleep(4);
    __builtin_amdgcn_fence(__ATOMIC_ACQUIRE, "agent");
  }
  __syncthreads();
}

template <int J>
DI void run_phase(PREF p, int l, unsigned char* ldsb, unsigned char* lds_all) {
  if (J == 0) phase_in(p, l, lds_all);
  else if (J == 1) phase_mix1(p, l, ldsb);
  else if (J == 2) phase_mix2(p, l, ldsb);
  else if (J == 3) glu_phase(p, l, lds_all);
  else if (J == 4) merge_phase(p, l, lds_all);
  else if (J == 5) f1_phase(p, l, lds_all);
  else if (J == 6) rows_ln(p, l);
  else if (J == 7) f3_phase(p, l, lds_all);
  else if (J == 8) rows_ple(p, l);
  else phase_prep(p, ldsb);
}

#if MULTI_LAUNCH
template <int J>
__global__ void __launch_bounds__(256, 2) phk(Params p, int l) {
  __shared__ __attribute__((aligned(16))) unsigned char ldsb[LDS_BYTES];
  run_phase<J>(p, l, ldsb);
}
#else
__global__ void __launch_bounds__(512, 2) mega(Params p_unused, int ph0, int ph1) {
  __shared__ __attribute__((aligned(16))) unsigned char lds_all[LDS_BYTES];
  unsigned char* ldsb = lds_all + half_() * LDS_HALF;
  cg::grid_group grid = cg::this_grid();
  for (int ph = ph0; ph < ph1; ++ph) {
    const __attribute__((address_space(4))) Params* pp = (const __attribute__((address_space(4))) Params*)__builtin_amdgcn_kernarg_segment_ptr();
    asm volatile("" : "+s"(pp));
    PREF p = *pp;
    if (ph1 < 0) grid.sync();
    if (ph > ph0) grid_barrier(p.bar, (unsigned)(ph - ph0));
    if (ph == 0) { run_phase<9>(p, 0, ldsb, lds_all); continue; }
    int l = (ph - 1) / NPH_LAYER; const int j = (ph - 1) % NPH_LAYER;
    asm volatile("" : "+s"(l));
    if (j == 0) run_phase<0>(p, l, ldsb, lds_all);
    else if (j == 1) run_phase<1>(p, l, ldsb, lds_all);
    else if (j == 2) run_phase<2>(p, l, ldsb, lds_all);
    else if (j == 3) run_phase<3>(p, l, ldsb, lds_all);
    else if (j == 4) run_phase<4>(p, l, ldsb, lds_all);
    else if (j == 5) run_phase<5>(p, l, ldsb, lds_all);
    else if (j == 6) run_phase<6>(p, l, ldsb, lds_all);
    else if (j == 7) run_phase<7>(p, l, ldsb, lds_all);
    else run_phase<8>(p, l, ldsb, lds_all);
  }
}
#endif

extern "C" void kernel_launch(void* const* d_in, const int* in_sizes, int n_in, void* d_out, int out_size, void* d_ws,
                              size_t ws_size, hipStream_t stream) {
  static int grid_blocks = 0;
  if (!grid_blocks) {
    int dev = 0, cus = 0, per_cu = 2;
    (void)hipGetDevice(&dev);
    (void)hipDeviceGetAttribute(&cus, hipDeviceAttributeMultiprocessorCount, dev);
#if !MULTI_LAUNCH
    (void)hipOccupancyMaxActiveBlocksPerMultiprocessor(&per_cu, mega, 512, 0);
    per_cu = 1;
#endif
    if (cus < 1) cus = 256;
    grid_blocks = cus * per_cu;
  }
  Params p{};
  const float** f = (const float**)&p;
  for (int i = 0; i < 31; ++i) f[i] = (const float*)d_in[i];
  p.out = (float*)d_out;
  unsigned char* ws = (unsigned char*)d_ws;
  size_t off = 0;
  auto take = [&](size_t bytes) { unsigned char* r = ws + off; off += (bytes + 255) & ~(size_t)255; return r; };
  p.wts = (u16*)take(WL * NL * 2);
  p.lam = (float*)take((size_t)NL * 16 * 64 * 2 * 4);
  p.bbre = (float*)take((size_t)NL * 16 * 64 * 16 * 4);
  p.bbim = (float*)take((size_t)NL * 16 * 64 * 16 * 4);
  p.rcos = (float*)take((size_t)S_ * 16 * 4);
  p.rsin = (float*)take((size_t)S_ * 16 * 4);
  p.X = (u16*)take((size_t)T_ * 1024 * 2);
  p.pb = (u16*)take((size_t)T_ * 256 * 2);
  p.hb = (u16*)take((size_t)T_ * HW * 2);
  p.ys = (u16*)take((size_t)T_ * 1024 * 2);
  p.cA = (u16*)take((size_t)T_ * 256 * 2);
  p.Qm = (u16*)take((size_t)T_ * 384 * 2);
  p.Km = (u16*)take((size_t)T_ * 384 * 2);
  p.Vmt = (u16*)take((size_t)T_ * 256 * 2);
  p.Vst = (u16*)take((size_t)T_ * 128 * 2);
  p.yss = (u16*)take((size_t)T_ * 256 * 2);
  p.hend = (float*)take((size_t)8 * 16 * 64 * 64 * 2 * 4);
  p.bar = (unsigned*)take(16384);
  p.mg = p.cA;
  p.fbuf = (float*)p.hb;
  if (off > ws_size) fprintf(stderr, "workspace too small: need %zu have %zu\n", off, ws_size);
  const int NPH = 1 + NPH_LAYER * NL;
#if MULTI_LAUNCH
  (void)NPH;
  const dim3 g(grid_blocks), b(256);
  hipLaunchKernelGGL(phk<9>, g, b, 0, stream, p, 0);
  for (int l = 0; l < NL; ++l) {
    hipLaunchKernelGGL(phk<0>, g, b, 0, stream, p, l);
    hipLaunchKernelGGL(phk<1>, g, b, 0, stream, p, l);
    hipLaunchKernelGGL(phk<2>, g, b, 0, stream, p, l);
    hipLaunchKernelGGL(phk<3>, g, b, 0, stream, p, l);
    hipLaunchKernelGGL(phk<4>, g, b, 0, stream, p, l);
    hipLaunchKernelGGL(phk<5>, g, b, 0, stream, p, l);
    hipLaunchKernelGGL(phk<6>, g, b, 0, stream, p, l);
    hipLaunchKernelGGL(phk<7>, g, b, 0, stream, p, l);
    hipLaunchKernelGGL(phk<8>, g, b, 0, stream, p, l);
  }
#else
  int ph0 = 0, ph1 = NPH;
  (void)hipMemsetAsync(p.bar, 0, 16384, stream);
  void* args[] = {&p, &ph0, &ph1};
  hipError_t e = hipLaunchCooperativeKernel((void*)mega, dim3(grid_blocks), dim3(512), args, 0, stream);
  if (e != hipSuccess) fprintf(stderr, "cooperative launch failed: %s (grid %d)\n", hipGetErrorString(e), grid_blocks);
#endif
}
```

```cpp
#include <hip/hip_runtime.h>
#include <hip/hip_cooperative_groups.h>
#include <cstdio>
#include <type_traits>
namespace cg = cooperative_groups;

#ifndef MULTI_LAUNCH
#define MULTI_LAUNCH 0
#endif

typedef unsigned short u16;
typedef __attribute__((ext_vector_type(8))) short bf16x8;
typedef __attribute__((ext_vector_type(4))) float f32x4;
typedef __attribute__((ext_vector_type(16))) float f32x16;
typedef __attribute__((ext_vector_type(4))) unsigned u32x4;
typedef __attribute__((ext_vector_type(2))) unsigned u32x2;
#define DI __device__ __forceinline__
DI int tidx() { int t = threadIdx.x & 255; asm volatile("" : "+v"(t)); return t; }
DI int half_() { return __builtin_amdgcn_readfirstlane((int)(threadIdx.x >> 8)); }
DI int vbid() { return (int)blockIdx.x * 2 + half_(); }
DI int vgrid() { return (int)gridDim.x * 2; }

constexpr int T_ = 32768, S_ = 4096, D_ = 1024, HW = 2720, NL = 4;
constexpr int OFF_AVAL = 0, OFF_AGATE = 256, OFF_AZ = 512, OFF_CQ = 768, OFF_CKV = 1024, OFF_KR = 1152, OFF_BZ = 1184,
              OFF_U = 1440, OFF_CZ = 1696, OFF_SQ = 1952, OFF_SK = 2208, OFF_SV = 2336, OFF_DZ = 2464;
constexpr size_t O_WIN = 0, O_WM = O_WIN + 2816 * 1024, O_PW2 = O_WM + 4096 * 1024, O_UQ = O_PW2 + 65536, O_UKV = O_UQ + 98304,
                 O_GLU = O_UKV + 65536, O_BR = O_GLU + 131072, O_OUT = O_BR + 1048576, O_PLE = O_OUT + 1048576,
                 O_PLEG = O_PLE + 262144, WL = O_PLEG + 1048576;
constexpr int LDT = 64;
constexpr int TILE_E = 128 * LDT;
constexpr int CST = 132;
constexpr int LDS_MAIN = 73728;
constexpr int LDS_HALF = LDS_MAIN + 1024;
constexpr int LDS_BYTES = 2 * LDS_HALF;
constexpr float LOG2E = 1.4426950408889634f;
constexpr int NPH_LAYER = 9;

struct Params {
  const float *x, *p, *w_in, *w_merge, *b_merge, *conv_w, *conv_b, *conv_ng, *conv_nb, *w_pw2, *qng, *kvng, *w_uq, *w_ukv,
      *a_re, *a_im, *log_dt, *b_re, *b_im, *c_re, *c_im, *ssm_d, *w_glu, *sinks, *w_branch, *w_out, *ln_g, *ln_b, *w_ple,
      *w_pleg, *ple_ng;
  float* out;
  u16* wts;
  float *lam, *bbre, *bbim, *rcos, *rsin;
  u16 *X, *pb, *hb, *ys, *cA, *Qm, *Km, *Vmt, *Vst, *yss, *mg;
  float *hend, *fbuf;
  unsigned* bar;
};

typedef const __attribute__((address_space(4))) Params& PREF;

DI unsigned pack2(float a, float b) { unsigned r; asm("v_cvt_pk_bf16_f32 %0, %1, %2\n\ts_nop 1" : "=v"(r) : "v"(a), "v"(b)); return r; }
DI u16 f2bf(float x) { return (u16)(pack2(x, x) & 0xffffu); }
DI float bf2f(u16 v) { return __uint_as_float(((unsigned)v) << 16); }
DI float lo2f(unsigned u) { return __uint_as_float(u << 16); }
DI float hi2f(unsigned u) { return __uint_as_float(u & 0xffff0000u); }
DI float sigm(float x) { return 1.f / (1.f + __expf(-x)); }
DI float silu(float x) { return x / (1.f + __expf(-x)); }
DI float gelu_t(float x) { float u = 0.7978845608028654f * (x + 0.044715f * x * x * x); return 0.5f * x * (1.f + tanhf(u)); }
DI void unpack8(u32x4 v, float* f) {
  f[0] = lo2f(v.x); f[1] = hi2f(v.x); f[2] = lo2f(v.y); f[3] = hi2f(v.y);
  f[4] = lo2f(v.z); f[5] = hi2f(v.z); f[6] = lo2f(v.w); f[7] = hi2f(v.w);
}
DI u32x4 pack8(const float* f) { u32x4 o; o.x = pack2(f[0], f[1]); o.y = pack2(f[2], f[3]); o.z = pack2(f[4], f[5]); o.w = pack2(f[6], f[7]); return o; }
DI float wsum(float v) {
#pragma unroll
  for (int o = 32; o >= 1; o >>= 1) v += __shfl_xor(v, o);
  return v;
}
#define MFMA32(a, b, c) __builtin_amdgcn_mfma_f32_32x32x16_bf16((a), (b), (c), 0, 0, 0)
#define MFMA16(a, b, c) __builtin_amdgcn_mfma_f32_16x16x32_bf16((a), (b), (c), 0, 0, 0)

DI void zero_acc(f32x4 (&a)[4][4]) {
#pragma unroll
  for (int i = 0; i < 4; ++i)
#pragma unroll
    for (int j = 0; j < 4; ++j)
#pragma unroll
      for (int k = 0; k < 4; ++k) a[i][j][k] = 0.f;
}

#define GM_LOAD(RA, RB, KT)                                                                 \
  _Pragma("unroll") for (int i = 0; i < 4; ++i) {                                           \
    RA[i] = *(const u32x4*)(ag + (size_t)(32 * i) * lda + (KT) * 64);                       \
    RB[i] = *(const u32x4*)(bg + (size_t)(32 * i) * ldb + (KT) * 64);                       \
  }
#define GM_STORE(RA, RB, STG)                                                               \
  {                                                                                         \
    u16* dA_ = lds + (STG) * 2 * TILE_E;                                                    \
    _Pragma("unroll") for (int i = 0; i < 4; ++i) {                                         \
      *(u32x4*)(dA_ + (lrow + 32 * i) * LDT + lsw) = RA[i];                                 \
      *(u32x4*)(dA_ + TILE_E + (lrow + 32 * i) * LDT + lsw) = RB[i];                        \
    }                                                                                       \
  }
#define GM_COMPUTE(STG)                                                                     \
  {                                                                                         \
    const u16* sA = lds + (STG) * 2 * TILE_E + (wm * 64 + fr) * LDT;                        \
    const u16* sB = lds + (STG) * 2 * TILE_E + TILE_E + (wn * 64 + fr) * LDT;               \
    __builtin_amdgcn_s_setprio(1);                                                          \
    _Pragma("unroll") for (int kk = 0; kk < 2; ++kk) {                                      \
      const int co = (((kk * 4 + fq) ^ (fr & 7)) * 8);                                      \
      bf16x8 af[4];                                                                         \
      _Pragma("unroll") for (int m = 0; m < 4; ++m) af[m] = *(const bf16x8*)(sA + m * 16 * LDT + co);   \
      _Pragma("unroll") for (int n = 0; n < 4; ++n) {                                       \
        const bf16x8 bfr = *(const bf16x8*)(sB + n * 16 * LDT + co);                        \
        _Pragma("unroll") for (int m = 0; m < 4; ++m) acc[m][n] = MFMA16(af[m], bfr, acc[m][n]);        \
      }                                                                                     \
    }                                                                                       \
    __builtin_amdgcn_s_setprio(0);                                                          \
  }
template <bool DEEP = true>
DI void gemm_main(f32x4 (&acc)[4][4], const u16* __restrict__ A, int lda, const u16* __restrict__ B, int ldb, int K, u16* lds) {
  const int tid = tidx(), lane = tid & 63, w = tid >> 6;
  const int wm = w >> 1, wn = w & 1, fr = lane & 15, fq = lane >> 4;
  const int lrow = tid >> 3, lch = (tid & 7) * 8, lsw = ((tid & 7) ^ (lrow & 7)) * 8;
  const u16* ag = A + (size_t)lrow * lda + lch;
  const u16* bg = B + (size_t)lrow * ldb + lch;
  const int nk = K >> 6;
  if (DEEP) {
    u32x4 ra0[4], rb0[4], ra1[4], rb1[4];
    GM_LOAD(ra0, rb0, 0)
    GM_LOAD(ra1, rb1, 1)
    __syncthreads();
    GM_STORE(ra0, rb0, 0)
    __syncthreads();
    for (int kt = 0; kt < nk; kt += 2) {
      if (kt + 2 < nk) { GM_LOAD(ra0, rb0, kt + 2) }
      GM_COMPUTE(0)
      __builtin_amdgcn_sched_barrier(0);
      GM_STORE(ra1, rb1, 1)
      __syncthreads();
      if (kt + 3 < nk) { GM_LOAD(ra1, rb1, kt + 3) }
      GM_COMPUTE(1)
      __builtin_amdgcn_sched_barrier(0);
      if (kt + 2 < nk) { GM_STORE(ra0, rb0, 0) }
      __syncthreads();
    }
  } else {
    u32x4 ra0[4], rb0[4];
    GM_LOAD(ra0, rb0, 0)
    __syncthreads();
    GM_STORE(ra0, rb0, 0)
    __syncthreads();
    for (int kt = 0; kt < nk; kt += 2) {
      GM_LOAD(ra0, rb0, kt + 1)
      GM_COMPUTE(0)
      __builtin_amdgcn_sched_barrier(0);
      GM_STORE(ra0, rb0, 1)
      __syncthreads();
      if (kt + 2 < nk) { GM_LOAD(ra0, rb0, kt + 2) }
      GM_COMPUTE(1)
      __builtin_amdgcn_sched_barrier(0);
      if (kt + 2 < nk) { GM_STORE(ra0, rb0, 0) }
      __syncthreads();
    }
  }
}

DI void stage_c(const f32x4 (&acc)[4][4], float* Cs) {
  const int tid = tidx(), lane = tid & 63, w = tid >> 6;
  const int wm = w >> 1, wn = w & 1, fr = lane & 15, fq = lane >> 4;
#pragma unroll
  for (int m = 0; m < 4; ++m)
#pragma unroll
    for (int n = 0; n < 4; ++n)
#pragma unroll
      for (int j = 0; j < 4; ++j) Cs[(wm * 64 + m * 16 + fq * 4 + j) * CST + wn * 64 + n * 16 + fr] = acc[m][n][j];
  __syncthreads();
}
DI void ld8(const float* Cs, float* v) {
  float4 a = *(const float4*)Cs, b = *(const float4*)(Cs + 4);
  v[0] = a.x; v[1] = a.y; v[2] = a.z; v[3] = a.w; v[4] = b.x; v[5] = b.y; v[6] = b.z; v[7] = b.w;
}

DI void prep_w(const float* __restrict__ src, int K, int N, u16* __restrict__ dst, int Npad, const float* __restrict__ g, int perm,
               u16* T) {
  const int tid = tidx();
  const int ntn = Npad >> 6, ntiles = (K >> 6) * ntn;
  for (int it = vbid(); it < ntiles; it += vgrid()) {
    const int kt = it / ntn, k0 = kt * 64, n0 = (it - kt * ntn) * 64;
    int sn0 = n0;
    if (perm) { int tl = n0 >> 7, rr = n0 & 127; sn0 = (rr < 64) ? (tl * 64 + rr) : (256 + tl * 64 + rr - 64); }
    __syncthreads();
    {
      const int nn = tid & 63, kq = tid >> 6;
      const bool valid = (n0 + nn) < N;
      float v[16];
#pragma unroll
      for (int i = 0; i < 16; ++i) v[i] = valid ? src[(size_t)(k0 + kq + 4 * i) * N + sn0 + nn] : 0.f;
      if (g) {
#pragma unroll
        for (int i = 0; i < 16; ++i) v[i] *= g[k0 + kq + 4 * i];
      }
#pragma unroll
      for (int i = 0; i < 16; ++i) T[(kq + 4 * i) * 72 + nn] = f2bf(v[i]);
    }
    __syncthreads();
    {
      const int nn = tid >> 2, kc = (tid & 3) * 16;
      unsigned w[8];
#pragma unroll
      for (int j = 0; j < 8; ++j) w[j] = (unsigned)T[(kc + 2 * j) * 72 + nn] | ((unsigned)T[(kc + 2 * j + 1) * 72 + nn] << 16);
      u32x4 o0 = {w[0], w[1], w[2], w[3]}, o1 = {w[4], w[5], w[6], w[7]};
      u16* d = dst + (size_t)(n0 + nn) * K + k0 + kc;
      *(u32x4*)d = o0; *(u32x4*)(d + 8) = o1;
    }
  }
}

DI void phase_prep(PREF p, unsigned char* ldsb) {
  u16* T = (u16*)ldsb;
  const int gtid = vbid() * 256 + tidx(), gsz = vgrid() * 256;
  for (int l = 0; l < NL; ++l) {
    u16* W = p.wts + (size_t)l * WL;
    prep_w(p.w_in + (size_t)l * 1024 * HW, 1024, HW, W + O_WIN, 2816, nullptr, 0, T);
    prep_w(p.w_merge + (size_t)l * 1024 * 4096, 1024, 4096, W + O_WM, 4096, nullptr, 0, T);
    prep_w(p.w_pw2 + (size_t)l * 65536, 256, 256, W + O_PW2, 256, nullptr, 0, T);
    prep_w(p.w_uq + (size_t)l * 256 * 384, 256, 384, W + O_UQ, 384, p.qng + l * 256, 0, T);
    prep_w(p.w_ukv + (size_t)l * 128 * 512, 128, 512, W + O_UKV, 512, p.kvng + l * 128, 0, T);
    prep_w(p.w_glu + (size_t)l * 256 * 512, 256, 512, W + O_GLU, 512, nullptr, 1, T);
    for (int nb = 0; nb < 4; ++nb)
      prep_w(p.w_branch + ((size_t)l * 4 + nb) * 256 * 1024, 256, 1024, W + O_BR + (size_t)nb * 1024 * 256, 1024, nullptr, 0, T);
    prep_w(p.w_out + (size_t)l * 1048576, 1024, 1024, W + O_OUT, 1024, nullptr, 0, T);
    prep_w(p.w_ple + (size_t)l * 262144, 256, 1024, W + O_PLE, 1024, nullptr, 0, T);
    prep_w(p.w_pleg + (size_t)l * 1048576, 1024, 1024, W + O_PLEG, 1024, nullptr, 0, T);
  }
  for (int idx = gtid; idx < NL * 16 * 64; idx += gsz) {
    int lg = idx >> 6;
    float dt = expf(p.log_dt[lg]);
    float lr = p.a_re[idx], li = p.a_im[idx];
    float mag = expf(lr * dt);
    float lbr = mag * cosf(li * dt), lbi = mag * sinf(li * dt);
    float den = lr * lr + li * li;
    float nr = lbr - 1.f, ni = lbi;
    float fre = (nr * lr + ni * li) / den, fim = (ni * lr - nr * li) / den;
    p.lam[idx * 2] = lbr; p.lam[idx * 2 + 1] = lbi;
    for (int h = 0; h < 16; ++h) {
      float br = p.b_re[(size_t)idx * 16 + h], bi = p.b_im[(size_t)idx * 16 + h];
      p.bbre[(size_t)idx * 16 + h] = fre * br - fim * bi;
      p.bbim[(size_t)idx * 16 + h] = fre * bi + fim * br;
    }
  }
  for (int idx = gtid; idx < S_ * 16; idx += gsz) {
    int pos = idx >> 4, i = idx & 15;
    float inv = powf(10000.f, -(float)(2 * i) / 32.f);
    float ang = (float)pos * inv;
    p.rcos[idx] = cosf(ang); p.rsin[idx] = sinf(ang);
  }
  for (int idx = gtid; idx < T_ * D_ / 8; idx += gsz) {
    const float4* s = (const float4*)(p.x + (size_t)idx * 8);
    float4 a = s[0], b = s[1];
    float v[8] = {a.x, a.y, a.z, a.w, b.x, b.y, b.z, b.w};
    *(u32x4*)(p.X + (size_t)idx * 8) = pack8(v);
  }
}

constexpr int G_HT = 128 * 64;
DI void lds_barrier() { asm volatile("s_waitcnt lgkmcnt(0)\n\ts_barrier" ::: "memory"); }
DI int tid512() { int t = threadIdx.x; asm volatile("" : "+v"(t)); return t; }
DI void g_stage_rc(int b, int& R, int& C) {
  int st = b >> 10, sb = b & 1023, swz = sb ^ (((sb >> 9) & 1) << 5);
  R = (st >> 1) * 16 + (swz >> 6); C = (st & 1) * 32 + ((swz & 63) >> 1);
}
#define G_SA(b, h) (shm + ((b) * 2 + (h)) * G_HT)
#define G_SB(b, h) (shm + (4 + (b) * 2 + (h)) * G_HT)
#define G_STAGE(P, BASE, O0, O1, LD, br, KOFF)                                                                             \
  do {                                                                                                                    \
    const u16* g_ = (BASE) + (size_t)(br) * (LD) + (KOFF);                                                              \
    __builtin_amdgcn_global_load_lds((const unsigned*)(g_ + (O0)), (unsigned*)((char*)(P) + t * 16), 16, 0, 0);          \
    __builtin_amdgcn_global_load_lds((const unsigned*)(g_ + (O1)), (unsigned*)((char*)(P) + t * 16 + 8192), 16, 0, 0);   \
  } while (0)
#define G_LDA(dst, b, h)                                                                                                  \
  _Pragma("unroll") for (int m = 0; m < 4; ++m) _Pragma("unroll") for (int k = 0; k < 2; ++k)                             \
      dst[m][k] = *(const bf16x8*)((const char*)G_SA(b, h) + ((wr * 4 + m) * 2 + k) * 1024 + rdo)
#define G_LDB(dst, b, h)                                                                                                  \
  _Pragma("unroll") for (int n = 0; n < 2; ++n) _Pragma("unroll") for (int k = 0; k < 2; ++k)                             \
      dst[n][k] = *(const bf16x8*)((const char*)G_SB(b, h) + ((wc * 2 + n) * 2 + k) * 1024 + rdo)
#define G_MMA(ai, bj, At, Bt)                                                                                             \
  do {                                                                                                                    \
    __builtin_amdgcn_s_setprio(1);                                                                                        \
    _Pragma("unroll") for (int m = 0; m < 4; ++m) _Pragma("unroll") for (int n = 0; n < 2; ++n)                           \
        _Pragma("unroll") for (int k = 0; k < 2; ++k) acc[ai][bj][m][n] = MFMA16(At[m][k], Bt[n][k], acc[ai][bj][m][n]);  \
    __builtin_amdgcn_s_setprio(0);                                                                                        \
  } while (0)
#define G_WAIT_V(n) asm volatile("s_waitcnt vmcnt(" #n ")" ::: "memory")
#define G_WAIT_L(n) asm volatile("s_waitcnt lgkmcnt(" #n ")" ::: "memory")
#define G_BAR __builtin_amdgcn_s_barrier()
#define G_SCHED __builtin_amdgcn_sched_barrier(0)

DI void br_flush(PREF p, f32x4 (&acc)[2][2][4][2], int slot);
template <int LDA, int LDB, int K, int MODE = 0>
DI void gemm256(f32x4 (&acc)[2][2][4][2], const u16* __restrict__ A, const u16* __restrict__ B, u16* shm, PREF p) {
#define KA(kt) ((kt) * 64)
#define KB(kt) (MODE ? (((kt) >> 2) * (1024 * LDB) + ((kt) & 3) * 64) : (kt) * 64)
  const int t = tid512();
  const int wid = t >> 6, lane = t & 63, wr = wid >> 2, wc = wid & 3, fr = lane & 15, fq = lane >> 4;
  int r0, c0, r1, c1;
  g_stage_rc(t * 16, r0, c0); g_stage_rc(t * 16 + 8192, r1, c1);
  const int oa0 = r0 * LDA + c0, oa1 = r1 * LDA + c1, ob0 = r0 * LDB + c0, ob1 = r1 * LDB + c1;
  const int obr = fr * 64 + fq * 16, rdo = obr ^ (((obr >> 9) & 1) << 5);
  bf16x8 At[4][2], B0[2][2], B1[2][2];
  constexpr int nt = K / 64;
  lds_barrier();
  G_STAGE(G_SB(0, 0), B, ob0, ob1, LDB, 0, KB(0)); G_STAGE(G_SA(0, 0), A, oa0, oa1, LDA, 0, KA(0));
  G_STAGE(G_SB(0, 1), B, ob0, ob1, LDB, 128, KB(0)); G_STAGE(G_SA(0, 1), A, oa0, oa1, LDA, 128, KA(0));
  if (wr == 1) G_BAR;
  G_WAIT_V(4); G_BAR;
  G_STAGE(G_SB(1, 0), B, ob0, ob1, LDB, 0, KB(1)); G_STAGE(G_SA(1, 0), A, oa0, oa1, LDA, 0, KA(1)); G_STAGE(G_SB(1, 1), B, ob0, ob1, LDB, 128, KB(1));
  G_WAIT_V(6); G_BAR;
  for (int tt = 0; tt < nt - 2; tt += 2) {
    G_LDB(B0, 0, 0); G_SCHED; G_LDA(At, 0, 0); G_STAGE(G_SA(1, 1), A, oa0, oa1, LDA, 128, KA(tt + 1));
    G_WAIT_L(8); G_BAR; G_WAIT_L(0); G_MMA(0, 0, At, B0); G_BAR; G_SCHED;
    G_LDB(B1, 0, 1); G_STAGE(G_SB(0, 0), B, ob0, ob1, LDB, 0, KB(tt + 2));
    G_BAR; G_WAIT_L(0); G_MMA(0, 1, At, B1); G_BAR;
    G_LDA(At, 0, 1); G_STAGE(G_SA(0, 0), A, oa0, oa1, LDA, 0, KA(tt + 2));
    G_BAR; G_WAIT_L(0); G_MMA(1, 0, At, B0); G_BAR; G_SCHED;
    G_STAGE(G_SB(0, 1), B, ob0, ob1, LDB, 128, KB(tt + 2));
    G_WAIT_V(6); G_BAR; G_MMA(1, 1, At, B1); G_BAR;
    G_LDB(B0, 1, 0); G_SCHED; G_LDA(At, 1, 0); G_STAGE(G_SA(0, 1), A, oa0, oa1, LDA, 128, KA(tt + 2));
    G_WAIT_L(8); G_BAR; G_WAIT_L(0); G_MMA(0, 0, At, B0); G_BAR; G_SCHED;
    G_LDB(B1, 1, 1); G_STAGE(G_SB(1, 0), B, ob0, ob1, LDB, 0, KB(tt + 3));
    G_BAR; G_WAIT_L(0); G_MMA(0, 1, At, B1); G_BAR;
    G_LDA(At, 1, 1); G_STAGE(G_SA(1, 0), A, oa0, oa1, LDA, 0, KA(tt + 3));
    G_BAR; G_WAIT_L(0); G_MMA(1, 0, At, B0); G_BAR; G_SCHED;
    G_STAGE(G_SB(1, 1), B, ob0, ob1, LDB, 128, KB(tt + 3));
    G_WAIT_V(6); G_BAR; G_MMA(1, 1, At, B1); G_BAR;
    if (MODE && ((tt + 1) & 3) == 3) br_flush(p, acc, (tt + 1) >> 2);
  }
  {
    G_LDB(B0, 0, 0); G_LDA(At, 0, 0); G_STAGE(G_SA(1, 1), A, oa0, oa1, LDA, 128, KA(nt - 1));
    G_BAR; G_WAIT_L(0); G_MMA(0, 0, At, B0); G_BAR;
    G_LDB(B1, 0, 1); G_BAR; G_WAIT_L(0); G_MMA(0, 1, At, B1); G_BAR;
    G_LDA(At, 0, 1); G_WAIT_V(4); G_BAR; G_WAIT_L(0); G_MMA(1, 0, At, B0); G_MMA(1, 1, At, B1); G_BAR;
  }
  {
    G_LDB(B0, 1, 0); G_LDA(At, 1, 0); G_WAIT_V(2); G_BAR; G_WAIT_L(0); G_MMA(0, 0, At, B0); G_BAR;
    G_LDB(B1, 1, 1); G_WAIT_V(0); G_BAR; G_WAIT_L(0); G_MMA(0, 1, At, B1); G_BAR;
    G_LDA(At, 1, 1); G_BAR; G_WAIT_L(0); G_MMA(1, 0, At, B0); G_MMA(1, 1, At, B1); G_BAR;
  }
  if (wr == 0) G_BAR;
#undef KA
#undef KB
}
DI void zero_acc256(f32x4 (&a)[2][2][4][2]) {
#pragma unroll
  for (int i = 0; i < 2; ++i)
#pragma unroll
    for (int j = 0; j < 2; ++j)
#pragma unroll
      for (int m = 0; m < 4; ++m)
#pragma unroll
        for (int n = 0; n < 2; ++n)
#pragma unroll
          for (int e = 0; e < 4; ++e) a[i][j][m][n][e] = 0.f;
}
template <int AI, int BJ>
DI void stage_q(const f32x4 (&acc)[2][2][4][2], float* Cs) {
  const int t = tid512(), wid = t >> 6, lane = t & 63, wr = wid >> 2, wc = wid & 3, fr = lane & 15, fq = lane >> 4;
  lds_barrier();
#pragma unroll
  for (int m = 0; m < 4; ++m)
#pragma unroll
    for (int n = 0; n < 2; ++n)
#pragma unroll
      for (int j = 0; j < 4; ++j) Cs[(wr * 64 + m * 16 + fq * 4 + j) * CST + wc * 32 + n * 16 + fr] = acc[AI][BJ][m][n][j];
  lds_barrier();
}
DI bool xcd_tile256(int k, int NT, int& m, int& n) {
  const int x = blockIdx.x & 7, slots = gridDim.x >> 3;
  const int idx = (int)(blockIdx.x >> 3) + slots * k;
  if (idx >= 16 * NT) return false;
  const int mg = idx / (8 * NT), rem = idx - mg * 8 * NT;
  n = rem >> 3; m = x * 16 + mg * 8 + (rem & 7);
  return true;
}

DI bool xcd_tile(int k, int NT, int& m, int& n) {
  const int x = (vbid() >> 1) & 7, slots = vgrid() >> 3;
  const int idx = (((vbid() >> 4) << 1) | (vbid() & 1)) + slots * k;
  if (idx >= 32 * NT) return false;
  const int mg = idx / (8 * NT), rem = idx - mg * 8 * NT;
  n = rem >> 3; m = x * 32 + mg * 8 + (rem & 7);
  return true;
}

template <int AI, int BJ>
DI void in_quadrant(PREF p, const f32x4 (&acc)[2][2][4][2], int mt, int nt, float* Cs) {
  const int t = tid512();
  const int row0 = mt * 256 + AI * 128, col0 = nt * 256 + BJ * 128;
  if (col0 >= HW) return;
  stage_q<AI, BJ>(acc, Cs);
#pragma unroll
  for (int q = 0; q < 4; ++q) {
    int r = (t >> 4) + 32 * q, c = (t & 15) * 8;
    if (col0 + c < HW) {
      float v[8]; ld8(Cs + r * CST + c, v);
      *(u32x4*)(p.hb + (size_t)(row0 + r) * HW + col0 + c) = pack8(v);
    }
  }
  if (col0 + 128 > OFF_SV && col0 < OFF_SV + 128) {
    int b = row0 >> 12, s0 = row0 & 4095;
#pragma unroll
    for (int q = 0; q < 4; ++q) {
      int item = t + 512 * q; int c = item & 127, rg = item >> 7;
      int vc = col0 + c - OFF_SV;
      if (vc >= 0 && vc < 128) {
        float v[8];
#pragma unroll
        for (int j = 0; j < 8; ++j) v[j] = Cs[(rg * 8 + j) * CST + c];
        *(u32x4*)(p.Vst + ((size_t)(b * 2 + (vc >> 6)) * 64 + (vc & 63)) * S_ + s0 + rg * 8) = pack8(v);
      }
    }
  }
}
DI void phase_in(PREF p, int l, unsigned char* lds_all) {
  u16* shm = (u16*)lds_all; float* Cs = (float*)lds_all;
  const int tid = tidx();
  const u16* W = p.wts + (size_t)l * WL + O_WIN;
  for (int k = 0;; ++k) {
    int mt, nt;
    if (!xcd_tile256(k, 11, mt, nt)) break;
    f32x4 acc[2][2][4][2]; zero_acc256(acc);
    gemm256<1024, 1024, 1024>(acc, p.X + (size_t)mt * 256 * 1024, W + (size_t)nt * 256 * 1024, shm, p);
    in_quadrant<0, 0>(p, acc, mt, nt, Cs); in_quadrant<0, 1>(p, acc, mt, nt, Cs);
    in_quadrant<1, 0>(p, acc, mt, nt, Cs); in_quadrant<1, 1>(p, acc, mt, nt, Cs);
  }
  __syncthreads();
  const int gtid = vbid() * 256 + tid, gsz = vgrid() * 256;
  const float* ps = p.p + (size_t)l * T_ * 256;
  for (int idx = gtid; idx < T_ * 256 / 8; idx += gsz) {
    const float4* s = (const float4*)(ps + (size_t)idx * 8);
    float4 a = s[0], b = s[1];
    float v[8] = {a.x, a.y, a.z, a.w, b.x, b.y, b.z, b.w};
    *(u32x4*)(p.pb + (size_t)idx * 8) = pack8(v);
  }
}

template <int DQK, bool WIN>
DI void attn_item(const u16* __restrict__ Qb, int ldq, const u16* __restrict__ Kb, int ldk, const u16* __restrict__ Vtb, int qb,
                  float qscale, float sink2, const u16* __restrict__ zb, int ldz, u16* __restrict__ ob, int ldo, u16* lds) {
  constexpr int KST = DQK + 8, NKS = DQK / 16, KCH = DQK / 8;
  constexpr int KBUF = 64 * KST, VBUF = 64 * 72, STG = KBUF + VBUF;
  constexpr int NKL = (64 * KCH) / 256;
  const int tid = tidx(), lane = tid & 63, w = tid >> 6, r = lane & 31, hh = lane >> 5;
  const int q0 = qb * 128 + w * 32;
  const int qrow = q0 + r;
  bf16x8 qf[NKS];
#pragma unroll
  for (int s = 0; s < NKS; ++s) qf[s] = *(const bf16x8*)(Qb + (size_t)qrow * ldq + 16 * s + 8 * hh);
  const int kt_lo = WIN ? (qb > 0 ? 2 * qb - 2 : 0) : 0;
  const int kt_hi = 2 * qb + 1;
  f32x16 o[2];
#pragma unroll
  for (int i = 0; i < 16; ++i) { o[0][i] = 0.f; o[1][i] = 0.f; }
  float m = WIN ? sink2 : -1e30f;
  float lsum = (WIN && hh == 0) ? 1.f : 0.f;
  u32x4 rkA[NKL], rvA[2], rkB[NKL], rvB[2];
  auto gload = [&](u32x4 (&rk)[NKL], u32x4 (&rv)[2], int kt) {
#pragma unroll
    for (int i = 0; i < NKL; ++i) {
      int id = tid + 256 * i; int row = id / KCH, ch = id % KCH;
      rk[i] = *(const u32x4*)(Kb + (size_t)(kt * 64 + row) * ldk + ch * 8);
    }
#pragma unroll
    for (int i = 0; i < 2; ++i) {
      int id = tid + 256 * i; int row = id >> 3, ch = id & 7;
      rv[i] = *(const u32x4*)(Vtb + (size_t)row * S_ + kt * 64 + ch * 8);
    }
  };
  auto swrite = [&](const u32x4 (&rk)[NKL], const u32x4 (&rv)[2], int buf) {
    u16* ks = lds + buf * STG; u16* vs = ks + KBUF;
#pragma unroll
    for (int i = 0; i < NKL; ++i) {
      int id = tid + 256 * i; int row = id / KCH, ch = id % KCH;
      *(u32x4*)(ks + row * KST + ch * 8) = rk[i];
    }
#pragma unroll
    for (int i = 0; i < 2; ++i) {
      int id = tid + 256 * i; int row = id >> 3, ch = id & 7;
      u16* d = vs + row * 72 + (ch >> 1) * 16 + (ch & 1) * 4;
      u32x2 lo = {rv[i].x, rv[i].y}, hi = {rv[i].z, rv[i].w};
      *(u32x2*)d = lo; *(u32x2*)(d + 8) = hi;
    }
  };
  auto tile_body = [&](int kt, int buf, auto mask_tag) {
    constexpr bool MASK = decltype(mask_tag)::value;
    const u16* ks = lds + buf * STG; const u16* vs = ks + KBUF;
    const int k0 = kt * 64;
    bool active = (k0 <= q0 + 31);
    if (WIN) active = active && (k0 + 63 >= q0 - 127);
    if (active) {
      f32x16 st[2];
#pragma unroll
      for (int kb = 0; kb < 2; ++kb) {
#pragma unroll
        for (int i = 0; i < 16; ++i) st[kb][i] = 0.f;
#pragma unroll
        for (int s = 0; s < NKS; ++s) {
          bf16x8 a = *(const bf16x8*)(ks + (kb * 32 + r) * KST + 16 * s + 8 * hh);
          st[kb] = MFMA32(a, qf[s], st[kb]);
        }
      }
      float mx = -INFINITY;
#pragma unroll
      for (int kb = 0; kb < 2; ++kb)
#pragma unroll
        for (int i = 0; i < 16; ++i) {
          float v = st[kb][i];
          if (MASK) {
            int kg = k0 + kb * 32 + (i & 3) + 8 * (i >> 2) + 4 * hh;
            bool ok = kg <= qrow;
            if (WIN) ok = ok && (qrow - kg < 128);
            v = ok ? v : -INFINITY;
            st[kb][i] = v;
          }
          mx = fmaxf(mx, v);
        }
      mx = fmaxf(mx, __shfl_xor(mx, 32));
      const float mn = fmaxf(m, mx);
      if (__any(mn != m)) {
        const float alpha = __builtin_amdgcn_exp2f((m - mn) * qscale);
        lsum *= alpha;
#pragma unroll
        for (int i = 0; i < 16; ++i) { o[0][i] *= alpha; o[1][i] *= alpha; }
      }
      m = mn;
      const float nb = -mn * qscale;
      float ps = 0.f;
#pragma unroll
      for (int kb = 0; kb < 2; ++kb)
#pragma unroll
        for (int i = 0; i < 16; ++i) { float pv = __builtin_amdgcn_exp2f(fmaf(st[kb][i], qscale, nb)); st[kb][i] = pv; ps += pv; }
      lsum += ps;
#pragma unroll
      for (int kb = 0; kb < 2; ++kb)
#pragma unroll
        for (int s2 = 0; s2 < 2; ++s2) {
          union { bf16x8 v; unsigned u[4]; } pf;
#pragma unroll
          for (int j = 0; j < 4; ++j) pf.u[j] = pack2(st[kb][8 * s2 + 2 * j], st[kb][8 * s2 + 2 * j + 1]);
#pragma unroll
          for (int vb = 0; vb < 2; ++vb) {
            const bf16x8 vf = *(const bf16x8*)(vs + (vb * 32 + r) * 72 + (kb * 2 + s2) * 16 + hh * 8);
            o[vb] = MFMA32(vf, pf.v, o[vb]);
          }
        }
    }
  };
  __syncthreads();
  gload(rkA, rvA, kt_lo);
  gload(rkB, rvB, kt_lo + 1);
  swrite(rkA, rvA, 0);
  __syncthreads();
  for (int kt = kt_lo; kt <= kt_hi; kt += 2) {
    if (kt + 2 <= kt_hi) gload(rkA, rvA, kt + 2);
    if (WIN || kt >= 2 * qb) tile_body(kt, 0, std::true_type{}); else tile_body(kt, 0, std::false_type{});
    swrite(rkB, rvB, 1);
    __syncthreads();
    if (kt + 3 <= kt_hi) gload(rkB, rvB, kt + 3);
    if (WIN || kt + 1 >= 2 * qb) tile_body(kt + 1, 1, std::true_type{}); else tile_body(kt + 1, 1, std::false_type{});
    if (kt + 2 <= kt_hi) swrite(rkA, rvA, 0);
    __syncthreads();
  }
  float lt = lsum + __shfl_xor(lsum, 32);
  float inv = 1.f / lt;
  u32x2 zr[8];
#pragma unroll
  for (int e = 0; e < 8; ++e) zr[e] = *(const u32x2*)(zb + (size_t)qrow * ldz + (e >> 2) * 32 + 8 * (e & 3) + 4 * hh);
#pragma unroll
  for (int vb = 0; vb < 2; ++vb)
#pragma unroll
    for (int g4 = 0; g4 < 4; ++g4) {
      int vd0 = vb * 32 + 8 * g4 + 4 * hh;
      u32x2 z = zr[vb * 4 + g4];
      float a0 = o[vb][4 * g4 + 0] * inv * silu(lo2f(z.x));
      float a1 = o[vb][4 * g4 + 1] * inv * silu(hi2f(z.x));
      float a2 = o[vb][4 * g4 + 2] * inv * silu(lo2f(z.y));
      float a3 = o[vb][4 * g4 + 3] * inv * silu(hi2f(z.y));
      u32x2 ov; ov.x = pack2(a0, a1); ov.y = pack2(a2, a3);
      *(u32x2*)(ob + (size_t)qrow * ldo + vd0) = ov;
    }
}

DI void conv_item(PREF p, int l, int tile, unsigned char* ldsb) {
  float* Gs = (float*)ldsb;
  const int tid = tidx(), lane = tid & 63, w = tid >> 6;
  const int t0 = tile * 32, s0 = t0 & 4095;
  __syncthreads();
  for (int id = tid; id < 62 * 32; id += 256) {
    int rr = id >> 5, ch = (id & 31) * 8;
    int s = s0 - 30 + rr;
    float v[8];
#pragma unroll
    for (int j = 0; j < 8; ++j) v[j] = 0.f;
    if (s >= 0) {
      const u16* src = p.hb + (size_t)(t0 - 30 + rr) * HW + ch;
      float a[8], g[8];
      unpack8(*(const u32x4*)(src + OFF_AVAL), a);
      unpack8(*(const u32x4*)(src + OFF_AGATE), g);
#pragma unroll
      for (int j = 0; j < 8; ++j) v[j] = a[j] * sigm(g[j]);
    }
    *(float4*)(Gs + rr * 256 + ch) = make_float4(v[0], v[1], v[2], v[3]);
    *(float4*)(Gs + rr * 256 + ch + 4) = make_float4(v[4], v[5], v[6], v[7]);
  }
  __syncthreads();
  {
    const int c = tid;
    float wv[31];
#pragma unroll
    for (int j = 0; j < 31; ++j) wv[j] = p.conv_w[((size_t)l * 31 + j) * 256 + c];
    const float bias = p.conv_b[l * 256 + c];
    for (int tt = 0; tt < 32; ++tt) {
      float acc = bias;
#pragma unroll
      for (int j = 0; j < 31; ++j) acc += wv[j] * Gs[(tt + j) * 256 + c];
      Gs[tt * 256 + c] = acc;
    }
  }
  __syncthreads();
  const float4 gg = *(const float4*)(p.conv_ng + l * 256 + lane * 4);
  const float4 bb = *(const float4*)(p.conv_nb + l * 256 + lane * 4);
  for (int q = 0; q < 8; ++q) {
    int tt = w * 8 + q;
    float4 v = *(const float4*)(Gs + tt * 256 + lane * 4);
    float mu = wsum(v.x + v.y + v.z + v.w) * (1.f / 256.f);
    float d0 = v.x - mu, d1 = v.y - mu, d2 = v.z - mu, d3 = v.w - mu;
    float var = wsum(d0 * d0 + d1 * d1 + d2 * d2 + d3 * d3) * (1.f / 256.f);
    float rs = rsqrtf(var + 1e-5f);
    float y0 = silu(d0 * rs * gg.x + bb.x), y1 = silu(d1 * rs * gg.y + bb.y);
    float y2 = silu(d2 * rs * gg.z + bb.z), y3 = silu(d3 * rs * gg.w + bb.w);
    u32x2 ov; ov.x = pack2(y0, y1); ov.y = pack2(y2, y3);
    *(u32x2*)(p.cA + (size_t)(t0 + tt) * 256 + lane * 4) = ov;
  }
}

DI void ssm_stage_u(PREF p, int b, int c, int gq, float* uS) {
  const int tid = tidx();
  int row = tid >> 2, cc = (tid & 3) * 16;
  const u16* src = p.hb + (size_t)(b * S_ + c * 64 + row) * HW + OFF_U + gq * 64 + cc;
  float f[16];
  unpack8(*(const u32x4*)src, f); unpack8(*(const u32x4*)(src + 8), f + 8);
#pragma unroll
  for (int j = 0; j < 4; ++j) *(float4*)(uS + row * 64 + cc + 4 * j) = make_float4(f[4 * j], f[4 * j + 1], f[4 * j + 2], f[4 * j + 3]);
}
#define SSM_STEP(t)                                                                                                        \
  {                                                                                                                        \
    const float4* up = (const float4*)(uS + (t) * 64 + w * 16);                                                            \
    float4 u0 = up[0], u1 = up[1], u2 = up[2], u3 = up[3];                                                                 \
    float uu[16] = {u0.x, u0.y, u0.z, u0.w, u1.x, u1.y, u1.z, u1.w, u2.x, u2.y, u2.z, u2.w, u3.x, u3.y, u3.z, u3.w};       \
    float bur = 0.f, bui = 0.f;                                                                                            \
    _Pragma("unroll") for (int j = 0; j < 16; ++j) { bur += bre[j] * uu[j]; bui += bim[j] * uu[j]; }                       \
    float nr = lr * hr - li * hi + bur, ni = lr * hi + li * hr + bui;                                                      \
    hr = nr; hi = ni;                                                                                                      \
  }

DI void ssm1_item(PREF p, int l, int item, unsigned char* ldsb) {
  const int gq = item & 3, c = (item >> 2) & 63, b = item >> 8;
  const int tid = tidx(), w = tid >> 6, lane = tid & 63;
  const int g = gq * 4 + w;
  float* uS = (float*)ldsb;
  __syncthreads();
  ssm_stage_u(p, b, c, gq, uS);
  __syncthreads();
  const size_t pi = (size_t)(l * 16 + g) * 64 + lane;
  float bre[16], bim[16];
#pragma unroll
  for (int j = 0; j < 16; ++j) { bre[j] = p.bbre[pi * 16 + j]; bim[j] = p.bbim[pi * 16 + j]; }
  const float lr = p.lam[pi * 2], li = p.lam[pi * 2 + 1];
  float hr = 0.f, hi = 0.f;
  for (int t = 0; t < 64; ++t) SSM_STEP(t)
  ((float2*)p.hend)[((size_t)(b * 16 + g) * 64 + c) * 64 + lane] = make_float2(hr, hi);
}

DI void ssm2_item(PREF p, int l, int item, unsigned char* ldsb) {
  const int gq = item & 3, c = (item >> 2) & 63, b = item >> 8;
  const int tid = tidx(), w = tid >> 6, lane = tid & 63;
  const int g = gq * 4 + w;
  float* uS = (float*)ldsb;
  u16* Hs = (u16*)(ldsb + 16384) + w * (16 * 136);
  __syncthreads();
  ssm_stage_u(p, b, c, gq, uS);
  __syncthreads();
  const size_t pi = (size_t)(l * 16 + g) * 64 + lane;
  float bre[16], bim[16];
#pragma unroll
  for (int j = 0; j < 16; ++j) { bre[j] = p.bbre[pi * 16 + j]; bim[j] = p.bbim[pi * 16 + j]; }
  const float lr = p.lam[pi * 2], li = p.lam[pi * 2 + 1];
  float pr = lr, pim = li;
#pragma unroll
  for (int q = 0; q < 6; ++q) { float a = pr * pr - pim * pim, bq = 2.f * pr * pim; pr = a; pim = bq; }
  float hr = 0.f, hi = 0.f;
  const float2* he = (const float2*)p.hend + ((size_t)(b * 16 + g) * 64) * 64 + lane;
  for (int cc = 0; cc < c; ++cc) {
    float2 e = he[(size_t)cc * 64];
    float nr = pr * hr - pim * hi + e.x, ni = pr * hi + pim * hr + e.y;
    hr = nr; hi = ni;
  }
  const int hcol = lane & 15, q4 = lane >> 4;
  bf16x8 cf[4];
  {
    const float* cre = p.c_re + ((size_t)(l * 16 + g) * 16 + hcol) * 64;
    const float* cim = p.c_im + ((size_t)(l * 16 + g) * 16 + hcol) * 64;
#pragma unroll
    for (int ks = 0; ks < 4; ++ks) {
      float v[8];
#pragma unroll
      for (int j = 0; j < 8; ++j) {
        int k = 32 * ks + 8 * q4 + j;
        v[j] = (ks < 2) ? cre[k] : -cim[k - 64];
      }
      union { bf16x8 v8; u32x4 u; } cv; cv.u = pack8(v); cf[ks] = cv.v8;
    }
  }
  const float dch = p.ssm_d[l * 256 + g * 16 + hcol];
  for (int sub = 0; sub < 4; ++sub) {
    for (int tt = 0; tt < 16; ++tt) {
      SSM_STEP(sub * 16 + tt)
      Hs[tt * 136 + lane] = f2bf(hr);
      Hs[tt * 136 + 64 + lane] = f2bf(hi);
    }
    __syncthreads();
    f32x4 acc = {0.f, 0.f, 0.f, 0.f};
#pragma unroll
    for (int ks = 0; ks < 4; ++ks) {
      bf16x8 a = *(const bf16x8*)(Hs + hcol * 136 + 32 * ks + 8 * q4);
      acc = MFMA16(a, cf[ks], acc);
    }
#pragma unroll
    for (int j = 0; j < 4; ++j) {
      int t = sub * 16 + 4 * q4 + j;
      float uu = uS[t * 64 + w * 16 + hcol];
      float yv = gelu_t(acc[j] + dch * uu);
      p.yss[(size_t)(b * S_ + c * 64 + t) * 256 + g * 16 + hcol] = f2bf(yv);
    }
    __syncthreads();
  }
}

DI void q_tile(PREF p, int l, int idx, unsigned char* ldsb) {
  u16* lds = (u16*)ldsb; float* Cs = (float*)ldsb; float* aux = (float*)(ldsb + LDS_MAIN);
  const int tid = tidx();
  const int mt = idx / 3, nt = idx % 3;
  const int row0 = mt * 128, col0 = nt * 128;
  __syncthreads();
  if (tid < 128) {
    const u16* src = p.hb + (size_t)(row0 + tid) * HW + OFF_CQ;
    float ss = 0.f;
    for (int i = 0; i < 32; ++i) { float f[8]; unpack8(*(const u32x4*)(src + i * 8), f);
#pragma unroll
      for (int j = 0; j < 8; ++j) ss += f[j] * f[j]; }
    aux[tid] = rsqrtf(ss * (1.f / 256.f) + 1e-6f);
  }
  f32x4 acc[4][4]; zero_acc(acc);
  gemm_main(acc, p.hb + (size_t)row0 * HW + OFF_CQ, HW, p.wts + (size_t)l * WL + O_UQ + (size_t)col0 * 256, 256, 256, lds);
  stage_c(acc, Cs);
#pragma unroll
  for (int q = 0; q < 8; ++q) {
    int r = (tid >> 4) + 16 * q, c = (tid & 15) * 8;
    int n = col0 + c; int dd = n % 96;
    float rs = aux[r];
    float v[8]; ld8(Cs + r * CST + c, v);
#pragma unroll
    for (int j = 0; j < 8; ++j) v[j] *= rs;
    if (dd >= 64) {
      int ri0 = dd - 64; int s = (row0 + r) & 4095;
      float pv[8];
      if (ri0 < 16) {
        ld8(Cs + r * CST + c + 16, pv);
        const float* cs = p.rcos + s * 16 + ri0; const float* sn = p.rsin + s * 16 + ri0;
#pragma unroll
        for (int j = 0; j < 8; ++j) v[j] = v[j] * cs[j] - pv[j] * rs * sn[j];
      } else {
        ld8(Cs + r * CST + c - 16, pv);
        const float* cs = p.rcos + s * 16 + ri0 - 16; const float* sn = p.rsin + s * 16 + ri0 - 16;
#pragma unroll
        for (int j = 0; j < 8; ++j) v[j] = v[j] * cs[j] + pv[j] * rs * sn[j];
      }
    }
    *(u32x4*)(p.Qm + (size_t)(row0 + r) * 384 + n) = pack8(v);
  }
}

DI void kv_tile(PREF p, int l, int idx, unsigned char* ldsb) {
  u16* lds = (u16*)ldsb; float* Cs = (float*)ldsb; float* aux = (float*)(ldsb + LDS_MAIN);
  const int tid = tidx();
  const int mt = idx >> 2, head = idx & 3;
  const int row0 = mt * 128;
  __syncthreads();
  if (tid < 128) {
    const u16* src = p.hb + (size_t)(row0 + tid) * HW + OFF_CKV;
    float ss = 0.f;
    for (int i = 0; i < 16; ++i) { float f[8]; unpack8(*(const u32x4*)(src + i * 8), f);
#pragma unroll
      for (int j = 0; j < 8; ++j) ss += f[j] * f[j]; }
    aux[tid] = rsqrtf(ss * (1.f / 128.f) + 1e-6f);
  }
  f32x4 acc[4][4]; zero_acc(acc);
  gemm_main(acc, p.hb + (size_t)row0 * HW + OFF_CKV, HW, p.wts + (size_t)l * WL + O_UKV + (size_t)head * 128 * 128, 128, 128, lds);
  stage_c(acc, Cs);
#pragma unroll
  for (int q = 0; q < 4; ++q) {
    int r = (tid >> 3) + 32 * q, c = (tid & 7) * 8;
    float rs = aux[r];
    float v[8]; ld8(Cs + r * CST + c, v);
#pragma unroll
    for (int j = 0; j < 8; ++j) v[j] *= rs;
    *(u32x4*)(p.Km + (size_t)(row0 + r) * 384 + head * 96 + c) = pack8(v);
  }
  {
    int b = row0 >> 12, s0 = row0 & 4095;
#pragma unroll
    for (int q = 0; q < 4; ++q) {
      int item = tid + 256 * q; int c = item & 63, rg = item >> 6;
      float v[8];
#pragma unroll
      for (int j = 0; j < 8; ++j) v[j] = Cs[(rg * 8 + j) * CST + 64 + c] * aux[rg * 8 + j];
      *(u32x4*)(p.Vmt + ((size_t)(b * 4 + head) * 64 + c) * S_ + s0 + rg * 8) = pack8(v);
    }
  }
  {
    int r = tid >> 1, half = tid & 1;
    int t = row0 + r, s = t & 4095;
    const u16* src = p.hb + (size_t)t * HW + OFF_KR;
    float x1[16], x2[16];
    unpack8(*(const u32x4*)(src), x1); unpack8(*(const u32x4*)(src + 8), x1 + 8);
    unpack8(*(const u32x4*)(src + 16), x2); unpack8(*(const u32x4*)(src + 24), x2 + 8);
    const float* cs = p.rcos + s * 16; const float* sn = p.rsin + s * 16;
    float ov[16];
#pragma unroll
    for (int i = 0; i < 16; ++i) ov[i] = half ? (x2[i] * cs[i] + x1[i] * sn[i]) : (x1[i] * cs[i] - x2[i] * sn[i]);
    u16* dst = p.Km + (size_t)t * 384 + head * 96 + 64 + half * 16;
    *(u32x4*)dst = pack8(ov); *(u32x4*)(dst + 8) = pack8(ov + 8);
  }
}

DI void pw2_tile(PREF p, int l, int idx, unsigned char* ldsb) {
  u16* lds = (u16*)ldsb; float* Cs = (float*)ldsb;
  const int tid = tidx();
  const int mt = idx >> 1, nt = idx & 1;
  const int row0 = mt * 128, col0 = nt * 128;
  f32x4 acc[4][4]; zero_acc(acc);
  gemm_main(acc, p.cA + (size_t)row0 * 256, 256, p.wts + (size_t)l * WL + O_PW2 + (size_t)col0 * 256, 256, 256, lds);
  stage_c(acc, Cs);
  u32x4 zr[8];
#pragma unroll
  for (int q = 0; q < 8; ++q) zr[q] = *(const u32x4*)(p.hb + (size_t)(row0 + (tid >> 4) + 16 * q) * HW + OFF_AZ + col0 + (tid & 15) * 8);
#pragma unroll
  for (int q = 0; q < 8; ++q) {
    int r = (tid >> 4) + 16 * q, c = (tid & 15) * 8;
    float v[8]; ld8(Cs + r * CST + c, v);
    float z[8]; unpack8(zr[q], z);
#pragma unroll
    for (int j = 0; j < 8; ++j) v[j] *= silu(z[j]);
    *(u32x4*)(p.ys + (size_t)(row0 + r) * 1024 + col0 + c) = pack8(v);
  }
}

DI void glu_tile(PREF p, int l, int idx, unsigned char* ldsb) {
  u16* lds = (u16*)ldsb; float* Cs = (float*)ldsb;
  const int tid = tidx();
  const int mt = idx >> 2, nt = idx & 3;
  const int row0 = mt * 128;
  f32x4 acc[4][4]; zero_acc(acc);
  gemm_main(acc, p.yss + (size_t)row0 * 256, 256, p.wts + (size_t)l * WL + O_GLU + (size_t)nt * 128 * 256, 256, 256, lds);
  stage_c(acc, Cs);
  u32x4 zr[4];
#pragma unroll
  for (int q = 0; q < 4; ++q) zr[q] = *(const u32x4*)(p.hb + (size_t)(row0 + (tid >> 3) + 32 * q) * HW + OFF_CZ + nt * 64 + (tid & 7) * 8);
#pragma unroll
  for (int q = 0; q < 4; ++q) {
    int r = (tid >> 3) + 32 * q, c = (tid & 7) * 8;
    float v[8], g[8]; ld8(Cs + r * CST + c, v); ld8(Cs + r * CST + 64 + c, g);
    float z[8]; unpack8(zr[q], z);
#pragma unroll
    for (int j = 0; j < 8; ++j) v[j] = v[j] * sigm(g[j]) * silu(z[j]);
    *(u32x4*)(p.ys + (size_t)(row0 + r) * 1024 + 512 + nt * 64 + c) = pack8(v);
  }
}

template <int AI, int BJ>
DI void glu_quadrant(PREF p, const f32x4 (&acc)[2][2][4][2], int mt, int nt, float* Cs) {
  const int t = tid512();
  const int row0 = mt * 256 + AI * 128, oc0 = (nt * 2 + BJ) * 64, c = (t & 7) * 8;
  u32x4 zr[2];
#pragma unroll
  for (int q = 0; q < 2; ++q) zr[q] = *(const u32x4*)(p.hb + (size_t)(row0 + (t >> 3) + 64 * q) * HW + OFF_CZ + oc0 + c);
  stage_q<AI, BJ>(acc, Cs);
#pragma unroll
  for (int q = 0; q < 2; ++q) {
    const int r = (t >> 3) + 64 * q;
    float v[8], g[8]; ld8(Cs + r * CST + c, v); ld8(Cs + r * CST + 64 + c, g);
    float z[8]; unpack8(zr[q], z);
#pragma unroll
    for (int j = 0; j < 8; ++j) v[j] = v[j] * sigm(g[j]) * silu(z[j]);
    *(u32x4*)(p.ys + (size_t)(row0 + r) * 1024 + 512 + oc0 + c) = pack8(v);
  }
}
DI void glu_phase(PREF p, int l, unsigned char* lds_all) {
  u16* shm = (u16*)lds_all; float* Cs = (float*)lds_all;
  for (int it = blockIdx.x; it < 256; it += gridDim.x) {
    const int mt = it >> 1, nt = it & 1;
    f32x4 acc[2][2][4][2]; zero_acc256(acc);
    gemm256<256, 256, 256>(acc, p.yss + (size_t)mt * 256 * 256, p.wts + (size_t)l * WL + O_GLU + (size_t)nt * 256 * 256, shm, p);
    glu_quadrant<0, 0>(p, acc, mt, nt, Cs); glu_quadrant<0, 1>(p, acc, mt, nt, Cs);
    glu_quadrant<1, 0>(p, acc, mt, nt, Cs); glu_quadrant<1, 1>(p, acc, mt, nt, Cs);
  }
  __syncthreads();
}

DI u32x4* merge_scratch(PREF p, int region) { const int t = tid512(); return (u32x4*)p.fbuf + (size_t)blockIdx.x * 40960 + region * 8192 + (t >> 6) * 1024 + (t & 63); }
DI void br_store(PREF p, const f32x4 (&acc)[2][2][4][2], int slot) {
  u32x4* sb = merge_scratch(p, slot);
#pragma unroll
  for (int ai = 0; ai < 2; ++ai)
#pragma unroll
    for (int bj = 0; bj < 2; ++bj)
#pragma unroll
      for (int m = 0; m < 4; ++m) {
        u32x4 o;
        o.x = pack2(acc[ai][bj][m][0][0], acc[ai][bj][m][0][1]); o.y = pack2(acc[ai][bj][m][0][2], acc[ai][bj][m][0][3]);
        o.z = pack2(acc[ai][bj][m][1][0], acc[ai][bj][m][1][1]); o.w = pack2(acc[ai][bj][m][1][2], acc[ai][bj][m][1][3]);
        sb[((ai * 2 + bj) * 4 + m) * 64] = o;
      }
}
DI void br_flush(PREF p, f32x4 (&acc)[2][2][4][2], int slot) { br_store(p, acc, slot); zero_acc256(acc); }
DI void gate_reg(PREF p, int l, int n, f32x4 (&acc)[2][2][4][2], int dt) {
  const u32x4* sbn = merge_scratch(p, n);
  u32x4* ssum = merge_scratch(p, 4);
  const int t = tid512(), wid = t >> 6, lane = t & 63, wc = wid & 3, fr = lane & 15;
  const float* bm = p.b_merge + (size_t)l * 4096 + n * 1024 + dt * 256 + wc * 32 + fr;
  float bias[2][2];
#pragma unroll
  for (int bj = 0; bj < 2; ++bj)
#pragma unroll
    for (int nn = 0; nn < 2; ++nn) bias[bj][nn] = bm[bj * 128 + nn * 16];
#pragma unroll
  for (int ai = 0; ai < 2; ++ai)
#pragma unroll
    for (int bj = 0; bj < 2; ++bj) {
      __builtin_amdgcn_sched_barrier(0);
      u32x4 bn[4], pv[4];
#pragma unroll
      for (int m = 0; m < 4; ++m) {
        bn[m] = sbn[((ai * 2 + bj) * 4 + m) * 64];
        if (n > 0) pv[m] = ssum[((ai * 2 + bj) * 4 + m) * 64];
      }
#pragma unroll
      for (int m = 0; m < 4; ++m) {
        float b[8]; unpack8(bn[m], b);
        float v[8];
#pragma unroll
        for (int nn = 0; nn < 2; ++nn)
#pragma unroll
          for (int j = 0; j < 4; ++j) v[nn * 4 + j] = sigm(acc[ai][bj][m][nn][j] + bias[bj][nn]) * b[nn * 4 + j];
        if (n > 0) {
          float o[8]; unpack8(pv[m], o);
#pragma unroll
          for (int e = 0; e < 8; ++e) v[e] += o[e];
        }
        if (n < 3) ssum[((ai * 2 + bj) * 4 + m) * 64] = pack8(v);
#pragma unroll
        for (int nn = 0; nn < 2; ++nn)
#pragma unroll
          for (int j = 0; j < 4; ++j) acc[ai][bj][m][nn][j] = v[nn * 4 + j];
      }
    }
}
template <int AI, int BJ>
DI void mg_quadrant(PREF p, const f32x4 (&acc)[2][2][4][2], int mt, int dt, float* Cs) {
  const int t = tid512();
  const int row0 = mt * 256 + AI * 128, col0 = dt * 256 + BJ * 128;
  stage_q<AI, BJ>(acc, Cs);
#pragma unroll
  for (int q = 0; q < 4; ++q) {
    int r = (t >> 4) + 32 * q, c = (t & 15) * 8;
    float v[8]; ld8(Cs + r * CST + c, v);
    *(u32x4*)(p.mg + (size_t)(row0 + r) * 1024 + col0 + c) = pack8(v);
  }
}
DI void merge_phase(PREF p, int l, unsigned char* lds_all) {
  u16* shm = (u16*)lds_all; float* Cs = (float*)lds_all;
  const u16* W = p.wts + (size_t)l * WL;
  for (int k = 0;; ++k) {
    int mt, dt;
    if (!xcd_tile256(k, 4, mt, dt)) break;
    {
      f32x4 acc[2][2][4][2]; zero_acc256(acc);
      gemm256<1024, 256, 1024, 1>(acc, p.ys + (size_t)mt * 256 * 1024, W + O_BR + (size_t)dt * 256 * 256, shm, p);
      br_store(p, acc, 3);
    }
#pragma unroll 1
    for (int n = 0; n < 4; ++n) {
      f32x4 acc[2][2][4][2]; zero_acc256(acc);
      gemm256<1024, 1024, 1024>(acc, p.X + (size_t)mt * 256 * 1024, W + O_WM + ((size_t)n * 1024 + dt * 256) * 1024, shm, p);
      gate_reg(p, l, n, acc, dt);
      if (n == 3) {
        mg_quadrant<0, 0>(p, acc, mt, dt, Cs); mg_quadrant<0, 1>(p, acc, mt, dt, Cs);
        mg_quadrant<1, 0>(p, acc, mt, dt, Cs); mg_quadrant<1, 1>(p, acc, mt, dt, Cs);
      }
    }
  }
  __syncthreads();
}

template <int AI, int BJ>
DI void f1_load(PREF p, int l, int mt, int dt, float4 (&xa)[4], float4 (&xb)[4]) {
  const int t = tid512();
  const int row0 = mt * 256 + AI * 128, col0 = dt * 256 + BJ * 128, c = (t & 15) * 8;
  if (l == 0) {
#pragma unroll
    for (int q = 0; q < 4; ++q) {
      const float4* xs = (const float4*)(p.x + (size_t)(row0 + (t >> 4) + 32 * q) * 1024 + col0 + c);
      xa[q] = xs[0]; xb[q] = xs[1];
    }
  } else {
#pragma unroll
    for (int q = 0; q < 4; ++q) {
      float f[8]; unpack8(*(const u32x4*)(p.X + (size_t)(row0 + (t >> 4) + 32 * q) * 1024 + col0 + c), f);
      xa[q] = make_float4(f[0], f[1], f[2], f[3]); xb[q] = make_float4(f[4], f[5], f[6], f[7]);
    }
  }
}
template <int AI, int BJ>
DI void f1_proc(PREF p, const f32x4 (&acc)[2][2][4][2], int mt, int dt, float* Cs, const float4 (&xa)[4], const float4 (&xb)[4]) {
  const int t = tid512();
  const int row0 = mt * 256 + AI * 128, col0 = dt * 256 + BJ * 128, c = (t & 15) * 8;
  const float alpha = 1.681792830507429f;
  stage_q<AI, BJ>(acc, Cs);
#pragma unroll
  for (int q = 0; q < 4; ++q) {
    int r = (t >> 4) + 32 * q;
    float v[8]; ld8(Cs + r * CST + c, v);
    float4 a = xa[q], b = xb[q];
    float y[8] = {alpha * a.x + v[0], alpha * a.y + v[1], alpha * a.z + v[2], alpha * a.w + v[3],
                  alpha * b.x + v[4], alpha * b.y + v[5], alpha * b.z + v[6], alpha * b.w + v[7]};
    *(u32x4*)((u16*)p.fbuf + (size_t)(row0 + r) * 1024 + col0 + c) = pack8(y);
  }
}
DI void f1_phase(PREF p, int l, unsigned char* lds_all) {
  u16* shm = (u16*)lds_all; float* Cs = (float*)lds_all;
  for (int k = 0;; ++k) {
    int mt, dt;
    if (!xcd_tile256(k, 4, mt, dt)) break;
    f32x4 acc[2][2][4][2]; zero_acc256(acc);
    gemm256<1024, 1024, 1024>(acc, p.mg + (size_t)mt * 256 * 1024, p.wts + (size_t)l * WL + O_OUT + (size_t)dt * 256 * 1024, shm, p);
    {
      float4 aA[4], bA[4];
      f1_load<0, 0>(p, l, mt, dt, aA, bA); f1_proc<0, 0>(p, acc, mt, dt, Cs, aA, bA);
      f1_load<0, 1>(p, l, mt, dt, aA, bA); f1_proc<0, 1>(p, acc, mt, dt, Cs, aA, bA);
      f1_load<1, 0>(p, l, mt, dt, aA, bA); f1_proc<1, 0>(p, acc, mt, dt, Cs, aA, bA);
      f1_load<1, 1>(p, l, mt, dt, aA, bA); f1_proc<1, 1>(p, acc, mt, dt, Cs, aA, bA);
    }
  }
  __syncthreads();
}

template <int AI, int BJ>
DI void f3_load(PREF p, int mt, int dt, u32x4 (&g)[4]) {
  const int t = tid512();
  const int row0 = mt * 256 + AI * 128, col0 = dt * 256 + BJ * 128, c = (t & 15) * 8;
#pragma unroll
  for (int q = 0; q < 4; ++q) g[q] = *(const u32x4*)((const u16*)p.fbuf + (size_t)(row0 + (t >> 4) + 32 * q) * 1024 + col0 + c);
}
template <int AI, int BJ, int PASS>
DI void f3_proc(PREF p, const f32x4 (&acc)[2][2][4][2], int mt, int dt, float* Cs, const u32x4 (&g)[4]) {
  const int t = tid512();
  const int row0 = mt * 256 + AI * 128, col0 = dt * 256 + BJ * 128;
  const int c = (t & 15) * 8;
  stage_q<AI, BJ>(acc, Cs);
#pragma unroll
  for (int q = 0; q < 4; ++q) {
    int r = (t >> 4) + 32 * q;
    float v[8]; ld8(Cs + r * CST + c, v);
    if (PASS == 0) {
#pragma unroll
      for (int j = 0; j < 8; ++j) v[j] = sigm(v[j]);
    } else {
      float gf[8]; unpack8(g[q], gf);
#pragma unroll
      for (int j = 0; j < 8; ++j) v[j] *= gf[j];
    }
    *(u32x4*)((u16*)p.fbuf + (size_t)(row0 + r) * 1024 + col0 + c) = pack8(v);
  }
}
DI void f3_phase(PREF p, int l, unsigned char* lds_all) {
  u16* shm = (u16*)lds_all; float* Cs = (float*)lds_all;
  const u16* W = p.wts + (size_t)l * WL;
  for (int k = 0;; ++k) {
    int mt, dt;
    if (!xcd_tile256(k, 4, mt, dt)) break;
    {
      f32x4 acc[2][2][4][2]; zero_acc256(acc);
      gemm256<1024, 1024, 1024>(acc, p.X + (size_t)mt * 256 * 1024, W + O_PLEG + (size_t)dt * 256 * 1024, shm, p);
      u32x4 gd[4];
      f3_proc<0, 0, 0>(p, acc, mt, dt, Cs, gd); f3_proc<0, 1, 0>(p, acc, mt, dt, Cs, gd);
      f3_proc<1, 0, 0>(p, acc, mt, dt, Cs, gd); f3_proc<1, 1, 0>(p, acc, mt, dt, Cs, gd);
    }
    f32x4 acc[2][2][4][2]; zero_acc256(acc);
    gemm256<256, 256, 256>(acc, p.pb + (size_t)mt * 256 * 256, W + O_PLE + (size_t)dt * 256 * 256, shm, p);
    {
      u32x4 gA[4], gB[4];
      f3_load<0, 0>(p, mt, dt, gA);
      f3_load<0, 1>(p, mt, dt, gB); f3_proc<0, 0, 1>(p, acc, mt, dt, Cs, gA);
      f3_load<1, 0>(p, mt, dt, gA); f3_proc<0, 1, 1>(p, acc, mt, dt, Cs, gB);
      f3_load<1, 1>(p, mt, dt, gB); f3_proc<1, 0, 1>(p, acc, mt, dt, Cs, gA);
      f3_proc<1, 1, 1>(p, acc, mt, dt, Cs, gB);
    }
  }
  __syncthreads();
}

DI void rows_ln(PREF p, int l) {
  const int tid = tidx(), lane = tid & 63, w = tid >> 6;
  float gg[16], bb[16];
#pragma unroll
  for (int h = 0; h < 2; ++h) {
    const int c = h * 512 + lane * 8;
    const float4 g0 = *(const float4*)(p.ln_g + l * 1024 + c), g1 = *(const float4*)(p.ln_g + l * 1024 + c + 4);
    const float4 b0 = *(const float4*)(p.ln_b + l * 1024 + c), b1 = *(const float4*)(p.ln_b + l * 1024 + c + 4);
    gg[h * 8 + 0] = g0.x; gg[h * 8 + 1] = g0.y; gg[h * 8 + 2] = g0.z; gg[h * 8 + 3] = g0.w;
    gg[h * 8 + 4] = g1.x; gg[h * 8 + 5] = g1.y; gg[h * 8 + 6] = g1.z; gg[h * 8 + 7] = g1.w;
    bb[h * 8 + 0] = b0.x; bb[h * 8 + 1] = b0.y; bb[h * 8 + 2] = b0.z; bb[h * 8 + 3] = b0.w;
    bb[h * 8 + 4] = b1.x; bb[h * 8 + 5] = b1.y; bb[h * 8 + 6] = b1.z; bb[h * 8 + 7] = b1.w;
  }
  for (int row = vbid() * 4 + w; row < T_ / 2; row += vgrid() * 4) {
    u32x4 raw[2][2];
#pragma unroll
    for (int k = 0; k < 2; ++k) {
      const u16* src = (const u16*)p.fbuf + (size_t)(row + k * (T_ / 2)) * 1024;
      raw[k][0] = *(const u32x4*)(src + lane * 8);
      raw[k][1] = *(const u32x4*)(src + 512 + lane * 8);
    }
#pragma unroll
    for (int k = 0; k < 2; ++k) {
      float v[16];
      unpack8(raw[k][0], v); unpack8(raw[k][1], v + 8);
      float s = 0.f;
#pragma unroll
      for (int i = 0; i < 16; ++i) s += v[i];
      const float mu = wsum(s) * (1.f / 1024.f);
      float sq = 0.f;
#pragma unroll
      for (int i = 0; i < 16; ++i) { v[i] -= mu; sq += v[i] * v[i]; }
      const float rs = rsqrtf(wsum(sq) * (1.f / 1024.f) + 1e-5f);
#pragma unroll
      for (int h = 0; h < 2; ++h) {
        float y[8];
#pragma unroll
        for (int j = 0; j < 8; ++j) y[j] = v[h * 8 + j] * rs * gg[h * 8 + j] + bb[h * 8 + j];
        *(u32x4*)(p.X + (size_t)(row + k * (T_ / 2)) * 1024 + h * 512 + lane * 8) = pack8(y);
      }
    }
  }
}

DI void rows_ple(PREF p, int l) {
  const int tid = tidx(), lane = tid & 63, w = tid >> 6;
  for (int row = vbid() * 4 + w; row < T_; row += vgrid() * 4) {
    const u16* src = (const u16*)p.fbuf + (size_t)row * 1024;
    float v[16];
    unpack8(*(const u32x4*)(src + lane * 8), v);
    unpack8(*(const u32x4*)(src + 512 + lane * 8), v + 8);
    float xv[16];
    unpack8(*(const u32x4*)(p.X + (size_t)row * 1024 + lane * 8), xv);
    unpack8(*(const u32x4*)(p.X + (size_t)row * 1024 + 512 + lane * 8), xv + 8);
    float sq = 0.f;
#pragma unroll
    for (int i = 0; i < 16; ++i) sq += v[i] * v[i];
    const float rs = rsqrtf(wsum(sq) * (1.f / 1024.f) + 1e-6f);
#pragma unroll
    for (int h = 0; h < 2; ++h) {
      const int c = h * 512 + lane * 8;
      const float4 g0 = *(const float4*)(p.ple_ng + l * 1024 + c), g1 = *(const float4*)(p.ple_ng + l * 1024 + c + 4);
      float y[8];
      y[0] = xv[h * 8 + 0] + v[h * 8 + 0] * rs * g0.x; y[1] = xv[h * 8 + 1] + v[h * 8 + 1] * rs * g0.y;
      y[2] = xv[h * 8 + 2] + v[h * 8 + 2] * rs * g0.z; y[3] = xv[h * 8 + 3] + v[h * 8 + 3] * rs * g0.w;
      y[4] = xv[h * 8 + 4] + v[h * 8 + 4] * rs * g1.x; y[5] = xv[h * 8 + 5] + v[h * 8 + 5] * rs * g1.y;
      y[6] = xv[h * 8 + 6] + v[h * 8 + 6] * rs * g1.z; y[7] = xv[h * 8 + 7] + v[h * 8 + 7] * rs * g1.w;
      if (l == NL - 1) {
        float4* od = (float4*)(p.out + (size_t)row * 1024 + c);
        od[0] = make_float4(y[0], y[1], y[2], y[3]); od[1] = make_float4(y[4], y[5], y[6], y[7]);
      } else {
        *(u32x4*)(p.X + (size_t)row * 1024 + c) = pack8(y);
      }
    }
  }
}

DI void phase_mix1(PREF p, int l, unsigned char* ldsb) {
  for (int it = vbid(); it < 1024; it += vgrid()) {
    int pi = it >> 1, b = pi >> 6, hq = ((pi >> 5) & 1) * 2 + (it & 1), qb = pi & 31;
    const u16* hbb = p.hb + (size_t)b * S_ * HW;
    attn_item<64, true>(hbb + OFF_SQ + hq * 64, HW, hbb + OFF_SK + (hq >> 1) * 64, HW,
                        p.Vst + (size_t)(b * 2 + (hq >> 1)) * 64 * S_, qb, 0.125f * LOG2E, p.sinks[l * 4 + hq] * 8.0f,
                        hbb + OFF_DZ + hq * 64, HW, p.ys + (size_t)b * S_ * 1024 + 768 + hq * 64, 1024, (u16*)ldsb);
  }
  for (int it = vbid(); it < 1024; it += vgrid()) kv_tile(p, l, it, ldsb);
  for (int it = vbid(); it < 768; it += vgrid()) q_tile(p, l, it, ldsb);
  for (int it = vbid(); it < 1024; it += vgrid()) conv_item(p, l, it, ldsb);
  for (int it = vbid(); it < 2048; it += vgrid()) ssm1_item(p, l, it, ldsb);
}
DI void phase_mix2(PREF p, int l, unsigned char* ldsb) {
  for (int it = vbid(); it < 1024; it += vgrid()) {
    int qb = (it < 512) ? 31 - (it >> 5) : ((it - 512) >> 5);
    int bh = it & 31, b = bh >> 2, head = bh & 3;
    attn_item<96, false>(p.Qm + (size_t)b * S_ * 384 + head * 96, 384, p.Km + (size_t)b * S_ * 384 + head * 96, 384,
                         p.Vmt + (size_t)(b * 4 + head) * 64 * S_, qb, 0.10206207261596577f * LOG2E, 0.f,
                         p.hb + (size_t)b * S_ * HW + OFF_BZ + head * 64, HW, p.ys + (size_t)b * S_ * 1024 + 256 + head * 64, 1024,
                         (u16*)ldsb);
  }
  for (int it = vbid(); it < 512; it += vgrid()) pw2_tile(p, l, it, ldsb);
  for (int it = vbid(); it < 2048; it += vgrid()) ssm2_item(p, l, it, ldsb);
}

DI void grid_barrier(unsigned* bar, unsigned gen) {
  asm volatile("s_waitcnt vmcnt(0)" ::: "memory");
  __syncthreads();
  if (threadIdx.x == 0) {
    __builtin_amdgcn_fence(__ATOMIC_RELEASE, "agent");
    const unsigned grp = blockIdx.x & 15u;
    const unsigned nblk = (gridDim.x + 15u - grp) >> 4;
    unsigned old = __hip_atomic_fetch_add(bar + 64 * (1 + grp), 1u, __ATOMIC_RELAXED, __HIP_MEMORY_SCOPE_AGENT);
    if (old + 1u == nblk * gen) {
      unsigned g = __hip_atomic_fetch_add(bar, 1u, __ATOMIC_RELAXED, __HIP_MEMORY_SCOPE_AGENT);
      if (g + 1u == 16u * gen) {
        for (int i = 0; i < 16; ++i) __hip_atomic_store(bar + 64 * (17 + i), gen, __ATOMIC_RELAXED, __HIP_MEMORY_SCOPE_AGENT);
      }
    }
    while (__hip_atomic_load(bar + 64 * (17 + grp), __ATOMIC_RELAXED, __HIP_MEMORY_SCOPE_AGENT) < gen) __builtin_amdgcn_s_sleep(4);
    __builtin_amdgcn_fence(__ATOMIC_ACQUIRE, "agent");
  }
  __syncthreads();
}

template <int J>
DI void run_phase(PREF p, int l, unsigned char* ldsb, unsigned char* lds_all) {
  if (J == 0) phase_in(p, l, lds_all);
  else if (J == 1) phase_mix1(p, l, ldsb);
  else if (J == 2) phase_mix2(p, l, ldsb);
  else if (J == 3) glu_phase(p, l, lds_all);
  else if (J == 4) merge_phase(p, l, lds_all);
  else if (J == 5) f1_phase(p, l, lds_all);
  else if (J == 6) rows_ln(p, l);
  else if (J == 7) f3_phase(p, l, lds_all);
  else if (J == 8) rows_ple(p, l);
  else phase_prep(p, ldsb);
}

#if MULTI_LAUNCH
template <int J>
__global__ void __launch_bounds__(256, 2) phk(Params p, int l) {
  __shared__ __attribute__((aligned(16))) unsigned char ldsb[LDS_BYTES];
  run_phase<J>(p, l, ldsb);
}
#else
__global__ void __launch_bounds__(512, 2) mega(Params p_unused, int ph0, int ph1) {
  __shared__ __attribute__((aligned(16))) unsigned char lds_all[LDS_BYTES];
  unsigned char* ldsb = lds_all + half_() * LDS_HALF;
  cg::grid_group grid = cg::this_grid();
  for (int ph = ph0; ph < ph1; ++ph) {
    const __attribute__((address_space(4))) Params* pp = (const __attribute__((address_space(4))) Params*)__builtin_amdgcn_kernarg_segment_ptr();
    asm volatile("" : "+s"(pp));
    PREF p = *pp;
    if (ph1 < 0) grid.sync();
    if (ph > ph0) grid_barrier(p.bar, (unsigned)(ph - ph0));
    if (ph == 0) { run_phase<9>(p, 0, ldsb, lds_all); continue; }
    int l = (ph - 1) / NPH_LAYER; const int j = (ph - 1) % NPH_LAYER;
    asm volatile("" : "+s"(l));
    if (j == 0) run_phase<0>(p, l, ldsb, lds_all);
    else if (j == 1) run_phase<1>(p, l, ldsb, lds_all);
    else if (j == 2) run_phase<2>(p, l, ldsb, lds_all);
    else if (j == 3) run_phase<3>(p, l, ldsb, lds_all);
    else if (j == 4) run_phase<4>(p, l, ldsb, lds_all);
    else if (j == 5) run_phase<5>(p, l, ldsb, lds_all);
    else if (j == 6) run_phase<6>(p, l, ldsb, lds_all);
    else if (j == 7) run_phase<7>(p, l, ldsb, lds_all);
    else run_phase<8>(p, l, ldsb, lds_all);
  }
}
#endif

extern "C" void kernel_launch(void* const* d_in, const int* in_sizes, int n_in, void* d_out, int out_size, void* d_ws,
                              size_t ws_size, hipStream_t stream) {
  static int grid_blocks = 0;
  if (!grid_blocks) {
    int dev = 0, cus = 0, per_cu = 2;
    (void)hipGetDevice(&dev);
    (void)hipDeviceGetAttribute(&cus, hipDeviceAttributeMultiprocessorCount, dev);
#if !MULTI_LAUNCH
    (void)hipOccupancyMaxActiveBlocksPerMultiprocessor(&per_cu, mega, 512, 0);
    per_cu = 1;
#endif
    if (cus < 1) cus = 256;
    grid_blocks = cus * per_cu;
  }
  Params p{};
  const float** f = (const float**)&p;
  for (int i = 0; i < 31; ++i) f[i] = (const float*)d_in[i];
  p.out = (float*)d_out;
  unsigned char* ws = (unsigned char*)d_ws;
  size_t off = 0;
  auto take = [&](size_t bytes) { unsigned char* r = ws + off; off += (bytes + 255) & ~(size_t)255; return r; };
  p.wts = (u16*)take(WL * NL * 2);
  p.lam = (float*)take((size_t)NL * 16 * 64 * 2 * 4);
  p.bbre = (float*)take((size_t)NL * 16 * 64 * 16 * 4);
  p.bbim = (float*)take((size_t)NL * 16 * 64 * 16 * 4);
  p.rcos = (float*)take((size_t)S_ * 16 * 4);
  p.rsin = (float*)take((size_t)S_ * 16 * 4);
  p.X = (u16*)take((size_t)T_ * 1024 * 2);
  p.pb = (u16*)take((size_t)T_ * 256 * 2);
  p.hb = (u16*)take((size_t)T_ * HW * 2);
  p.ys = (u16*)take((size_t)T_ * 1024 * 2);
  p.cA = (u16*)take((size_t)T_ * 256 * 2);
  p.Qm = (u16*)take((size_t)T_ * 384 * 2);
  p.Km = (u16*)take((size_t)T_ * 384 * 2);
  p.Vmt = (u16*)take((size_t)T_ * 256 * 2);
  p.Vst = (u16*)take((size_t)T_ * 128 * 2);
  p.yss = (u16*)take((size_t)T_ * 256 * 2);
  p.hend = (float*)take((size_t)8 * 16 * 64 * 64 * 2 * 4);
  p.bar = (unsigned*)take(16384);
  p.mg = p.cA;
  p.fbuf = (float*)p.hb;
  if (off > ws_size) fprintf(stderr, "workspace too small: need %zu have %zu\n", off, ws_size);
  const int NPH = 1 + NPH_LAYER * NL;
#if MULTI_LAUNCH
  (void)NPH;
  const dim3 g(grid_blocks), b(256);
  hipLaunchKernelGGL(phk<9>, g, b, 0, stream, p, 0);
  for (int l = 0; l < NL; ++l) {
    hipLaunchKernelGGL(phk<0>, g, b, 0, stream, p, l);
    hipLaunchKernelGGL(phk<1>, g, b, 0, stream, p, l);
    hipLaunchKernelGGL(phk<2>, g, b, 0, stream, p, l);
    hipLaunchKernelGGL(phk<3>, g, b, 0, stream, p, l);
    hipLaunchKernelGGL(phk<4>, g, b, 0, stream, p, l);
    hipLaunchKernelGGL(phk<5>, g, b, 0, stream, p, l);
    hipLaunchKernelGGL(phk<6>, g, b, 0, stream, p, l);
    hipLaunchKernelGGL(phk<7>, g, b, 0, stream, p, l);
    hipLaunchKernelGGL(phk<8>, g, b, 0, stream, p, l);
  }
#else
  int ph0 = 0, ph1 = NPH;
  (void)hipMemsetAsync(p.bar, 0, 16384, stream);
  void* args[] = {&p, &ph0, &ph1};
  hipError_t e = hipLaunchCooperativeKernel((void*)mega, dim3(grid_blocks), dim3(512), args, 0, stream);
  if (e != hipSuccess) fprintf(stderr, "cooperative launch failed: %s (grid %d)\n", hipGetErrorString(e), grid_blocks);
#endif
}
```

```cpp
#include <hip/hip_runtime.h>
#include <hip/hip_cooperative_groups.h>
#include <cstdio>
#include <type_traits>
namespace cg = cooperative_groups;

#ifndef MULTI_LAUNCH
#define MULTI_LAUNCH 0
#endif

typedef unsigned short u16;
typedef __attribute__((ext_vector_type(8))) short bf16x8;
typedef __attribute__((ext_vector_type(4))) float f32x4;
typedef __attribute__((ext_vector_type(16))) float f32x16;
typedef __attribute__((ext_vector_type(4))) unsigned u32x4;
typedef __attribute__((ext_vector_type(2))) unsigned u32x2;
#define DI __device__ __forceinline__
DI int tidx() { int t = threadIdx.x & 255; asm volatile("" : "+v"(t)); return t; }
DI int half_() { return __builtin_amdgcn_readfirstlane((int)(threadIdx.x >> 8)); }
DI int vbid() { return (int)blockIdx.x * 2 + half_(); }
DI int vgrid() { return (int)gridDim.x * 2; }

constexpr int T_ = 32768, S_ = 4096, D_ = 1024, HW = 2720, NL = 4;
constexpr int OFF_AVAL = 0, OFF_AGATE = 256, OFF_AZ = 512, OFF_CQ = 768, OFF_CKV = 1024, OFF_KR = 1152, OFF_BZ = 1184,
              OFF_U = 1440, OFF_CZ = 1696, OFF_SQ = 1952, OFF_SK = 2208, OFF_SV = 2336, OFF_DZ = 2464;
constexpr size_t O_WIN = 0, O_WM = O_WIN + 2816 * 1024, O_PW2 = O_WM + 4096 * 1024, O_UQ = O_PW2 + 65536, O_UKV = O_UQ + 98304,
                 O_GLU = O_UKV + 65536, O_BR = O_GLU + 131072, O_OUT = O_BR + 1048576, O_PLE = O_OUT + 1048576,
                 O_PLEG = O_PLE + 262144, WL = O_PLEG + 1048576;
constexpr int LDT = 64;
constexpr int TILE_E = 128 * LDT;
constexpr int CST = 132;
constexpr int LDS_MAIN = 73728;
constexpr int LDS_HALF = LDS_MAIN + 1024;
constexpr int LDS_BYTES = 2 * LDS_HALF;
constexpr float LOG2E = 1.4426950408889634f;
constexpr int NPH_LAYER = 9;

struct Params {
  const float *x, *p, *w_in, *w_merge, *b_merge, *conv_w, *conv_b, *conv_ng, *conv_nb, *w_pw2, *qng, *kvng, *w_uq, *w_ukv,
      *a_re, *a_im, *log_dt, *b_re, *b_im, *c_re, *c_im, *ssm_d, *w_glu, *sinks, *w_branch, *w_out, *ln_g, *ln_b, *w_ple,
      *w_pleg, *ple_ng;
  float* out;
  u16* wts;
  float *lam, *bbre, *bbim, *rcos, *rsin;
  u16 *X, *pb, *hb, *ys, *cA, *Qm, *Km, *Vmt, *Vst, *yss, *mg;
  float *hend, *fbuf;
  unsigned* bar;
};

typedef const __attribute__((address_space(4))) Params& PREF;

DI unsigned pack2(float a, float b) { unsigned r; asm("v_cvt_pk_bf16_f32 %0, %1, %2\n\ts_nop 1" : "=v"(r) : "v"(a), "v"(b)); return r; }
DI u16 f2bf(float x) { return (u16)(pack2(x, x) & 0xffffu); }
DI float bf2f(u16 v) { return __uint_as_float(((unsigned)v) << 16); }
DI float lo2f(unsigned u) { return __uint_as_float(u << 16); }
DI float hi2f(unsigned u) { return __uint_as_float(u & 0xffff0000u); }
DI float sigm(float x) { return 1.f / (1.f + __expf(-x)); }
DI float silu(float x) { return x / (1.f + __expf(-x)); }
DI float gelu_t(float x) { float u = 0.7978845608028654f * (x + 0.044715f * x * x * x); return 0.5f * x * (1.f + tanhf(u)); }
DI void unpack8(u32x4 v, float* f) {
  f[0] = lo2f(v.x); f[1] = hi2f(v.x); f[2] = lo2f(v.y); f[3] = hi2f(v.y);
  f[4] = lo2f(v.z); f[5] = hi2f(v.z); f[6] = lo2f(v.w); f[7] = hi2f(v.w);
}
DI u32x4 pack8(const float* f) { u32x4 o; o.x = pack2(f[0], f[1]); o.y = pack2(f[2], f[3]); o.z = pack2(f[4], f[5]); o.w = pack2(f[6], f[7]); return o; }
DI float wsum(float v) {
#pragma unroll
  for (int o = 32; o >= 1; o >>= 1) v += __shfl_xor(v, o);
  return v;
}
#define MFMA32(a, b, c) __builtin_amdgcn_mfma_f32_32x32x16_bf16((a), (b), (c), 0, 0, 0)
#define MFMA16(a, b, c) __builtin_amdgcn_mfma_f32_16x16x32_bf16((a), (b), (c), 0, 0, 0)

DI void zero_acc(f32x4 (&a)[4][4]) {
#pragma unroll
  for (int i = 0; i < 4; ++i)
#pragma unroll
    for (int j = 0; j < 4; ++j)
#pragma unroll
      for (int k = 0; k < 4; ++k) a[i][j][k] = 0.f;
}

#define GM_LOAD(RA, RB, KT)                                                                 \
  _Pragma("unroll") for (int i = 0; i < 4; ++i) {                                           \
    RA[i] = *(const u32x4*)(ag + (size_t)(32 * i) * lda + (KT) * 64);                       \
    RB[i] = *(const u32x4*)(bg + (size_t)(32 * i) * ldb + (KT) * 64);                       \
  }
#define GM_STORE(RA, RB, STG)                                                               \
  {                                                                                         \
    u16* dA_ = lds + (STG) * 2 * TILE_E;                                                    \
    _Pragma("unroll") for (int i = 0; i < 4; ++i) {                                         \
      *(u32x4*)(dA_ + (lrow + 32 * i) * LDT + lsw) = RA[i];                                 \
      *(u32x4*)(dA_ + TILE_E + (lrow + 32 * i) * LDT + lsw) = RB[i];                        \
    }                                                                                       \
  }
#define GM_COMPUTE(STG)                                                                     \
  {                                                                                         \
    const u16* sA = lds + (STG) * 2 * TILE_E + (wm * 64 + fr) * LDT;                        \
    const u16* sB = lds + (STG) * 2 * TILE_E + TILE_E + (wn * 64 + fr) * LDT;               \
    __builtin_amdgcn_s_setprio(1);                                                          \
    _Pragma("unroll") for (int kk = 0; kk < 2; ++kk) {                                      \
      const int co = (((kk * 4 + fq) ^ (fr & 7)) * 8);                                      \
      bf16x8 af[4];                                                                         \
      _Pragma("unroll") for (int m = 0; m < 4; ++m) af[m] = *(const bf16x8*)(sA + m * 16 * LDT + co);   \
      _Pragma("unroll") for (int n = 0; n < 4; ++n) {                                       \
        const bf16x8 bfr = *(const bf16x8*)(sB + n * 16 * LDT + co);                        \
        _Pragma("unroll") for (int m = 0; m < 4; ++m) acc[m][n] = MFMA16(af[m], bfr, acc[m][n]);        \
      }                                                                                     \
    }                                                                                       \
    __builtin_amdgcn_s_setprio(0);                                                          \
  }
template <bool DEEP = true>
DI void gemm_main(f32x4 (&acc)[4][4], const u16* __restrict__ A, int lda, const u16* __restrict__ B, int ldb, int K, u16* lds) {
  const int tid = tidx(), lane = tid & 63, w = tid >> 6;
  const int wm = w >> 1, wn = w & 1, fr = lane & 15, fq = lane >> 4;
  const int lrow = tid >> 3, lch = (tid & 7) * 8, lsw = ((tid & 7) ^ (lrow & 7)) * 8;
  const u16* ag = A + (size_t)lrow * lda + lch;
  const u16* bg = B + (size_t)lrow * ldb + lch;
  const int nk = K >> 6;
  if (DEEP) {
    u32x4 ra0[4], rb0[4], ra1[4], rb1[4];
    GM_LOAD(ra0, rb0, 0)
    GM_LOAD(ra1, rb1, 1)
    __syncthreads();
    GM_STORE(ra0, rb0, 0)
    __syncthreads();
    for (int kt = 0; kt < nk; kt += 2) {
      if (kt + 2 < nk) { GM_LOAD(ra0, rb0, kt + 2) }
      GM_COMPUTE(0)
      __builtin_amdgcn_sched_barrier(0);
      GM_STORE(ra1, rb1, 1)
      __syncthreads();
      if (kt + 3 < nk) { GM_LOAD(ra1, rb1, kt + 3) }
      GM_COMPUTE(1)
      __builtin_amdgcn_sched_barrier(0);
      if (kt + 2 < nk) { GM_STORE(ra0, rb0, 0) }
      __syncthreads();
    }
  } else {
    u32x4 ra0[4], rb0[4];
    GM_LOAD(ra0, rb0, 0)
    __syncthreads();
    GM_STORE(ra0, rb0, 0)
    __syncthreads();
    for (int kt = 0; kt < nk; kt += 2) {
      GM_LOAD(ra0, rb0, kt + 1)
      GM_COMPUTE(0)
      __builtin_amdgcn_sched_barrier(0);
      GM_STORE(ra0, rb0, 1)
      __syncthreads();
      if (kt + 2 < nk) { GM_LOAD(ra0, rb0, kt + 2) }
      GM_COMPUTE(1)
      __builtin_amdgcn_sched_barrier(0);
      if (kt + 2 < nk) { GM_STORE(ra0, rb0, 0) }
      __syncthreads();
    }
  }
}

DI void stage_c(const f32x4 (&acc)[4][4], float* Cs) {
  const int tid = tidx(), lane = tid & 63, w = tid >> 6;
  const int wm = w >> 1, wn = w & 1, fr = lane & 15, fq = lane >> 4;
#pragma unroll
  for (int m = 0; m < 4; ++m)
#pragma unroll
    for (int n = 0; n < 4; ++n)
#pragma unroll
      for (int j = 0; j < 4; ++j) Cs[(wm * 64 + m * 16 + fq * 4 + j) * CST + wn * 64 + n * 16 + fr] = acc[m][n][j];
  __syncthreads();
}
DI void ld8(const float* Cs, float* v) {
  float4 a = *(const float4*)Cs, b = *(const float4*)(Cs + 4);
  v[0] = a.x; v[1] = a.y; v[2] = a.z; v[3] = a.w; v[4] = b.x; v[5] = b.y; v[6] = b.z; v[7] = b.w;
}

DI void prep_w(const float* __restrict__ src, int K, int N, u16* __restrict__ dst, int Npad, const float* __restrict__ g, int perm,
               u16* T) {
  const int tid = tidx();
  const int ntn = Npad >> 6, ntiles = (K >> 6) * ntn;
  for (int it = vbid(); it < ntiles; it += vgrid()) {
    const int kt = it / ntn, k0 = kt * 64, n0 = (it - kt * ntn) * 64;
    int sn0 = n0;
    if (perm) { int tl = n0 >> 7, rr = n0 & 127; sn0 = (rr < 64) ? (tl * 64 + rr) : (256 + tl * 64 + rr - 64); }
    __syncthreads();
    {
      const int nn = tid & 63, kq = tid >> 6;
      const bool valid = (n0 + nn) < N;
      float v[16];
#pragma unroll
      for (int i = 0; i < 16; ++i) v[i] = valid ? src[(size_t)(k0 + kq + 4 * i) * N + sn0 + nn] : 0.f;
      if (g) {
#pragma unroll
        for (int i = 0; i < 16; ++i) v[i] *= g[k0 + kq + 4 * i];
      }
#pragma unroll
      for (int i = 0; i < 16; ++i) T[(kq + 4 * i) * 72 + nn] = f2bf(v[i]);
    }
    __syncthreads();
    {
      const int nn = tid >> 2, kc = (tid & 3) * 16;
      unsigned w[8];
#pragma unroll
      for (int j = 0; j < 8; ++j) w[j] = (unsigned)T[(kc + 2 * j) * 72 + nn] | ((unsigned)T[(kc + 2 * j + 1) * 72 + nn] << 16);
      u32x4 o0 = {w[0], w[1], w[2], w[3]}, o1 = {w[4], w[5], w[6], w[7]};
      u16* d = dst + (size_t)(n0 + nn) * K + k0 + kc;
      *(u32x4*)d = o0; *(u32x4*)(d + 8) = o1;
    }
  }
}

DI void phase_prep(PREF p, unsigned char* ldsb) {
  u16* T = (u16*)ldsb;
  const int gtid = vbid() * 256 + tidx(), gsz = vgrid() * 256;
  for (int l = 0; l < NL; ++l) {
    u16* W = p.wts + (size_t)l * WL;
    prep_w(p.w_in + (size_t)l * 1024 * HW, 1024, HW, W + O_WIN, 2816, nullptr, 0, T);
    prep_w(p.w_merge + (size_t)l * 1024 * 4096, 1024, 4096, W + O_WM, 4096, nullptr, 0, T);
    prep_w(p.w_pw2 + (size_t)l * 65536, 256, 256, W + O_PW2, 256, nullptr, 0, T);
    prep_w(p.w_uq + (size_t)l * 256 * 384, 256, 384, W + O_UQ, 384, p.qng + l * 256, 0, T);
    prep_w(p.w_ukv + (size_t)l * 128 * 512, 128, 512, W + O_UKV, 512, p.kvng + l * 128, 0, T);
    prep_w(p.w_glu + (size_t)l * 256 * 512, 256, 512, W + O_GLU, 512, nullptr, 1, T);
    for (int nb = 0; nb < 4; ++nb)
      prep_w(p.w_branch + ((size_t)l * 4 + nb) * 256 * 1024, 256, 1024, W + O_BR + (size_t)nb * 1024 * 256, 1024, nullptr, 0, T);
    prep_w(p.w_out + (size_t)l * 1048576, 1024, 1024, W + O_OUT, 1024, nullptr, 0, T);
    prep_w(p.w_ple + (size_t)l * 262144, 256, 1024, W + O_PLE, 1024, nullptr, 0, T);
    prep_w(p.w_pleg + (size_t)l * 1048576, 1024, 1024, W + O_PLEG, 1024, nullptr, 0, T);
  }
  for (int idx = gtid; idx < NL * 16 * 64; idx += gsz) {
    int lg = idx >> 6;
    float dt = expf(p.log_dt[lg]);
    float lr = p.a_re[idx], li = p.a_im[idx];
    float mag = expf(lr * dt);
    float lbr = mag * cosf(li * dt), lbi = mag * sinf(li * dt);
    float den = lr * lr + li * li;
    float nr = lbr - 1.f, ni = lbi;
    float fre = (nr * lr + ni * li) / den, fim = (ni * lr - nr * li) / den;
    p.lam[idx * 2] = lbr; p.lam[idx * 2 + 1] = lbi;
    for (int h = 0; h < 16; ++h) {
      float br = p.b_re[(size_t)idx * 16 + h], bi = p.b_im[(size_t)idx * 16 + h];
      p.bbre[(size_t)idx * 16 + h] = fre * br - fim * bi;
      p.bbim[(size_t)idx * 16 + h] = fre * bi + fim * br;
    }
  }
  for (int idx = gtid; idx < S_ * 16; idx += gsz) {
    int pos = idx >> 4, i = idx & 15;
    float inv = powf(10000.f, -(float)(2 * i) / 32.f);
    float ang = (float)pos * inv;
    p.rcos[idx] = cosf(ang); p.rsin[idx] = sinf(ang);
  }
  for (int idx = gtid; idx < T_ * D_ / 8; idx += gsz) {
    const float4* s = (const float4*)(p.x + (size_t)idx * 8);
    float4 a = s[0], b = s[1];
    float v[8] = {a.x, a.y, a.z, a.w, b.x, b.y, b.z, b.w};
    *(u32x4*)(p.X + (size_t)idx * 8) = pack8(v);
  }
}

constexpr int G_HT = 128 * 64;
DI void lds_barrier() { asm volatile("s_waitcnt lgkmcnt(0)\n\ts_barrier" ::: "memory"); }
DI int tid512() { int t = threadIdx.x; asm volatile("" : "+v"(t)); return t; }
DI void g_stage_rc(int b, int& R, int& C) {
  int st = b >> 10, sb = b & 1023, swz = sb ^ (((sb >> 9) & 1) << 5);
  R = (st >> 1) * 16 + (swz >> 6); C = (st & 1) * 32 + ((swz & 63) >> 1);
}
#define G_SA(b, h) (shm + ((b) * 2 + (h)) * G_HT)
#define G_SB(b, h) (shm + (4 + (b) * 2 + (h)) * G_HT)
#define G_STAGE(P, BASE, O0, O1, LD, br, KOFF)                                                                             \
  do {                                                                                                                    \
    const u16* g_ = (BASE) + (size_t)(br) * (LD) + (KOFF);                                                              \
    __builtin_amdgcn_global_load_lds((const unsigned*)(g_ + (O0)), (unsigned*)((char*)(P) + t * 16), 16, 0, 0);          \
    __builtin_amdgcn_global_load_lds((const unsigned*)(g_ + (O1)), (unsigned*)((char*)(P) + t * 16 + 8192), 16, 0, 0);   \
  } while (0)
#define G_LDA(dst, b, h)                                                                                                  \
  _Pragma("unroll") for (int m = 0; m < 4; ++m) _Pragma("unroll") for (int k = 0; k < 2; ++k)                             \
      dst[m][k] = *(const bf16x8*)((const char*)G_SA(b, h) + ((wr * 4 + m) * 2 + k) * 1024 + rdo)
#define G_LDB(dst, b, h)                                                                                                  \
  _Pragma("unroll") for (int n = 0; n < 2; ++n) _Pragma("unroll") for (int k = 0; k < 2; ++k)                             \
      dst[n][k] = *(const bf16x8*)((const char*)G_SB(b, h) + ((wc * 2 + n) * 2 + k) * 1024 + rdo)
#define G_MMA(ai, bj, At, Bt)                                                                                             \
  do {                                                                                                                    \
    __builtin_amdgcn_s_setprio(1);                                                                                        \
    _Pragma("unroll") for (int m = 0; m < 4; ++m) _Pragma("unroll") for (int n = 0; n < 2; ++n)                           \
        _Pragma("unroll") for (int k = 0; k < 2; ++k) acc[ai][bj][m][n] = MFMA16(At[m][k], Bt[n][k], acc[ai][bj][m][n]);  \
    __builtin_amdgcn_s_setprio(0);                                                                                        \
  } while (0)
#define G_WAIT_V(n) asm volatile("s_waitcnt vmcnt(" #n ")" ::: "memory")
#define G_WAIT_L(n) asm volatile("s_waitcnt lgkmcnt(" #n ")" ::: "memory")
#define G_BAR __builtin_amdgcn_s_barrier()
#define G_SCHED __builtin_amdgcn_sched_barrier(0)

DI void br_flush(PREF p, f32x4 (&acc)[2][2][4][2], int slot);
template <int LDA, int LDB, int K, int MODE = 0>
DI void gemm256(f32x4 (&acc)[2][2][4][2], const u16* __restrict__ A, const u16* __restrict__ B, u16* shm, PREF p) {
#define KA(kt) ((kt) * 64)
#define KB(kt) (MODE ? (((kt) >> 2) * (1024 * LDB) + ((kt) & 3) * 64) : (kt) * 64)
  const int t = tid512();
  const int wid = t >> 6, lane = t & 63, wr = wid >> 2, wc = wid & 3, fr = lane & 15, fq = lane >> 4;
  int r0, c0, r1, c1;
  g_stage_rc(t * 16, r0, c0); g_stage_rc(t * 16 + 8192, r1, c1);
  const int oa0 = r0 * LDA + c0, oa1 = r1 * LDA + c1, ob0 = r0 * LDB + c0, ob1 = r1 * LDB + c1;
  const int obr = fr * 64 + fq * 16, rdo = obr ^ (((obr >> 9) & 1) << 5);
  bf16x8 At[4][2], B0[2][2], B1[2][2];
  constexpr int nt = K / 64;
  lds_barrier();
  G_STAGE(G_SB(0, 0), B, ob0, ob1, LDB, 0, KB(0)); G_STAGE(G_SA(0, 0), A, oa0, oa1, LDA, 0, KA(0));
  G_STAGE(G_SB(0, 1), B, ob0, ob1, LDB, 128, KB(0)); G_STAGE(G_SA(0, 1), A, oa0, oa1, LDA, 128, KA(0));
  if (wr == 1) G_BAR;
  G_WAIT_V(4); G_BAR;
  G_STAGE(G_SB(1, 0), B, ob0, ob1, LDB, 0, KB(1)); G_STAGE(G_SA(1, 0), A, oa0, oa1, LDA, 0, KA(1)); G_STAGE(G_SB(1, 1), B, ob0, ob1, LDB, 128, KB(1));
  G_WAIT_V(6); G_BAR;
  for (int tt = 0; tt < nt - 2; tt += 2) {
    G_LDB(B0, 0, 0); G_SCHED; G_LDA(At, 0, 0); G_STAGE(G_SA(1, 1), A, oa0, oa1, LDA, 128, KA(tt + 1));
    G_WAIT_L(8); G_BAR; G_WAIT_L(0); G_MMA(0, 0, At, B0); G_BAR; G_SCHED;
    G_LDB(B1, 0, 1); G_STAGE(G_SB(0, 0), B, ob0, ob1, LDB, 0, KB(tt + 2));
    G_BAR; G_WAIT_L(0); G_MMA(0, 1, At, B1); G_BAR;
    G_LDA(At, 0, 1); G_STAGE(G_SA(0, 0), A, oa0, oa1, LDA, 0, KA(tt + 2));
    G_BAR; G_WAIT_L(0); G_MMA(1, 0, At, B0); G_BAR; G_SCHED;
    G_STAGE(G_SB(0, 1), B, ob0, ob1, LDB, 128, KB(tt + 2));
    G_WAIT_V(6); G_BAR; G_MMA(1, 1, At, B1); G_BAR;
    G_LDB(B0, 1, 0); G_SCHED; G_LDA(At, 1, 0); G_STAGE(G_SA(0, 1), A, oa0, oa1, LDA, 128, KA(tt + 2));
    G_WAIT_L(8); G_BAR; G_WAIT_L(0); G_MMA(0, 0, At, B0); G_BAR; G_SCHED;
    G_LDB(B1, 1, 1); G_STAGE(G_SB(1, 0), B, ob0, ob1, LDB, 0, KB(tt + 3));
    G_BAR; G_WAIT_L(0); G_MMA(0, 1, At, B1); G_BAR;
    G_LDA(At, 1, 1); G_STAGE(G_SA(1, 0), A, oa0, oa1, LDA, 0, KA(tt + 3));
    G_BAR; G_WAIT_L(0); G_MMA(1, 0, At, B0); G_BAR; G_SCHED;
    G_STAGE(G_SB(1, 1), B, ob0, ob1, LDB, 128, KB(tt + 3));
    G_WAIT_V(6); G_BAR; G_MMA(1, 1, At, B1); G_BAR;
    if (MODE && ((tt + 1) & 3) == 3) br_flush(p, acc, (tt + 1) >> 2);
  }
  {
    G_LDB(B0, 0, 0); G_LDA(At, 0, 0); G_STAGE(G_SA(1, 1), A, oa0, oa1, LDA, 128, KA(nt - 1));
    G_BAR; G_WAIT_L(0); G_MMA(0, 0, At, B0); G_BAR;
    G_LDB(B1, 0, 1); G_BAR; G_WAIT_L(0); G_MMA(0, 1, At, B1); G_BAR;
    G_LDA(At, 0, 1); G_WAIT_V(4); G_BAR; G_WAIT_L(0); G_MMA(1, 0, At, B0); G_MMA(1, 1, At, B1); G_BAR;
  }
  {
    G_LDB(B0, 1, 0); G_LDA(At, 1, 0); G_WAIT_V(2); G_BAR; G_WAIT_L(0); G_MMA(0, 0, At, B0); G_BAR;
    G_LDB(B1, 1, 1); G_WAIT_V(0); G_BAR; G_WAIT_L(0); G_MMA(0, 1, At, B1); G_BAR;
    G_LDA(At, 1, 1); G_BAR; G_WAIT_L(0); G_MMA(1, 0, At, B0); G_MMA(1, 1, At, B1); G_BAR;
  }
  if (wr == 0) G_BAR;
#undef KA
#undef KB
}
DI void zero_acc256(f32x4 (&a)[2][2][4][2]) {
#pragma unroll
  for (int i = 0; i < 2; ++i)
#pragma unroll
    for (int j = 0; j < 2; ++j)
#pragma unroll
      for (int m = 0; m < 4; ++m)
#pragma unroll
        for (int n = 0; n < 2; ++n)
#pragma unroll
          for (int e = 0; e < 4; ++e) a[i][j][m][n][e] = 0.f;
}
template <int AI, int BJ>
DI void stage_q(const f32x4 (&acc)[2][2][4][2], float* Cs) {
  const int t = tid512(), wid = t >> 6, lane = t & 63, wr = wid >> 2, wc = wid & 3, fr = lane & 15, fq = lane >> 4;
  lds_barrier();
#pragma unroll
  for (int m = 0; m < 4; ++m)
#pragma unroll
    for (int n = 0; n < 2; ++n)
#pragma unroll
      for (int j = 0; j < 4; ++j) Cs[(wr * 64 + m * 16 + fq * 4 + j) * CST + wc * 32 + n * 16 + fr] = acc[AI][BJ][m][n][j];
  lds_barrier();
}
DI bool xcd_tile256(int k, int NT, int& m, int& n) {
  const int x = blockIdx.x & 7, slots = gridDim.x >> 3;
  const int idx = (int)(blockIdx.x >> 3) + slots * k;
  if (idx >= 16 * NT) return false;
  const int mg = idx / (8 * NT), rem = idx - mg * 8 * NT;
  n = rem >> 3; m = x * 16 + mg * 8 + (rem & 7);
  return true;
}

DI bool xcd_tile(int k, int NT, int& m, int& n) {
  const int x = (vbid() >> 1) & 7, slots = vgrid() >> 3;
  const int idx = (((vbid() >> 4) << 1) | (vbid() & 1)) + slots * k;
  if (idx >= 32 * NT) return false;
  const int mg = idx / (8 * NT), rem = idx - mg * 8 * NT;
  n = rem >> 3; m = x * 32 + mg * 8 + (rem & 7);
  return true;
}

template <int AI, int BJ>
DI void in_quadrant(PREF p, const f32x4 (&acc)[2][2][4][2], int mt, int nt, float* Cs) {
  const int t = tid512();
  const int row0 = mt * 256 + AI * 128, col0 = nt * 256 + BJ * 128;
  if (col0 >= HW) return;
  stage_q<AI, BJ>(acc, Cs);
#pragma unroll
  for (int q = 0; q < 4; ++q) {
    int r = (t >> 4) + 32 * q, c = (t & 15) * 8;
    if (col0 + c < HW) {
      float v[8]; ld8(Cs + r * CST + c, v);
      *(u32x4*)(p.hb + (size_t)(row0 + r) * HW + col0 + c) = pack8(v);
    }
  }
  if (col0 + 128 > OFF_SV && col0 < OFF_SV + 128) {
    int b = row0 >> 12, s0 = row0 & 4095;
#pragma unroll
    for (int q = 0; q < 4; ++q) {
      int item = t + 512 * q; int c = item & 127, rg = item >> 7;
      int vc = col0 + c - OFF_SV;
      if (vc >= 0 && vc < 128) {
        float v[8];
#pragma unroll
        for (int j = 0; j < 8; ++j) v[j] = Cs[(rg * 8 + j) * CST + c];
        *(u32x4*)(p.Vst + ((size_t)(b * 2 + (vc >> 6)) * 64 + (vc & 63)) * S_ + s0 + rg * 8) = pack8(v);
      }
    }
  }
}
DI void phase_in(PREF p, int l, unsigned char* lds_all) {
  u16* shm = (u16*)lds_all; float* Cs = (float*)lds_all;
  const int tid = tidx();
  const u16* W = p.wts + (size_t)l * WL + O_WIN;
  for (int k = 0;; ++k) {
    int mt, nt;
    if (!xcd_tile256(k, 11, mt, nt)) break;
    f32x4 acc[2][2][4][2]; zero_acc256(acc);
    gemm256<1024, 1024, 1024>(acc, p.X + (size_t)mt * 256 * 1024, W + (size_t)nt * 256 * 1024, shm, p);
    in_quadrant<0, 0>(p, acc, mt, nt, Cs); in_quadrant<0, 1>(p, acc, mt, nt, Cs);
    in_quadrant<1, 0>(p, acc, mt, nt, Cs); in_quadrant<1, 1>(p, acc, mt, nt, Cs);
  }
  __syncthreads();
  const int gtid = vbid() * 256 + tid, gsz = vgrid() * 256;
  const float* ps = p.p + (size_t)l * T_ * 256;
  for (int idx = gtid; idx < T_ * 256 / 8; idx += gsz) {
    const float4* s = (const float4*)(ps + (size_t)idx * 8);
    float4 a = s[0], b = s[1];
    float v[8] = {a.x, a.y, a.z, a.w, b.x, b.y, b.z, b.w};
    *(u32x4*)(p.pb + (size_t)idx * 8) = pack8(v);
  }
}

template <int DQK, bool WIN>
DI void attn_item(const u16* __restrict__ Qb, int ldq, const u16* __restrict__ Kb, int ldk, const u16* __restrict__ Vtb, int qb,
                  float qscale, float sink2, const u16* __restrict__ zb, int ldz, u16* __restrict__ ob, int ldo, u16* lds) {
  constexpr int KST = DQK + 8, NKS = DQK / 16, KCH = DQK / 8;
  constexpr int KBUF = 64 * KST, VBUF = 64 * 72, STG = KBUF + VBUF;
  constexpr int NKL = (64 * KCH) / 256;
  const int tid = tidx(), lane = tid & 63, w = tid >> 6, r = lane & 31, hh = lane >> 5;
  const int q0 = qb * 128 + w * 32;
  const int qrow = q0 + r;
  bf16x8 qf[NKS];
#pragma unroll
  for (int s = 0; s < NKS; ++s) qf[s] = *(const bf16x8*)(Qb + (size_t)qrow * ldq + 16 * s + 8 * hh);
  const int kt_lo = WIN ? (qb > 0 ? 2 * qb - 2 : 0) : 0;
  const int kt_hi = 2 * qb + 1;
  f32x16 o[2];
#pragma unroll
  for (int i = 0; i < 16; ++i) { o[0][i] = 0.f; o[1][i] = 0.f; }
  float m = WIN ? sink2 : -1e30f;
  float lsum = (WIN && hh == 0) ? 1.f : 0.f;
  u32x4 rkA[NKL], rvA[2], rkB[NKL], rvB[2];
  auto gload = [&](u32x4 (&rk)[NKL], u32x4 (&rv)[2], int kt) {
#pragma unroll
    for (int i = 0; i < NKL; ++i) {
      int id = tid + 256 * i; int row = id / KCH, ch = id % KCH;
      rk[i] = *(const u32x4*)(Kb + (size_t)(kt * 64 + row) * ldk + ch * 8);
    }
#pragma unroll
    for (int i = 0; i < 2; ++i) {
      int id = tid + 256 * i; int row = id >> 3, ch = id & 7;
      rv[i] = *(const u32x4*)(Vtb + (size_t)row * S_ + kt * 64 + ch * 8);
    }
  };
  auto swrite = [&](const u32x4 (&rk)[NKL], const u32x4 (&rv)[2], int buf) {
    u16* ks = lds + buf * STG; u16* vs = ks + KBUF;
#pragma unroll
    for (int i = 0; i < NKL; ++i) {
      int id = tid + 256 * i; int row = id / KCH, ch = id % KCH;
      *(u32x4*)(ks + row * KST + ch * 8) = rk[i];
    }
#pragma unroll
    for (int i = 0; i < 2; ++i) {
      int id = tid + 256 * i; int row = id >> 3, ch = id & 7;
      u16* d = vs + row * 72 + (ch >> 1) * 16 + (ch & 1) * 4;
      u32x2 lo = {rv[i].x, rv[i].y}, hi = {rv[i].z, rv[i].w};
      *(u32x2*)d = lo; *(u32x2*)(d + 8) = hi;
    }
  };
  auto tile_body = [&](int kt, int buf, auto mask_tag) {
    constexpr bool MASK = decltype(mask_tag)::value;
    const u16* ks = lds + buf * STG; const u16* vs = ks + KBUF;
    const int k0 = kt * 64;
    bool active = (k0 <= q0 + 31);
    if (WIN) active = active && (k0 + 63 >= q0 - 127);
    if (active) {
      f32x16 st[2];
#pragma unroll
      for (int kb = 0; kb < 2; ++kb) {
#pragma unroll
        for (int i = 0; i < 16; ++i) st[kb][i] = 0.f;
#pragma unroll
        for (int s = 0; s < NKS; ++s) {
          bf16x8 a = *(const bf16x8*)(ks + (kb * 32 + r) * KST + 16 * s + 8 * hh);
          st[kb] = MFMA32(a, qf[s], st[kb]);
        }
      }
      float mx = -INFINITY;
#pragma unroll
      for (int kb = 0; kb < 2; ++kb)
#pragma unroll
        for (int i = 0; i < 16; ++i) {
          float v = st[kb][i];
          if (MASK) {
            int kg = k0 + kb * 32 + (i & 3) + 8 * (i >> 2) + 4 * hh;
            bool ok = kg <= qrow;
            if (WIN) ok = ok && (qrow - kg < 128);
            v = ok ? v : -INFINITY;
            st[kb][i] = v;
          }
          mx = fmaxf(mx, v);
        }
      mx = fmaxf(mx, __shfl_xor(mx, 32));
      const float mn = fmaxf(m, mx);
      if (__any(mn != m)) {
        const float alpha = __builtin_amdgcn_exp2f((m - mn) * qscale);
        lsum *= alpha;
#pragma unroll
        for (int i = 0; i < 16; ++i) { o[0][i] *= alpha; o[1][i] *= alpha; }
      }
      m = mn;
      const float nb = -mn * qscale;
      float ps = 0.f;
#pragma unroll
      for (int kb = 0; kb < 2; ++kb)
#pragma unroll
        for (int i = 0; i < 16; ++i) { float pv = __builtin_amdgcn_exp2f(fmaf(st[kb][i], qscale, nb)); st[kb][i] = pv; ps += pv; }
      lsum += ps;
#pragma unroll
      for (int kb = 0; kb < 2; ++kb)
#pragma unroll
        for (int s2 = 0; s2 < 2; ++s2) {
          union { bf16x8 v; unsigned u[4]; } pf;
#pragma unroll
          for (int j = 0; j < 4; ++j) pf.u[j] = pack2(st[kb][8 * s2 + 2 * j], st[kb][8 * s2 + 2 * j + 1]);
#pragma unroll
          for (int vb = 0; vb < 2; ++vb) {
            const bf16x8 vf = *(const bf16x8*)(vs + (vb * 32 + r) * 72 + (kb * 2 + s2) * 16 + hh * 8);
            o[vb] = MFMA32(vf, pf.v, o[vb]);
          }
        }
    }
  };
  __syncthreads();
  gload(rkA, rvA, kt_lo);
  gload(rkB, rvB, kt_lo + 1);
  swrite(rkA, rvA, 0);
  __syncthreads();
  for (int kt = kt_lo; kt <= kt_hi; kt += 2) {
    if (kt + 2 <= kt_hi) gload(rkA, rvA, kt + 2);
    if (WIN || kt >= 2 * qb) tile_body(kt, 0, std::true_type{}); else tile_body(kt, 0, std::false_type{});
    swrite(rkB, rvB, 1);
    __syncthreads();
    if (kt + 3 <= kt_hi) gload(rkB, rvB, kt + 3);
    if (WIN || kt + 1 >= 2 * qb) tile_body(kt + 1, 1, std::true_type{}); else tile_body(kt + 1, 1, std::false_type{});
    if (kt + 2 <= kt_hi) swrite(rkA, rvA, 0);
    __syncthreads();
  }
  float lt = lsum + __shfl_xor(lsum, 32);
  float inv = 1.f / lt;
  u32x2 zr[8];
#pragma unroll
  for (int e = 0; e < 8; ++e) zr[e] = *(const u32x2*)(zb + (size_t)qrow * ldz + (e >> 2) * 32 + 8 * (e & 3) + 4 * hh);
#pragma unroll
  for (int vb = 0; vb < 2; ++vb)
#pragma unroll
    for (int g4 = 0; g4 < 4; ++g4) {
      int vd0 = vb * 32 + 8 * g4 + 4 * hh;
      u32x2 z = zr[vb * 4 + g4];
      float a0 = o[vb][4 * g4 + 0] * inv * silu(lo2f(z.x));
      float a1 = o[vb][4 * g4 + 1] * inv * silu(hi2f(z.x));
      float a2 = o[vb][4 * g4 + 2] * inv * silu(lo2f(z.y));
      float a3 = o[vb][4 * g4 + 3] * inv * silu(hi2f(z.y));
      u32x2 ov; ov.x = pack2(a0, a1); ov.y = pack2(a2, a3);
      *(u32x2*)(ob + (size_t)qrow * ldo + vd0) = ov;
    }
}

DI void conv_item(PREF p, int l, int tile, unsigned char* ldsb) {
  float* Gs = (float*)ldsb;
  const int tid = tidx(), lane = tid & 63, w = tid >> 6;
  const int t0 = tile * 32, s0 = t0 & 4095;
  __syncthreads();
  for (int id = tid; id < 62 * 32; id += 256) {
    int rr = id >> 5, ch = (id & 31) * 8;
    int s = s0 - 30 + rr;
    float v[8];
#pragma unroll
    for (int j = 0; j < 8; ++j) v[j] = 0.f;
    if (s >= 0) {
      const u16* src = p.hb + (size_t)(t0 - 30 + rr) * HW + ch;
      float a[8], g[8];
      unpack8(*(const u32x4*)(src + OFF_AVAL), a);
      unpack8(*(const u32x4*)(src + OFF_AGATE), g);
#pragma unroll
      for (int j = 0; j < 8; ++j) v[j] = a[j] * sigm(g[j]);
    }
    *(float4*)(Gs + rr * 256 + ch) = make_float4(v[0], v[1], v[2], v[3]);
    *(float4*)(Gs + rr * 256 + ch + 4) = make_float4(v[4], v[5], v[6], v[7]);
  }
  __syncthreads();
  {
    const int c = tid;
    float wv[31];
#pragma unroll
    for (int j = 0; j < 31; ++j) wv[j] = p.conv_w[((size_t)l * 31 + j) * 256 + c];
    const float bias = p.conv_b[l * 256 + c];
    for (int tt = 0; tt < 32; ++tt) {
      float acc = bias;
#pragma unroll
      for (int j = 0; j < 31; ++j) acc += wv[j] * Gs[(tt + j) * 256 + c];
      Gs[tt * 256 + c] = acc;
    }
  }
  __syncthreads();
  const float4 gg = *(const float4*)(p.conv_ng + l * 256 + lane * 4);
  const float4 bb = *(const float4*)(p.conv_nb + l * 256 + lane * 4);
  for (int q = 0; q < 8; ++q) {
    int tt = w * 8 + q;
    float4 v = *(const float4*)(Gs + tt * 256 + lane * 4);
    float mu = wsum(v.x + v.y + v.z + v.w) * (1.f / 256.f);
    float d0 = v.x - mu, d1 = v.y - mu, d2 = v.z - mu, d3 = v.w - mu;
    float var = wsum(d0 * d0 + d1 * d1 + d2 * d2 + d3 * d3) * (1.f / 256.f);
    float rs = rsqrtf(var + 1e-5f);
    float y0 = silu(d0 * rs * gg.x + bb.x), y1 = silu(d1 * rs * gg.y + bb.y);
    float y2 = silu(d2 * rs * gg.z + bb.z), y3 = silu(d3 * rs * gg.w + bb.w);
    u32x2 ov; ov.x = pack2(y0, y1); ov.y = pack2(y2, y3);
    *(u32x2*)(p.cA + (size_t)(t0 + tt) * 256 + lane * 4) = ov;
  }
}

DI void ssm_stage_u(PREF p, int b, int c, int gq, float* uS) {
  const int tid = tidx();
  int row = tid >> 2, cc = (tid & 3) * 16;
  const u16* src = p.hb + (size_t)(b * S_ + c * 64 + row) * HW + OFF_U + gq * 64 + cc;
  float f[16];
  unpack8(*(const u32x4*)src, f); unpack8(*(const u32x4*)(src + 8), f + 8);
#pragma unroll
  for (int j = 0; j < 4; ++j) *(float4*)(uS + row * 64 + cc + 4 * j) = make_float4(f[4 * j], f[4 * j + 1], f[4 * j + 2], f[4 * j + 3]);
}
#define SSM_STEP(t)                                                                                                        \
  {                                                                                                                        \
    const float4* up = (const float4*)(uS + (t) * 64 + w * 16);                                                            \
    float4 u0 = up[0], u1 = up[1], u2 = up[2], u3 = up[3];                                                                 \
    float uu[16] = {u0.x, u0.y, u0.z, u0.w, u1.x, u1.y, u1.z, u1.w, u2.x, u2.y, u2.z, u2.w, u3.x, u3.y, u3.z, u3.w};       \
    float bur = 0.f, bui = 0.f;                                                                                            \
    _Pragma("unroll") for (int j = 0; j < 16; ++j) { bur += bre[j] * uu[j]; bui += bim[j] * uu[j]; }                       \
    float nr = lr * hr - li * hi + bur, ni = lr * hi + li * hr + bui;                                                      \
    hr = nr; hi = ni;                                                                                                      \
  }

DI void ssm1_item(PREF p, int l, int item, unsigned char* ldsb) {
  const int gq = item & 3, c = (item >> 2) & 63, b = item >> 8;
  const int tid = tidx(), w = tid >> 6, lane = tid & 63;
  const int g = gq * 4 + w;
  float* uS = (float*)ldsb;
  __syncthreads();
  ssm_stage_u(p, b, c, gq, uS);
  __syncthreads();
  const size_t pi = (size_t)(l * 16 + g) * 64 + lane;
  float bre[16], bim[16];
#pragma unroll
  for (int j = 0; j < 16; ++j) { bre[j] = p.bbre[pi * 16 + j]; bim[j] = p.bbim[pi * 16 + j]; }
  const float lr = p.lam[pi * 2], li = p.lam[pi * 2 + 1];
  float hr = 0.f, hi = 0.f;
  for (int t = 0; t < 64; ++t) SSM_STEP(t)
  ((float2*)p.hend)[((size_t)(b * 16 + g) * 64 + c) * 64 + lane] = make_float2(hr, hi);
}

DI void ssm2_item(PREF p, int l, int item, unsigned char* ldsb) {
  const int gq = item & 3, c = (item >> 2) & 63, b = item >> 8;
  const int tid = tidx(), w = tid >> 6, lane = tid & 63;
  const int g = gq * 4 + w;
  float* uS = (float*)ldsb;
  u16* Hs = (u16*)(ldsb + 16384) + w * (16 * 136);
  __syncthreads();
  ssm_stage_u(p, b, c, gq, uS);
  __syncthreads();
  const size_t pi = (size_t)(l * 16 + g) * 64 + lane;
  float bre[16], bim[16];
#pragma unroll
  for (int j = 0; j < 16; ++j) { bre[j] = p.bbre[pi * 16 + j]; bim[j] = p.bbim[pi * 16 + j]; }
  const float lr = p.lam[pi * 2], li = p.lam[pi * 2 + 1];
  float pr = lr, pim = li;
#pragma unroll
  for (int q = 0; q < 6; ++q) { float a = pr * pr - pim * pim, bq = 2.f * pr * pim; pr = a; pim = bq; }
  float hr = 0.f, hi = 0.f;
  const float2* he = (const float2*)p.hend + ((size_t)(b * 16 + g) * 64) * 64 + lane;
  for (int cc = 0; cc < c; ++cc) {
    float2 e = he[(size_t)cc * 64];
    float nr = pr * hr - pim * hi + e.x, ni = pr * hi + pim * hr + e.y;
    hr = nr; hi = ni;
  }
  const int hcol = lane & 15, q4 = lane >> 4;
  bf16x8 cf[4];
  {
    const float* cre = p.c_re + ((size_t)(l * 16 + g) * 16 + hcol) * 64;
    const float* cim = p.c_im + ((size_t)(l * 16 + g) * 16 + hcol) * 64;
#pragma unroll
    for (int ks = 0; ks < 4; ++ks) {
      float v[8];
#pragma unroll
      for (int j = 0; j < 8; ++j) {
        int k = 32 * ks + 8 * q4 + j;
        v[j] = (k & 1) ? -cim[k >> 1] : cre[k >> 1];
      }
      union { bf16x8 v8; u32x4 u; } cv; cv.u = pack8(v); cf[ks] = cv.v8;
    }
  }
  const float dch = p.ssm_d[l * 256 + g * 16 + hcol];
  for (int sub = 0; sub < 4; ++sub) {
    for (int tt = 0; tt < 16; ++tt) {
      SSM_STEP(sub * 16 + tt)
      *(unsigned*)(Hs + tt * 136 + 2 * lane) = pack2(hr, hi);
    }
    __syncthreads();
    f32x4 acc = {0.f, 0.f, 0.f, 0.f};
#pragma unroll
    for (int ks = 0; ks < 4; ++ks) {
      bf16x8 a = *(const bf16x8*)(Hs + hcol * 136 + 32 * ks + 8 * q4);
      acc = MFMA16(a, cf[ks], acc);
    }
#pragma unroll
    for (int j = 0; j < 4; ++j) {
      int t = sub * 16 + 4 * q4 + j;
      float uu = uS[t * 64 + w * 16 + hcol];
      float yv = gelu_t(acc[j] + dch * uu);
      p.yss[(size_t)(b * S_ + c * 64 + t) * 256 + g * 16 + hcol] = f2bf(yv);
    }
    __syncthreads();
  }
}

DI void q_tile(PREF p, int l, int idx, unsigned char* ldsb) {
  u16* lds = (u16*)ldsb; float* Cs = (float*)ldsb; float* aux = (float*)(ldsb + LDS_MAIN);
  const int tid = tidx();
  const int mt = idx / 3, nt = idx % 3;
  const int row0 = mt * 128, col0 = nt * 128;
  __syncthreads();
  if (tid < 128) {
    const u16* src = p.hb + (size_t)(row0 + tid) * HW + OFF_CQ;
    float ss = 0.f;
    for (int i = 0; i < 32; ++i) { float f[8]; unpack8(*(const u32x4*)(src + i * 8), f);
#pragma unroll
      for (int j = 0; j < 8; ++j) ss += f[j] * f[j]; }
    aux[tid] = rsqrtf(ss * (1.f / 256.f) + 1e-6f);
  }
  f32x4 acc[4][4]; zero_acc(acc);
  gemm_main(acc, p.hb + (size_t)row0 * HW + OFF_CQ, HW, p.wts + (size_t)l * WL + O_UQ + (size_t)col0 * 256, 256, 256, lds);
  stage_c(acc, Cs);
#pragma unroll
  for (int q = 0; q < 8; ++q) {
    int r = (tid >> 4) + 16 * q, c = (tid & 15) * 8;
    int n = col0 + c; int dd = n % 96;
    float rs = aux[r];
    float v[8]; ld8(Cs + r * CST + c, v);
#pragma unroll
    for (int j = 0; j < 8; ++j) v[j] *= rs;
    if (dd >= 64) {
      int ri0 = dd - 64; int s = (row0 + r) & 4095;
      float pv[8];
      if (ri0 < 16) {
        ld8(Cs + r * CST + c + 16, pv);
        const float* cs = p.rcos + s * 16 + ri0; const float* sn = p.rsin + s * 16 + ri0;
#pragma unroll
        for (int j = 0; j < 8; ++j) v[j] = v[j] * cs[j] - pv[j] * rs * sn[j];
      } else {
        ld8(Cs + r * CST + c - 16, pv);
        const float* cs = p.rcos + s * 16 + ri0 - 16; const float* sn = p.rsin + s * 16 + ri0 - 16;
#pragma unroll
        for (int j = 0; j < 8; ++j) v[j] = v[j] * cs[j] + pv[j] * rs * sn[j];
      }
    }
    *(u32x4*)(p.Qm + (size_t)(row0 + r) * 384 + n) = pack8(v);
  }
}

DI void kv_tile(PREF p, int l, int idx, unsigned char* ldsb) {
  u16* lds = (u16*)ldsb; float* Cs = (float*)ldsb; float* aux = (float*)(ldsb + LDS_MAIN);
  const int tid = tidx();
  const int mt = idx >> 2, head = idx & 3;
  const int row0 = mt * 128;
  __syncthreads();
  if (tid < 128) {
    const u16* src = p.hb + (size_t)(row0 + tid) * HW + OFF_CKV;
    float ss = 0.f;
    for (int i = 0; i < 16; ++i) { float f[8]; unpack8(*(const u32x4*)(src + i * 8), f);
#pragma unroll
      for (int j = 0; j < 8; ++j) ss += f[j] * f[j]; }
    aux[tid] = rsqrtf(ss * (1.f / 128.f) + 1e-6f);
  }
  f32x4 acc[4][4]; zero_acc(acc);
  gemm_main(acc, p.hb + (size_t)row0 * HW + OFF_CKV, HW, p.wts + (size_t)l * WL + O_UKV + (size_t)head * 128 * 128, 128, 128, lds);
  stage_c(acc, Cs);
#pragma unroll
  for (int q = 0; q < 4; ++q) {
    int r = (tid >> 3) + 32 * q, c = (tid & 7) * 8;
    float rs = aux[r];
    float v[8]; ld8(Cs + r * CST + c, v);
#pragma unroll
    for (int j = 0; j < 8; ++j) v[j] *= rs;
    *(u32x4*)(p.Km + (size_t)(row0 + r) * 384 + head * 96 + c) = pack8(v);
  }
  {
    int b = row0 >> 12, s0 = row0 & 4095;
#pragma unroll
    for (int q = 0; q < 4; ++q) {
      int item = tid + 256 * q; int c = item & 63, rg = item >> 6;
      float v[8];
#pragma unroll
      for (int j = 0; j < 8; ++j) v[j] = Cs[(rg * 8 + j) * CST + 64 + c] * aux[rg * 8 + j];
      *(u32x4*)(p.Vmt + ((size_t)(b * 4 + head) * 64 + c) * S_ + s0 + rg * 8) = pack8(v);
    }
  }
  {
    int r = tid >> 1, half = tid & 1;
    int t = row0 + r, s = t & 4095;
    const u16* src = p.hb + (size_t)t * HW + OFF_KR;
    float x1[16], x2[16];
    unpack8(*(const u32x4*)(src), x1); unpack8(*(const u32x4*)(src + 8), x1 + 8);
    unpack8(*(const u32x4*)(src + 16), x2); unpack8(*(const u32x4*)(src + 24), x2 + 8);
    const float* cs = p.rcos + s * 16; const float* sn = p.rsin + s * 16;
    float ov[16];
#pragma unroll
    for (int i = 0; i < 16; ++i) ov[i] = half ? (x2[i] * cs[i] + x1[i] * sn[i]) : (x1[i] * cs[i] - x2[i] * sn[i]);
    u16* dst = p.Km + (size_t)t * 384 + head * 96 + 64 + half * 16;
    *(u32x4*)dst = pack8(ov); *(u32x4*)(dst + 8) = pack8(ov + 8);
  }
}

DI void pw2_tile(PREF p, int l, int idx, unsigned char* ldsb) {
  u16* lds = (u16*)ldsb; float* Cs = (float*)ldsb;
  const int tid = tidx();
  const int mt = idx >> 1, nt = idx & 1;
  const int row0 = mt * 128, col0 = nt * 128;
  f32x4 acc[4][4]; zero_acc(acc);
  gemm_main(acc, p.cA + (size_t)row0 * 256, 256, p.wts + (size_t)l * WL + O_PW2 + (size_t)col0 * 256, 256, 256, lds);
  stage_c(acc, Cs);
  u32x4 zr[8];
#pragma unroll
  for (int q = 0; q < 8; ++q) zr[q] = *(const u32x4*)(p.hb + (size_t)(row0 + (tid >> 4) + 16 * q) * HW + OFF_AZ + col0 + (tid & 15) * 8);
#pragma unroll
  for (int q = 0; q < 8; ++q) {
    int r = (tid >> 4) + 16 * q, c = (tid & 15) * 8;
    float v[8]; ld8(Cs + r * CST + c, v);
    float z[8]; unpack8(zr[q], z);
#pragma unroll
    for (int j = 0; j < 8; ++j) v[j] *= silu(z[j]);
    *(u32x4*)(p.ys + (size_t)(row0 + r) * 1024 + col0 + c) = pack8(v);
  }
}

DI void glu_tile(PREF p, int l, int idx, unsigned char* ldsb) {
  u16* lds = (u16*)ldsb; float* Cs = (float*)ldsb;
  const int tid = tidx();
  const int mt = idx >> 2, nt = idx & 3;
  const int row0 = mt * 128;
  f32x4 acc[4][4]; zero_acc(acc);
  gemm_main(acc, p.yss + (size_t)row0 * 256, 256, p.wts + (size_t)l * WL + O_GLU + (size_t)nt * 128 * 256, 256, 256, lds);
  stage_c(acc, Cs);
  u32x4 zr[4];
#pragma unroll
  for (int q = 0; q < 4; ++q) zr[q] = *(const u32x4*)(p.hb + (size_t)(row0 + (tid >> 3) + 32 * q) * HW + OFF_CZ + nt * 64 + (tid & 7) * 8);
#pragma unroll
  for (int q = 0; q < 4; ++q) {
    int r = (tid >> 3) + 32 * q, c = (tid & 7) * 8;
    float v[8], g[8]; ld8(Cs + r * CST + c, v); ld8(Cs + r * CST + 64 + c, g);
    float z[8]; unpack8(zr[q], z);
#pragma unroll
    for (int j = 0; j < 8; ++j) v[j] = v[j] * sigm(g[j]) * silu(z[j]);
    *(u32x4*)(p.ys + (size_t)(row0 + r) * 1024 + 512 + nt * 64 + c) = pack8(v);
  }
}

template <int AI, int BJ>
DI void glu_quadrant(PREF p, const f32x4 (&acc)[2][2][4][2], int mt, int nt, float* Cs) {
  const int t = tid512();
  const int row0 = mt * 256 + AI * 128, oc0 = (nt * 2 + BJ) * 64, c = (t & 7) * 8;
  u32x4 zr[2];
#pragma unroll
  for (int q = 0; q < 2; ++q) zr[q] = *(const u32x4*)(p.hb + (size_t)(row0 + (t >> 3) + 64 * q) * HW + OFF_CZ + oc0 + c);
  stage_q<AI, BJ>(acc, Cs);
#pragma unroll
  for (int q = 0; q < 2; ++q) {
    const int r = (t >> 3) + 64 * q;
    float v[8], g[8]; ld8(Cs + r * CST + c, v); ld8(Cs + r * CST + 64 + c, g);
    float z[8]; unpack8(zr[q], z);
#pragma unroll
    for (int j = 0; j < 8; ++j) v[j] = v[j] * sigm(g[j]) * silu(z[j]);
    *(u32x4*)(p.ys + (size_t)(row0 + r) * 1024 + 512 + oc0 + c) = pack8(v);
  }
}
DI void glu_phase(PREF p, int l, unsigned char* lds_all) {
  u16* shm = (u16*)lds_all; float* Cs = (float*)lds_all;
  for (int it = blockIdx.x; it < 256; it += gridDim.x) {
    const int mt = it >> 1, nt = it & 1;
    f32x4 acc[2][2][4][2]; zero_acc256(acc);
    gemm256<256, 256, 256>(acc, p.yss + (size_t)mt * 256 * 256, p.wts + (size_t)l * WL + O_GLU + (size_t)nt * 256 * 256, shm, p);
    glu_quadrant<0, 0>(p, acc, mt, nt, Cs); glu_quadrant<0, 1>(p, acc, mt, nt, Cs);
    glu_quadrant<1, 0>(p, acc, mt, nt, Cs); glu_quadrant<1, 1>(p, acc, mt, nt, Cs);
  }
  __syncthreads();
}

DI u32x4* merge_scratch(PREF p, int region) { const int t = tid512(); return (u32x4*)p.fbuf + (size_t)blockIdx.x * 40960 + region * 8192 + (t >> 6) * 1024 + (t & 63); }
DI void br_store(PREF p, const f32x4 (&acc)[2][2][4][2], int slot) {
  u32x4* sb = merge_scratch(p, slot);
#pragma unroll
  for (int ai = 0; ai < 2; ++ai)
#pragma unroll
    for (int bj = 0; bj < 2; ++bj)
#pragma unroll
      for (int m = 0; m < 4; ++m) {
        u32x4 o;
        o.x = pack2(acc[ai][bj][m][0][0], acc[ai][bj][m][0][1]); o.y = pack2(acc[ai][bj][m][0][2], acc[ai][bj][m][0][3]);
        o.z = pack2(acc[ai][bj][m][1][0], acc[ai][bj][m][1][1]); o.w = pack2(acc[ai][bj][m][1][2], acc[ai][bj][m][1][3]);
        sb[((ai * 2 + bj) * 4 + m) * 64] = o;
      }
}
DI void br_flush(PREF p, f32x4 (&acc)[2][2][4][2], int slot) { br_store(p, acc, slot); zero_acc256(acc); }
DI void gate_reg(PREF p, int l, int n, f32x4 (&acc)[2][2][4][2], int dt) {
  const u32x4* sbn = merge_scratch(p, n);
  u32x4* ssum = merge_scratch(p, 4);
  const int t = tid512(), wid = t >> 6, lane = t & 63, wc = wid & 3, fr = lane & 15;
  const float* bm = p.b_merge + (size_t)l * 4096 + n * 1024 + dt * 256 + wc * 32 + fr;
  float bias[2][2];
#pragma unroll
  for (int bj = 0; bj < 2; ++bj)
#pragma unroll
    for (int nn = 0; nn < 2; ++nn) bias[bj][nn] = bm[bj * 128 + nn * 16];
#pragma unroll
  for (int ai = 0; ai < 2; ++ai)
#pragma unroll
    for (int bj = 0; bj < 2; ++bj) {
      __builtin_amdgcn_sched_barrier(0);
      u32x4 bn[4], pv[4];
#pragma unroll
      for (int m = 0; m < 4; ++m) {
        bn[m] = sbn[((ai * 2 + bj) * 4 + m) * 64];
        if (n > 0) pv[m] = ssum[((ai * 2 + bj) * 4 + m) * 64];
      }
#pragma unroll
      for (int m = 0; m < 4; ++m) {
        float b[8]; unpack8(bn[m], b);
        float v[8];
#pragma unroll
        for (int nn = 0; nn < 2; ++nn)
#pragma unroll
          for (int j = 0; j < 4; ++j) v[nn * 4 + j] = sigm(acc[ai][bj][m][nn][j] + bias[bj][nn]) * b[nn * 4 + j];
        if (n > 0) {
          float o[8]; unpack8(pv[m], o);
#pragma unroll
          for (int e = 0; e < 8; ++e) v[e] += o[e];
        }
        if (n < 3) ssum[((ai * 2 + bj) * 4 + m) * 64] = pack8(v);
#pragma unroll
        for (int nn = 0; nn < 2; ++nn)
#pragma unroll
          for (int j = 0; j < 4; ++j) acc[ai][bj][m][nn][j] = v[nn * 4 + j];
      }
    }
}
template <int AI, int BJ>
DI void mg_quadrant(PREF p, const f32x4 (&acc)[2][2][4][2], int mt, int dt, float* Cs) {
  const int t = tid512();
  const int row0 = mt * 256 + AI * 128, col0 = dt * 256 + BJ * 128;
  stage_q<AI, BJ>(acc, Cs);
#pragma unroll
  for (int q = 0; q < 4; ++q) {
    int r = (t >> 4) + 32 * q, c = (t & 15) * 8;
    float v[8]; ld8(Cs + r * CST + c, v);
    *(u32x4*)(p.mg + (size_t)(row0 + r) * 1024 + col0 + c) = pack8(v);
  }
}
DI void merge_phase(PREF p, int l, unsigned char* lds_all) {
  u16* shm = (u16*)lds_all; float* Cs = (float*)lds_all;
  const u16* W = p.wts + (size_t)l * WL;
  for (int k = 0;; ++k) {
    int mt, dt;
    if (!xcd_tile256(k, 4, mt, dt)) break;
    {
      f32x4 acc[2][2][4][2]; zero_acc256(acc);
      gemm256<1024, 256, 1024, 1>(acc, p.ys + (size_t)mt * 256 * 1024, W + O_BR + (size_t)dt * 256 * 256, shm, p);
      br_store(p, acc, 3);
    }
#pragma unroll 1
    for (int n = 0; n < 4; ++n) {
      f32x4 acc[2][2][4][2]; zero_acc256(acc);
      gemm256<1024, 1024, 1024>(acc, p.X + (size_t)mt * 256 * 1024, W + O_WM + ((size_t)n * 1024 + dt * 256) * 1024, shm, p);
      gate_reg(p, l, n, acc, dt);
      if (n == 3) {
        mg_quadrant<0, 0>(p, acc, mt, dt, Cs); mg_quadrant<0, 1>(p, acc, mt, dt, Cs);
        mg_quadrant<1, 0>(p, acc, mt, dt, Cs); mg_quadrant<1, 1>(p, acc, mt, dt, Cs);
      }
    }
  }
  __syncthreads();
}

template <int AI, int BJ>
DI void f1_load(PREF p, int l, int mt, int dt, float4 (&xa)[4], float4 (&xb)[4]) {
  const int t = tid512();
  const int row0 = mt * 256 + AI * 128, col0 = dt * 256 + BJ * 128, c = (t & 15) * 8;
  if (l == 0) {
#pragma unroll
    for (int q = 0; q < 4; ++q) {
      const float4* xs = (const float4*)(p.x + (size_t)(row0 + (t >> 4) + 32 * q) * 1024 + col0 + c);
      xa[q] = xs[0]; xb[q] = xs[1];
    }
  } else {
#pragma unroll
    for (int q = 0; q < 4; ++q) {
      float f[8]; unpack8(*(const u32x4*)(p.X + (size_t)(row0 + (t >> 4) + 32 * q) * 1024 + col0 + c), f);
      xa[q] = make_float4(f[0], f[1], f[2], f[3]); xb[q] = make_float4(f[4], f[5], f[6], f[7]);
    }
  }
}
template <int AI, int BJ>
DI void f1_proc(PREF p, const f32x4 (&acc)[2][2][4][2], int mt, int dt, float* Cs, const float4 (&xa)[4], const float4 (&xb)[4]) {
  const int t = tid512();
  const int row0 = mt * 256 + AI * 128, col0 = dt * 256 + BJ * 128, c = (t & 15) * 8;
  const float alpha = 1.681792830507429f;
  stage_q<AI, BJ>(acc, Cs);
#pragma unroll
  for (int q = 0; q < 4; ++q) {
    int r = (t >> 4) + 32 * q;
    float v[8]; ld8(Cs + r * CST + c, v);
    float4 a = xa[q], b = xb[q];
    float y[8] = {alpha * a.x + v[0], alpha * a.y + v[1], alpha * a.z + v[2], alpha * a.w + v[3],
                  alpha * b.x + v[4], alpha * b.y + v[5], alpha * b.z + v[6], alpha * b.w + v[7]};
    *(u32x4*)((u16*)p.fbuf + (size_t)(row0 + r) * 1024 + col0 + c) = pack8(y);
  }
}
DI void f1_phase(PREF p, int l, unsigned char* lds_all) {
  u16* shm = (u16*)lds_all; float* Cs = (float*)lds_all;
  for (int k = 0;; ++k) {
    int mt, dt;
    if (!xcd_tile256(k, 4, mt, dt)) break;
    f32x4 acc[2][2][4][2]; zero_acc256(acc);
    gemm256<1024, 1024, 1024>(acc, p.mg + (size_t)mt * 256 * 1024, p.wts + (size_t)l * WL + O_OUT + (size_t)dt * 256 * 1024, shm, p);
    {
      float4 aA[4], bA[4];
      f1_load<0, 0>(p, l, mt, dt, aA, bA); f1_proc<0, 0>(p, acc, mt, dt, Cs, aA, bA);
      f1_load<0, 1>(p, l, mt, dt, aA, bA); f1_proc<0, 1>(p, acc, mt, dt, Cs, aA, bA);
      f1_load<1, 0>(p, l, mt, dt, aA, bA); f1_proc<1, 0>(p, acc, mt, dt, Cs, aA, bA);
      f1_load<1, 1>(p, l, mt, dt, aA, bA); f1_proc<1, 1>(p, acc, mt, dt, Cs, aA, bA);
    }
  }
  __syncthreads();
}

template <int AI, int BJ>
DI void f3_load(PREF p, int mt, int dt, u32x4 (&g)[4]) {
  const int t = tid512();
  const int row0 = mt * 256 + AI * 128, col0 = dt * 256 + BJ * 128, c = (t & 15) * 8;
#pragma unroll
  for (int q = 0; q < 4; ++q) g[q] = *(const u32x4*)((const u16*)p.fbuf + (size_t)(row0 + (t >> 4) + 32 * q) * 1024 + col0 + c);
}
template <int AI, int BJ, int PASS>
DI void f3_proc(PREF p, const f32x4 (&acc)[2][2][4][2], int mt, int dt, float* Cs, const u32x4 (&g)[4]) {
  const int t = tid512();
  const int row0 = mt * 256 + AI * 128, col0 = dt * 256 + BJ * 128;
  const int c = (t & 15) * 8;
  stage_q<AI, BJ>(acc, Cs);
#pragma unroll
  for (int q = 0; q < 4; ++q) {
    int r = (t >> 4) + 32 * q;
    float v[8]; ld8(Cs + r * CST + c, v);
    if (PASS == 0) {
#pragma unroll
      for (int j = 0; j < 8; ++j) v[j] = sigm(v[j]);
    } else {
      float gf[8]; unpack8(g[q], gf);
#pragma unroll
      for (int j = 0; j < 8; ++j) v[j] *= gf[j];
    }
    *(u32x4*)((u16*)p.fbuf + (size_t)(row0 + r) * 1024 + col0 + c) = pack8(v);
  }
}
DI void f3_phase(PREF p, int l, unsigned char* lds_all) {
  u16* shm = (u16*)lds_all; float* Cs = (float*)lds_all;
  const u16* W = p.wts + (size_t)l * WL;
  for (int k = 0;; ++k) {
    int mt, dt;
    if (!xcd_tile256(k, 4, mt, dt)) break;
    {
      f32x4 acc[2][2][4][2]; zero_acc256(acc);
      gemm256<1024, 1024, 1024>(acc, p.X + (size_t)mt * 256 * 1024, W + O_PLEG + (size_t)dt * 256 * 1024, shm, p);
      u32x4 gd[4];
      f3_proc<0, 0, 0>(p, acc, mt, dt, Cs, gd); f3_proc<0, 1, 0>(p, acc, mt, dt, Cs, gd);
      f3_proc<1, 0, 0>(p, acc, mt, dt, Cs, gd); f3_proc<1, 1, 0>(p, acc, mt, dt, Cs, gd);
    }
    f32x4 acc[2][2][4][2]; zero_acc256(acc);
    gemm256<256, 256, 256>(acc, p.pb + (size_t)mt * 256 * 256, W + O_PLE + (size_t)dt * 256 * 256, shm, p);
    {
      u32x4 gA[4], gB[4];
      f3_load<0, 0>(p, mt, dt, gA);
      f3_load<0, 1>(p, mt, dt, gB); f3_proc<0, 0, 1>(p, acc, mt, dt, Cs, gA);
      f3_load<1, 0>(p, mt, dt, gA); f3_proc<0, 1, 1>(p, acc, mt, dt, Cs, gB);
      f3_load<1, 1>(p, mt, dt, gB); f3_proc<1, 0, 1>(p, acc, mt, dt, Cs, gA);
      f3_proc<1, 1, 1>(p, acc, mt, dt, Cs, gB);
    }
  }
  __syncthreads();
}

DI void rows_ln(PREF p, int l) {
  const int tid = tidx(), lane = tid & 63, w = tid >> 6;
  float gg[16], bb[16];
#pragma unroll
  for (int h = 0; h < 2; ++h) {
    const int c = h * 512 + lane * 8;
    const float4 g0 = *(const float4*)(p.ln_g + l * 1024 + c), g1 = *(const float4*)(p.ln_g + l * 1024 + c + 4);
    const float4 b0 = *(const float4*)(p.ln_b + l * 1024 + c), b1 = *(const float4*)(p.ln_b + l * 1024 + c + 4);
    gg[h * 8 + 0] = g0.x; gg[h * 8 + 1] = g0.y; gg[h * 8 + 2] = g0.z; gg[h * 8 + 3] = g0.w;
    gg[h * 8 + 4] = g1.x; gg[h * 8 + 5] = g1.y; gg[h * 8 + 6] = g1.z; gg[h * 8 + 7] = g1.w;
    bb[h * 8 + 0] = b0.x; bb[h * 8 + 1] = b0.y; bb[h * 8 + 2] = b0.z; bb[h * 8 + 3] = b0.w;
    bb[h * 8 + 4] = b1.x; bb[h * 8 + 5] = b1.y; bb[h * 8 + 6] = b1.z; bb[h * 8 + 7] = b1.w;
  }
  for (int row = vbid() * 4 + w; row < T_ / 2; row += vgrid() * 4) {
    u32x4 raw[2][2];
#pragma unroll
    for (int k = 0; k < 2; ++k) {
      const u16* src = (const u16*)p.fbuf + (size_t)(row + k * (T_ / 2)) * 1024;
      raw[k][0] = *(const u32x4*)(src + lane * 8);
      raw[k][1] = *(const u32x4*)(src + 512 + lane * 8);
    }
#pragma unroll
    for (int k = 0; k < 2; ++k) {
      float v[16];
      unpack8(raw[k][0], v); unpack8(raw[k][1], v + 8);
      float s = 0.f;
#pragma unroll
      for (int i = 0; i < 16; ++i) s += v[i];
      const float mu = wsum(s) * (1.f / 1024.f);
      float sq = 0.f;
#pragma unroll
      for (int i = 0; i < 16; ++i) { v[i] -= mu; sq += v[i] * v[i]; }
      const float rs = rsqrtf(wsum(sq) * (1.f / 1024.f) + 1e-5f);
#pragma unroll
      for (int h = 0; h < 2; ++h) {
        float y[8];
#pragma unroll
        for (int j = 0; j < 8; ++j) y[j] = v[h * 8 + j] * rs * gg[h * 8 + j] + bb[h * 8 + j];
        *(u32x4*)(p.X + (size_t)(row + k * (T_ / 2)) * 1024 + h * 512 + lane * 8) = pack8(y);
      }
    }
  }
}

DI void rows_ple(PREF p, int l) {
  const int tid = tidx(), lane = tid & 63, w = tid >> 6;
  for (int row = vbid() * 4 + w; row < T_; row += vgrid() * 4) {
    const u16* src = (const u16*)p.fbuf + (size_t)row * 1024;
    float v[16];
    unpack8(*(const u32x4*)(src + lane * 8), v);
    unpack8(*(const u32x4*)(src + 512 + lane * 8), v + 8);
    float xv[16];
    unpack8(*(const u32x4*)(p.X + (size_t)row * 1024 + lane * 8), xv);
    unpack8(*(const u32x4*)(p.X + (size_t)row * 1024 + 512 + lane * 8), xv + 8);
    float sq = 0.f;
#pragma unroll
    for (int i = 0; i < 16; ++i) sq += v[i] * v[i];
    const float rs = rsqrtf(wsum(sq) * (1.f / 1024.f) + 1e-6f);
#pragma unroll
    for (int h = 0; h < 2; ++h) {
      const int c = h * 512 + lane * 8;
      const float4 g0 = *(const float4*)(p.ple_ng + l * 1024 + c), g1 = *(const float4*)(p.ple_ng + l * 1024 + c + 4);
      float y[8];
      y[0] = xv[h * 8 + 0] + v[h * 8 + 0] * rs * g0.x; y[1] = xv[h * 8 + 1] + v[h * 8 + 1] * rs * g0.y;
      y[2] = xv[h * 8 + 2] + v[h * 8 + 2] * rs * g0.z; y[3] = xv[h * 8 + 3] + v[h * 8 + 3] * rs * g0.w;
      y[4] = xv[h * 8 + 4] + v[h * 8 + 4] * rs * g1.x; y[5] = xv[h * 8 + 5] + v[h * 8 + 5] * rs * g1.y;
      y[6] = xv[h * 8 + 6] + v[h * 8 + 6] * rs * g1.z; y[7] = xv[h * 8 + 7] + v[h * 8 + 7] * rs * g1.w;
      if (l == NL - 1) {
        float4* od = (float4*)(p.out + (size_t)row * 1024 + c);
        od[0] = make_float4(y[0], y[1], y[2], y[3]); od[1] = make_float4(y[4], y[5], y[6], y[7]);
      } else {
        *(u32x4*)(p.X + (size_t)row * 1024 + c) = pack8(y);
      }
    }
  }
}

DI void phase_mix1(PREF p, int l, unsigned char* ldsb) {
  for (int it = vbid(); it < 1024; it += vgrid()) {
    int pi = it >> 1, b = pi >> 6, hq = ((pi >> 5) & 1) * 2 + (it & 1), qb = pi & 31;
    const u16* hbb = p.hb + (size_t)b * S_ * HW;
    attn_item<64, true>(hbb + OFF_SQ + hq * 64, HW, hbb + OFF_SK + (hq >> 1) * 64, HW,
                        p.Vst + (size_t)(b * 2 + (hq >> 1)) * 64 * S_, qb, 0.125f * LOG2E, p.sinks[l * 4 + hq] * 8.0f,
                        hbb + OFF_DZ + hq * 64, HW, p.ys + (size_t)b * S_ * 1024 + 768 + hq * 64, 1024, (u16*)ldsb);
  }
  for (int it = vbid(); it < 1024; it += vgrid()) kv_tile(p, l, it, ldsb);
  for (int it = vbid(); it < 768; it += vgrid()) q_tile(p, l, it, ldsb);
  for (int it = vbid(); it < 1024; it += vgrid()) conv_item(p, l, it, ldsb);
  for (int it = vbid(); it < 2048; it += vgrid()) ssm1_item(p, l, it, ldsb);
}
DI void phase_mix2(PREF p, int l, unsigned char* ldsb) {
  for (int it = vbid(); it < 1024; it += vgrid()) {
    int qb = (it < 512) ? 31 - (it >> 5) : ((it - 512) >> 5);
    int bh = it & 31, b = bh >> 2, head = bh & 3;
    attn_item<96, false>(p.Qm + (size_t)b * S_ * 384 + head * 96, 384, p.Km + (size_t)b * S_ * 384 + head * 96, 384,
                         p.Vmt + (size_t)(b * 4 + head) * 64 * S_, qb, 0.10206207261596577f * LOG2E, 0.f,
                         p.hb + (size_t)b * S_ * HW + OFF_BZ + head * 64, HW, p.ys + (size_t)b * S_ * 1024 + 256 + head * 64, 1024,
                         (u16*)ldsb);
  }
  for (int it = vbid(); it < 512; it += vgrid()) pw2_tile(p, l, it, ldsb);
  for (int it = vbid(); it < 2048; it += vgrid()) ssm2_item(p, l, it, ldsb);
}

DI void grid_barrier(unsigned* bar, unsigned gen) {
  asm volatile("s_waitcnt vmcnt(0)" ::: "memory");
  __syncthreads();
  if (threadIdx.x == 0) {
    __builtin_amdgcn_fence(__ATOMIC_RELEASE, "agent");
    const unsigned grp = blockIdx.x & 15u;
    const unsigned nblk = (gridDim.x + 15u - grp) >> 4;
    unsigned old = __hip_atomic_fetch_add(bar + 64 * (1 + grp), 1u, __ATOMIC_RELAXED, __HIP_MEMORY_SCOPE_AGENT);
    if (old + 1u == nblk * gen) {
      unsigned g = __hip_atomic_fetch_add(bar, 1u, __ATOMIC_RELAXED, __HIP_MEMORY_SCOPE_AGENT);
      if (g + 1u == 16u * gen) {
        for (int i = 0; i < 16; ++i) __hip_atomic_store(bar + 64 * (17 + i), gen, __ATOMIC_RELAXED, __HIP_MEMORY_SCOPE_AGENT);
      }
    }
    while (__hip_atomic_load(bar + 64 * (17 + grp), __ATOMIC_RELAXED, __HIP_MEMORY_SCOPE_AGENT) < gen) __builtin_amdgcn_s_sleep(4);
    __builtin_amdgcn_fence(__ATOMIC_ACQUIRE, "agent");
  }
  __syncthreads();
}

template <int J>
DI void run_phase(PREF p, int l, unsigned char* ldsb, unsigned char* lds_all) {
  if (J == 0) phase_in(p, l, lds_all);
  else if (J == 1) phase_mix1(p, l, ldsb);
  else if (J == 2) phase_mix2(p, l, ldsb);
  else if (J == 3) glu_phase(p, l, lds_all);
  else if (J == 4) merge_phase(p, l, lds_all);
  else if (J == 5) f1_phase(p, l, lds_all);
  else if (J == 6) rows_ln(p, l);
  else if (J == 7) f3_phase(p, l, lds_all);
  else if (J == 8) rows_ple(p, l);
  else phase_prep(p, ldsb);
}

#if MULTI_LAUNCH
template <int J>
__global__ void __launch_bounds__(256, 2) phk(Params p, int l) {
  __shared__ __attribute__((aligned(16))) unsigned char ldsb[LDS_BYTES];
  run_phase<J>(p, l, ldsb);
}
#else
__global__ void __launch_bounds__(512, 2) mega(Params p_unused, int ph0, int ph1) {
  __shared__ __attribute__((aligned(16))) unsigned char lds_all[LDS_BYTES];
  unsigned char* ldsb = lds_all + half_() * LDS_HALF;
  cg::grid_group grid = cg::this_grid();
  for (int ph = ph0; ph < ph1; ++ph) {
    const __attribute__((address_space(4))) Params* pp = (const __attribute__((address_space(4))) Params*)__builtin_amdgcn_kernarg_segment_ptr();
    asm volatile("" : "+s"(pp));
    PREF p = *pp;
    if (ph1 < 0) grid.sync();
    if (ph > ph0) grid_barrier(p.bar, (unsigned)(ph - ph0));
    if (ph == 0) { run_phase<9>(p, 0, ldsb, lds_all); continue; }
    int l = (ph - 1) / NPH_LAYER; const int j = (ph - 1) % NPH_LAYER;
    asm volatile("" : "+s"(l));
    if (j == 0) run_phase<0>(p, l, ldsb, lds_all);
    else if (j == 1) run_phase<1>(p, l, ldsb, lds_all);
    else if (j == 2) run_phase<2>(p, l, ldsb, lds_all);
    else if (j == 3) run_phase<3>(p, l, ldsb, lds_all);
    else if (j == 4) run_phase<4>(p, l, ldsb, lds_all);
    else if (j == 5) run_phase<5>(p, l, ldsb, lds_all);
    else if (j == 6) run_phase<6>(p, l, ldsb, lds_all);
    else if (j == 7) run_phase<7>(p, l, ldsb, lds_all);
    else run_phase<8>(p, l, ldsb, lds_all);
  }
}
#endif

extern "C" void kernel_launch(void* const* d_in, const int* in_sizes, int n_in, void* d_out, int out_size, void* d_ws,
                              size_t ws_size, hipStream_t stream) {
  static int grid_blocks = 0;
  if (!grid_blocks) {
    int dev = 0, cus = 0, per_cu = 2;
    (void)hipGetDevice(&dev);
    (void)hipDeviceGetAttribute(&cus, hipDeviceAttributeMultiprocessorCount, dev);
#if !MULTI_LAUNCH
    (void)hipOccupancyMaxActiveBlocksPerMultiprocessor(&per_cu, mega, 512, 0);
    per_cu = 1;
#endif
    if (cus < 1) cus = 256;
    grid_blocks = cus * per_cu;
  }
  Params p{};
  const float** f = (const float**)&p;
  for (int i = 0; i < 31; ++i) f[i] = (const float*)d_in[i];
  p.out = (float*)d_out;
  unsigned char* ws = (unsigned char*)d_ws;
  size_t off = 0;
  auto take = [&](size_t bytes) { unsigned char* r = ws + off; off += (bytes + 255) & ~(size_t)255; return r; };
  p.wts = (u16*)take(WL * NL * 2);
  p.lam = (float*)take((size_t)NL * 16 * 64 * 2 * 4);
  p.bbre = (float*)take((size_t)NL * 16 * 64 * 16 * 4);
  p.bbim = (float*)take((size_t)NL * 16 * 64 * 16 * 4);
  p.rcos = (float*)take((size_t)S_ * 16 * 4);
  p.rsin = (float*)take((size_t)S_ * 16 * 4);
  p.X = (u16*)take((size_t)T_ * 1024 * 2);
  p.pb = (u16*)take((size_t)T_ * 256 * 2);
  p.hb = (u16*)take((size_t)T_ * HW * 2);
  p.ys = (u16*)take((size_t)T_ * 1024 * 2);
  p.cA = (u16*)take((size_t)T_ * 256 * 2);
  p.Qm = (u16*)take((size_t)T_ * 384 * 2);
  p.Km = (u16*)take((size_t)T_ * 384 * 2);
  p.Vmt = (u16*)take((size_t)T_ * 256 * 2);
  p.Vst = (u16*)take((size_t)T_ * 128 * 2);
  p.yss = (u16*)take((size_t)T_ * 256 * 2);
  p.hend = (float*)take((size_t)8 * 16 * 64 * 64 * 2 * 4);
  p.bar = (unsigned*)take(16384);
  p.mg = p.cA;
  p.fbuf = (float*)p.hb;
  if (off > ws_size) fprintf(stderr, "workspace too small: need %zu have %zu\n", off, ws_size);
  const int NPH = 1 + NPH_LAYER * NL;
#if MULTI_LAUNCH
  (void)NPH;
  const dim3 g(grid_blocks), b(256);
  hipLaunchKernelGGL(phk<9>, g, b, 0, stream, p, 0);
  for (int l = 0; l < NL; ++l) {
    hipLaunchKernelGGL(phk<0>, g, b, 0, stream, p, l);
    hipLaunchKernelGGL(phk<1>, g, b, 0, stream, p, l);
    hipLaunchKernelGGL(phk<2>, g, b, 0, stream, p, l);
    hipLaunchKernelGGL(phk<3>, g, b, 0, stream, p, l);
    hipLaunchKernelGGL(phk<4>, g, b, 0, stream, p, l);
    hipLaunchKernelGGL(phk<5>, g, b, 0, stream, p, l);
    hipLaunchKernelGGL(phk<6>, g, b, 0, stream, p, l);
    hipLaunchKernelGGL(phk<7>, g, b, 0, stream, p, l);
    hipLaunchKernelGGL(phk<8>, g, b, 0, stream, p, l);
  }
#else
  int ph0 = 0, ph1 = NPH;
  (void)hipMemsetAsync(p.bar, 0, 16384, stream);
  void* args[] = {&p, &ph0, &ph1};
  hipError_t e = hipLaunchCooperativeKernel((void*)mega, dim3(grid_blocks), dim3(512), args, 0, stream);
  if (e != hipSuccess) fprintf(stderr, "cooperative launch failed: %s (grid %d)\n", hipGetErrorString(e), grid_blocks);
#endif
}
```

```cpp
#include <hip/hip_runtime.h>
#include <hip/hip_cooperative_groups.h>
#include <cstdio>
#include <type_traits>
namespace cg = cooperative_groups;

#ifndef MULTI_LAUNCH
#define MULTI_LAUNCH 0
#endif

typedef unsigned short u16;
typedef __attribute__((ext_vector_type(8))) short bf16x8;
typedef __attribute__((ext_vector_type(4))) float f32x4;
typedef __attribute__((ext_vector_type(16))) float f32x16;
typedef __attribute__((ext_vector_type(4))) unsigned u32x4;
typedef __attribute__((ext_vector_type(2))) unsigned u32x2;
#define DI __device__ __forceinline__
DI int tidx() { int t = threadIdx.x & 255; asm volatile("" : "+v"(t)); return t; }
DI int half_() { return __builtin_amdgcn_readfirstlane((int)(threadIdx.x >> 8)); }
DI int vbid() { return (int)blockIdx.x * 2 + half_(); }
DI int vgrid() { return (int)gridDim.x * 2; }

constexpr int T_ = 32768, S_ = 4096, D_ = 1024, HW = 2720, NL = 4;
constexpr int OFF_AVAL = 0, OFF_AGATE = 256, OFF_AZ = 512, OFF_CQ = 768, OFF_CKV = 1024, OFF_KR = 1152, OFF_BZ = 1184,
              OFF_U = 1440, OFF_CZ = 1696, OFF_SQ = 1952, OFF_SK = 2208, OFF_SV = 2336, OFF_DZ = 2464;
constexpr size_t O_WIN = 0, O_WM = O_WIN + 2816 * 1024, O_PW2 = O_WM + 4096 * 1024, O_UQ = O_PW2 + 65536, O_UKV = O_UQ + 98304,
                 O_GLU = O_UKV + 65536, O_BR = O_GLU + 131072, O_OUT = O_BR + 1048576, O_PLE = O_OUT + 1048576,
                 O_PLEG = O_PLE + 262144, WL = O_PLEG + 1048576;
constexpr int LDT = 64;
constexpr int TILE_E = 128 * LDT;
constexpr int CST = 132;
constexpr int LDS_MAIN = 73728;
constexpr int LDS_HALF = LDS_MAIN + 1024;
constexpr int LDS_BYTES = 2 * LDS_HALF;
constexpr float LOG2E = 1.4426950408889634f;
constexpr int NPH_LAYER = 9;

struct Params {
  const float *x, *p, *w_in, *w_merge, *b_merge, *conv_w, *conv_b, *conv_ng, *conv_nb, *w_pw2, *qng, *kvng, *w_uq, *w_ukv,
      *a_re, *a_im, *log_dt, *b_re, *b_im, *c_re, *c_im, *ssm_d, *w_glu, *sinks, *w_branch, *w_out, *ln_g, *ln_b, *w_ple,
      *w_pleg, *ple_ng;
  float* out;
  u16* wts;
  float *lam, *bbre, *bbim, *rcos, *rsin;
  u16 *X, *pb, *hb, *ys, *cA, *Qm, *Km, *Vmt, *Vst, *yss, *mg;
  float *hend, *fbuf;
  unsigned* bar;
};

typedef const __attribute__((address_space(4))) Params& PREF;

DI unsigned pack2(float a, float b) { unsigned r; asm("v_cvt_pk_bf16_f32 %0, %1, %2\n\ts_nop 1" : "=v"(r) : "v"(a), "v"(b)); return r; }
DI u16 f2bf(float x) { return (u16)(pack2(x, x) & 0xffffu); }
DI float bf2f(u16 v) { return __uint_as_float(((unsigned)v) << 16); }
DI float lo2f(unsigned u) { return __uint_as_float(u << 16); }
DI float hi2f(unsigned u) { return __uint_as_float(u & 0xffff0000u); }
DI float sigm(float x) { return 1.f / (1.f + __expf(-x)); }
DI float silu(float x) { return x / (1.f + __expf(-x)); }
DI float gelu_t(float x) { float u = 0.7978845608028654f * (x + 0.044715f * x * x * x); return x / (1.f + __expf(-2.f * u)); }
DI void unpack8(u32x4 v, float* f) {
  f[0] = lo2f(v.x); f[1] = hi2f(v.x); f[2] = lo2f(v.y); f[3] = hi2f(v.y);
  f[4] = lo2f(v.z); f[5] = hi2f(v.z); f[6] = lo2f(v.w); f[7] = hi2f(v.w);
}
DI u32x4 pack8(const float* f) { u32x4 o; o.x = pack2(f[0], f[1]); o.y = pack2(f[2], f[3]); o.z = pack2(f[4], f[5]); o.w = pack2(f[6], f[7]); return o; }
DI float wsum(float v) {
#pragma unroll
  for (int o = 32; o >= 1; o >>= 1) v += __shfl_xor(v, o);
  return v;
}
#define MFMA32(a, b, c) __builtin_amdgcn_mfma_f32_32x32x16_bf16((a), (b), (c), 0, 0, 0)
#define MFMA16(a, b, c) __builtin_amdgcn_mfma_f32_16x16x32_bf16((a), (b), (c), 0, 0, 0)

DI void zero_acc(f32x4 (&a)[4][4]) {
#pragma unroll
  for (int i = 0; i < 4; ++i)
#pragma unroll
    for (int j = 0; j < 4; ++j)
#pragma unroll
      for (int k = 0; k < 4; ++k) a[i][j][k] = 0.f;
}

#define GM_LOAD(RA, RB, KT)                                                                 \
  _Pragma("unroll") for (int i = 0; i < 4; ++i) {                                           \
    RA[i] = *(const u32x4*)(ag + (size_t)(32 * i) * lda + (KT) * 64);                       \
    RB[i] = *(const u32x4*)(bg + (size_t)(32 * i) * ldb + (KT) * 64);                       \
  }
#define GM_STORE(RA, RB, STG)                                                               \
  {                                                                                         \
    u16* dA_ = lds + (STG) * 2 * TILE_E;                                                    \
    _Pragma("unroll") for (int i = 0; i < 4; ++i) {                                         \
      *(u32x4*)(dA_ + (lrow + 32 * i) * LDT + lsw) = RA[i];                                 \
      *(u32x4*)(dA_ + TILE_E + (lrow + 32 * i) * LDT + lsw) = RB[i];                        \
    }                                                                                       \
  }
#define GM_COMPUTE(STG)                                                                     \
  {                                                                                         \
    const u16* sA = lds + (STG) * 2 * TILE_E + (wm * 64 + fr) * LDT;                        \
    const u16* sB = lds + (STG) * 2 * TILE_E + TILE_E + (wn * 64 + fr) * LDT;               \
    __builtin_amdgcn_s_setprio(1);                                                          \
    _Pragma("unroll") for (int kk = 0; kk < 2; ++kk) {                                      \
      const int co = (((kk * 4 + fq) ^ (fr & 7)) * 8);                                      \
      bf16x8 af[4];                                                                         \
      _Pragma("unroll") for (int m = 0; m < 4; ++m) af[m] = *(const bf16x8*)(sA + m * 16 * LDT + co);   \
      _Pragma("unroll") for (int n = 0; n < 4; ++n) {                                       \
        const bf16x8 bfr = *(const bf16x8*)(sB + n * 16 * LDT + co);                        \
        _Pragma("unroll") for (int m = 0; m < 4; ++m) acc[m][n] = MFMA16(af[m], bfr, acc[m][n]);        \
      }                                                                                     \
    }                                                                                       \
    __builtin_amdgcn_s_setprio(0);                                                          \
  }
template <bool DEEP = true>
DI void gemm_main(f32x4 (&acc)[4][4], const u16* __restrict__ A, int lda, const u16* __restrict__ B, int ldb, int K, u16* lds) {
  const int tid = tidx(), lane = tid & 63, w = tid >> 6;
  const int wm = w >> 1, wn = w & 1, fr = lane & 15, fq = lane >> 4;
  const int lrow = tid >> 3, lch = (tid & 7) * 8, lsw = ((tid & 7) ^ (lrow & 7)) * 8;
  const u16* ag = A + (size_t)lrow * lda + lch;
  const u16* bg = B + (size_t)lrow * ldb + lch;
  const int nk = K >> 6;
  if (DEEP) {
    u32x4 ra0[4], rb0[4], ra1[4], rb1[4];
    GM_LOAD(ra0, rb0, 0)
    GM_LOAD(ra1, rb1, 1)
    __syncthreads();
    GM_STORE(ra0, rb0, 0)
    __syncthreads();
    for (int kt = 0; kt < nk; kt += 2) {
      if (kt + 2 < nk) { GM_LOAD(ra0, rb0, kt + 2) }
      GM_COMPUTE(0)
      __builtin_amdgcn_sched_barrier(0);
      GM_STORE(ra1, rb1, 1)
      __syncthreads();
      if (kt + 3 < nk) { GM_LOAD(ra1, rb1, kt + 3) }
      GM_COMPUTE(1)
      __builtin_amdgcn_sched_barrier(0);
      if (kt + 2 < nk) { GM_STORE(ra0, rb0, 0) }
      __syncthreads();
    }
  } else {
    u32x4 ra0[4], rb0[4];
    GM_LOAD(ra0, rb0, 0)
    __syncthreads();
    GM_STORE(ra0, rb0, 0)
    __syncthreads();
    for (int kt = 0; kt < nk; kt += 2) {
      GM_LOAD(ra0, rb0, kt + 1)
      GM_COMPUTE(0)
      __builtin_amdgcn_sched_barrier(0);
      GM_STORE(ra0, rb0, 1)
      __syncthreads();
      if (kt + 2 < nk) { GM_LOAD(ra0, rb0, kt + 2) }
      GM_COMPUTE(1)
      __builtin_amdgcn_sched_barrier(0);
      if (kt + 2 < nk) { GM_STORE(ra0, rb0, 0) }
      __syncthreads();
    }
  }
}

DI void stage_c(const f32x4 (&acc)[4][4], float* Cs) {
  const int tid = tidx(), lane = tid & 63, w = tid >> 6;
  const int wm = w >> 1, wn = w & 1, fr = lane & 15, fq = lane >> 4;
#pragma unroll
  for (int m = 0; m < 4; ++m)
#pragma unroll
    for (int n = 0; n < 4; ++n)
#pragma unroll
      for (int j = 0; j < 4; ++j) Cs[(wm * 64 + m * 16 + fq * 4 + j) * CST + wn * 64 + n * 16 + fr] = acc[m][n][j];
  __syncthreads();
}
DI void ld8(const float* Cs, float* v) {
  float4 a = *(const float4*)Cs, b = *(const float4*)(Cs + 4);
  v[0] = a.x; v[1] = a.y; v[2] = a.z; v[3] = a.w; v[4] = b.x; v[5] = b.y; v[6] = b.z; v[7] = b.w;
}

DI void prep_w(const float* __restrict__ src, int K, int N, u16* __restrict__ dst, int Npad, const float* __restrict__ g, int perm,
               u16* T) {
  const int tid = tidx();
  const int ntn = Npad >> 6, ntiles = (K >> 6) * ntn;
  for (int it = vbid(); it < ntiles; it += vgrid()) {
    const int kt = it / ntn, k0 = kt * 64, n0 = (it - kt * ntn) * 64;
    int sn0 = n0;
    if (perm) { int tl = n0 >> 7, rr = n0 & 127; sn0 = (rr < 64) ? (tl * 64 + rr) : (256 + tl * 64 + rr - 64); }
    __syncthreads();
    {
      const int nn = tid & 63, kq = tid >> 6;
      const bool valid = (n0 + nn) < N;
      float v[16];
#pragma unroll
      for (int i = 0; i < 16; ++i) v[i] = valid ? src[(size_t)(k0 + kq + 4 * i) * N + sn0 + nn] : 0.f;
      if (g) {
#pragma unroll
        for (int i = 0; i < 16; ++i) v[i] *= g[k0 + kq + 4 * i];
      }
#pragma unroll
      for (int i = 0; i < 16; ++i) T[(kq + 4 * i) * 72 + nn] = f2bf(v[i]);
    }
    __syncthreads();
    {
      const int nn = tid >> 2, kc = (tid & 3) * 16;
      unsigned w[8];
#pragma unroll
      for (int j = 0; j < 8; ++j) w[j] = (unsigned)T[(kc + 2 * j) * 72 + nn] | ((unsigned)T[(kc + 2 * j + 1) * 72 + nn] << 16);
      u32x4 o0 = {w[0], w[1], w[2], w[3]}, o1 = {w[4], w[5], w[6], w[7]};
      u16* d = dst + (size_t)(n0 + nn) * K + k0 + kc;
      *(u32x4*)d = o0; *(u32x4*)(d + 8) = o1;
    }
  }
}

DI void phase_prep(PREF p, unsigned char* ldsb) {
  u16* T = (u16*)ldsb;
  const int gtid = vbid() * 256 + tidx(), gsz = vgrid() * 256;
  for (int l = 0; l < NL; ++l) {
    u16* W = p.wts + (size_t)l * WL;
    prep_w(p.w_in + (size_t)l * 1024 * HW, 1024, HW, W + O_WIN, 2816, nullptr, 0, T);
    prep_w(p.w_merge + (size_t)l * 1024 * 4096, 1024, 4096, W + O_WM, 4096, nullptr, 0, T);
    prep_w(p.w_pw2 + (size_t)l * 65536, 256, 256, W + O_PW2, 256, nullptr, 0, T);
    prep_w(p.w_uq + (size_t)l * 256 * 384, 256, 384, W + O_UQ, 384, p.qng + l * 256, 0, T);
    prep_w(p.w_ukv + (size_t)l * 128 * 512, 128, 512, W + O_UKV, 512, p.kvng + l * 128, 0, T);
    prep_w(p.w_glu + (size_t)l * 256 * 512, 256, 512, W + O_GLU, 512, nullptr, 1, T);
    for (int nb = 0; nb < 4; ++nb)
      prep_w(p.w_branch + ((size_t)l * 4 + nb) * 256 * 1024, 256, 1024, W + O_BR + (size_t)nb * 1024 * 256, 1024, nullptr, 0, T);
    prep_w(p.w_out + (size_t)l * 1048576, 1024, 1024, W + O_OUT, 1024, nullptr, 0, T);
    prep_w(p.w_ple + (size_t)l * 262144, 256, 1024, W + O_PLE, 1024, nullptr, 0, T);
    prep_w(p.w_pleg + (size_t)l * 1048576, 1024, 1024, W + O_PLEG, 1024, nullptr, 0, T);
  }
  for (int idx = gtid; idx < NL * 16 * 64; idx += gsz) {
    int lg = idx >> 6;
    float dt = expf(p.log_dt[lg]);
    float lr = p.a_re[idx], li = p.a_im[idx];
    float mag = expf(lr * dt);
    float lbr = mag * cosf(li * dt), lbi = mag * sinf(li * dt);
    float den = lr * lr + li * li;
    float nr = lbr - 1.f, ni = lbi;
    float fre = (nr * lr + ni * li) / den, fim = (ni * lr - nr * li) / den;
    p.lam[idx * 2] = lbr; p.lam[idx * 2 + 1] = lbi;
    for (int h = 0; h < 16; ++h) {
      float br = p.b_re[(size_t)idx * 16 + h], bi = p.b_im[(size_t)idx * 16 + h];
      p.bbre[(size_t)idx * 16 + h] = fre * br - fim * bi;
      p.bbim[(size_t)idx * 16 + h] = fre * bi + fim * br;
    }
  }
  for (int idx = gtid; idx < S_ * 16; idx += gsz) {
    int pos = idx >> 4, i = idx & 15;
    float inv = powf(10000.f, -(float)(2 * i) / 32.f);
    float ang = (float)pos * inv;
    p.rcos[idx] = cosf(ang); p.rsin[idx] = sinf(ang);
  }
  for (int idx = gtid; idx < T_ * D_ / 8; idx += gsz) {
    const float4* s = (const float4*)(p.x + (size_t)idx * 8);
    float4 a = s[0], b = s[1];
    float v[8] = {a.x, a.y, a.z, a.w, b.x, b.y, b.z, b.w};
    *(u32x4*)(p.X + (size_t)idx * 8) = pack8(v);
  }
}

constexpr int G_HT = 128 * 64;
DI void lds_barrier() { asm volatile("s_waitcnt lgkmcnt(0)\n\ts_barrier" ::: "memory"); }
DI int tid512() { int t = threadIdx.x; asm volatile("" : "+v"(t)); return t; }
DI void g_stage_rc(int b, int& R, int& C) {
  int st = b >> 10, sb = b & 1023, swz = sb ^ (((sb >> 9) & 1) << 5);
  R = (st >> 1) * 16 + (swz >> 6); C = (st & 1) * 32 + ((swz & 63) >> 1);
}
#define G_SA(b, h) (shm + ((b) * 2 + (h)) * G_HT)
#define G_SB(b, h) (shm + (4 + (b) * 2 + (h)) * G_HT)
#define G_STAGE(P, BASE, O0, O1, LD, br, KOFF)                                                                             \
  do {                                                                                                                    \
    const u16* g_ = (BASE) + (size_t)(br) * (LD) + (KOFF);                                                              \
    __builtin_amdgcn_global_load_lds((const unsigned*)(g_ + (O0)), (unsigned*)((char*)(P) + t * 16), 16, 0, 0);          \
    __builtin_amdgcn_global_load_lds((const unsigned*)(g_ + (O1)), (unsigned*)((char*)(P) + t * 16 + 8192), 16, 0, 0);   \
  } while (0)
#define G_LDA(dst, b, h)                                                                                                  \
  _Pragma("unroll") for (int m = 0; m < 4; ++m) _Pragma("unroll") for (int k = 0; k < 2; ++k)                             \
      dst[m][k] = *(const bf16x8*)((const char*)G_SA(b, h) + ((wr * 4 + m) * 2 + k) * 1024 + rdo)
#define G_LDB(dst, b, h)                                                                                                  \
  _Pragma("unroll") for (int n = 0; n < 2; ++n) _Pragma("unroll") for (int k = 0; k < 2; ++k)                             \
      dst[n][k] = *(const bf16x8*)((const char*)G_SB(b, h) + ((wc * 2 + n) * 2 + k) * 1024 + rdo)
#define G_MMA(ai, bj, At, Bt)                                                                                             \
  do {                                                                                                                    \
    __builtin_amdgcn_s_setprio(1);                                                                                        \
    _Pragma("unroll") for (int m = 0; m < 4; ++m) _Pragma("unroll") for (int n = 0; n < 2; ++n)                           \
        _Pragma("unroll") for (int k = 0; k < 2; ++k) acc[ai][bj][m][n] = MFMA16(At[m][k], Bt[n][k], acc[ai][bj][m][n]);  \
    __builtin_amdgcn_s_setprio(0);                                                                                        \
  } while (0)
#define G_WAIT_V(n) asm volatile("s_waitcnt vmcnt(" #n ")" ::: "memory")
#define G_WAIT_L(n) asm volatile("s_waitcnt lgkmcnt(" #n ")" ::: "memory")
#define G_BAR __builtin_amdgcn_s_barrier()
#define G_SCHED __builtin_amdgcn_sched_barrier(0)

DI void br_flush(PREF p, f32x4 (&acc)[2][2][4][2], int slot);
template <int LDA, int LDB, int K, int MODE = 0>
DI void gemm256(f32x4 (&acc)[2][2][4][2], const u16* __restrict__ A, const u16* __restrict__ B, u16* shm, PREF p) {
#define KA(kt) ((kt) * 64)
#define KB(kt) (MODE ? (((kt) >> 2) * (1024 * LDB) + ((kt) & 3) * 64) : (kt) * 64)
  const int t = tid512();
  const int wid = t >> 6, lane = t & 63, wr = wid >> 2, wc = wid & 3, fr = lane & 15, fq = lane >> 4;
  int r0, c0, r1, c1;
  g_stage_rc(t * 16, r0, c0); g_stage_rc(t * 16 + 8192, r1, c1);
  const int oa0 = r0 * LDA + c0, oa1 = r1 * LDA + c1, ob0 = r0 * LDB + c0, ob1 = r1 * LDB + c1;
  const int obr = fr * 64 + fq * 16, rdo = obr ^ (((obr >> 9) & 1) << 5);
  bf16x8 At[4][2], B0[2][2], B1[2][2];
  constexpr int nt = K / 64;
  lds_barrier();
  G_STAGE(G_SB(0, 0), B, ob0, ob1, LDB, 0, KB(0)); G_STAGE(G_SA(0, 0), A, oa0, oa1, LDA, 0, KA(0));
  G_STAGE(G_SB(0, 1), B, ob0, ob1, LDB, 128, KB(0)); G_STAGE(G_SA(0, 1), A, oa0, oa1, LDA, 128, KA(0));
  if (wr == 1) G_BAR;
  G_WAIT_V(4); G_BAR;
  G_STAGE(G_SB(1, 0), B, ob0, ob1, LDB, 0, KB(1)); G_STAGE(G_SA(1, 0), A, oa0, oa1, LDA, 0, KA(1)); G_STAGE(G_SB(1, 1), B, ob0, ob1, LDB, 128, KB(1));
  G_WAIT_V(6); G_BAR;
  for (int tt = 0; tt < nt - 2; tt += 2) {
    G_LDB(B0, 0, 0); G_SCHED; G_LDA(At, 0, 0); G_STAGE(G_SA(1, 1), A, oa0, oa1, LDA, 128, KA(tt + 1));
    G_WAIT_L(8); G_BAR; G_WAIT_L(0); G_MMA(0, 0, At, B0); G_BAR; G_SCHED;
    G_LDB(B1, 0, 1); G_STAGE(G_SB(0, 0), B, ob0, ob1, LDB, 0, KB(tt + 2));
    G_BAR; G_WAIT_L(0); G_MMA(0, 1, At, B1); G_BAR;
    G_LDA(At, 0, 1); G_STAGE(G_SA(0, 0), A, oa0, oa1, LDA, 0, KA(tt + 2));
    G_BAR; G_WAIT_L(0); G_MMA(1, 0, At, B0); G_BAR; G_SCHED;
    G_STAGE(G_SB(0, 1), B, ob0, ob1, LDB, 128, KB(tt + 2));
    G_WAIT_V(6); G_BAR; G_MMA(1, 1, At, B1); G_BAR;
    G_LDB(B0, 1, 0); G_SCHED; G_LDA(At, 1, 0); G_STAGE(G_SA(0, 1), A, oa0, oa1, LDA, 128, KA(tt + 2));
    G_WAIT_L(8); G_BAR; G_WAIT_L(0); G_MMA(0, 0, At, B0); G_BAR; G_SCHED;
    G_LDB(B1, 1, 1); G_STAGE(G_SB(1, 0), B, ob0, ob1, LDB, 0, KB(tt + 3));
    G_BAR; G_WAIT_L(0); G_MMA(0, 1, At, B1); G_BAR;
    G_LDA(At, 1, 1); G_STAGE(G_SA(1, 0), A, oa0, oa1, LDA, 0, KA(tt + 3));
    G_BAR; G_WAIT_L(0); G_MMA(1, 0, At, B0); G_BAR; G_SCHED;
    G_STAGE(G_SB(1, 1), B, ob0, ob1, LDB, 128, KB(tt + 3));
    G_WAIT_V(6); G_BAR; G_MMA(1, 1, At, B1); G_BAR;
    if (MODE && ((tt + 1) & 3) == 3) br_flush(p, acc, (tt + 1) >> 2);
  }
  {
    G_LDB(B0, 0, 0); G_LDA(At, 0, 0); G_STAGE(G_SA(1, 1), A, oa0, oa1, LDA, 128, KA(nt - 1));
    G_BAR; G_WAIT_L(0); G_MMA(0, 0, At, B0); G_BAR;
    G_LDB(B1, 0, 1); G_BAR; G_WAIT_L(0); G_MMA(0, 1, At, B1); G_BAR;
    G_LDA(At, 0, 1); G_WAIT_V(4); G_BAR; G_WAIT_L(0); G_MMA(1, 0, At, B0); G_MMA(1, 1, At, B1); G_BAR;
  }
  {
    G_LDB(B0, 1, 0); G_LDA(At, 1, 0); G_WAIT_V(2); G_BAR; G_WAIT_L(0); G_MMA(0, 0, At, B0); G_BAR;
    G_LDB(B1, 1, 1); G_WAIT_V(0); G_BAR; G_WAIT_L(0); G_MMA(0, 1, At, B1); G_BAR;
    G_LDA(At, 1, 1); G_BAR; G_WAIT_L(0); G_MMA(1, 0, At, B0); G_MMA(1, 1, At, B1); G_BAR;
  }
  if (wr == 0) G_BAR;
#undef KA
#undef KB
}
DI void zero_acc256(f32x4 (&a)[2][2][4][2]) {
#pragma unroll
  for (int i = 0; i < 2; ++i)
#pragma unroll
    for (int j = 0; j < 2; ++j)
#pragma unroll
      for (int m = 0; m < 4; ++m)
#pragma unroll
        for (int n = 0; n < 2; ++n)
#pragma unroll
          for (int e = 0; e < 4; ++e) a[i][j][m][n][e] = 0.f;
}
template <int AI, int BJ>
DI void stage_q(const f32x4 (&acc)[2][2][4][2], float* Cs) {
  const int t = tid512(), wid = t >> 6, lane = t & 63, wr = wid >> 2, wc = wid & 3, fr = lane & 15, fq = lane >> 4;
  lds_barrier();
#pragma unroll
  for (int m = 0; m < 4; ++m)
#pragma unroll
    for (int n = 0; n < 2; ++n)
#pragma unroll
      for (int j = 0; j < 4; ++j) Cs[(wr * 64 + m * 16 + fq * 4 + j) * CST + wc * 32 + n * 16 + fr] = acc[AI][BJ][m][n][j];
  lds_barrier();
}
DI bool xcd_tile256(int k, int NT, int& m, int& n) {
  const int x = blockIdx.x & 7, slots = gridDim.x >> 3;
  const int idx = (int)(blockIdx.x >> 3) + slots * k;
  if (idx >= 16 * NT) return false;
  const int mg = idx / (8 * NT), rem = idx - mg * 8 * NT;
  n = rem >> 3; m = x * 16 + mg * 8 + (rem & 7);
  return true;
}

DI bool xcd_tile(int k, int NT, int& m, int& n) {
  const int x = (vbid() >> 1) & 7, slots = vgrid() >> 3;
  const int idx = (((vbid() >> 4) << 1) | (vbid() & 1)) + slots * k;
  if (idx >= 32 * NT) return false;
  const int mg = idx / (8 * NT), rem = idx - mg * 8 * NT;
  n = rem >> 3; m = x * 32 + mg * 8 + (rem & 7);
  return true;
}

template <int AI, int BJ>
DI void in_quadrant(PREF p, const f32x4 (&acc)[2][2][4][2], int mt, int nt, float* Cs) {
  const int t = tid512();
  const int row0 = mt * 256 + AI * 128, col0 = nt * 256 + BJ * 128;
  if (col0 >= HW) return;
  stage_q<AI, BJ>(acc, Cs);
#pragma unroll
  for (int q = 0; q < 4; ++q) {
    int r = (t >> 4) + 32 * q, c = (t & 15) * 8;
    if (col0 + c < HW) {
      float v[8]; ld8(Cs + r * CST + c, v);
      *(u32x4*)(p.hb + (size_t)(row0 + r) * HW + col0 + c) = pack8(v);
    }
  }
  if (col0 + 128 > OFF_SV && col0 < OFF_SV + 128) {
    int b = row0 >> 12, s0 = row0 & 4095;
#pragma unroll
    for (int q = 0; q < 4; ++q) {
      int item = t + 512 * q; int c = item & 127, rg = item >> 7;
      int vc = col0 + c - OFF_SV;
      if (vc >= 0 && vc < 128) {
        float v[8];
#pragma unroll
        for (int j = 0; j < 8; ++j) v[j] = Cs[(rg * 8 + j) * CST + c];
        *(u32x4*)(p.Vst + ((size_t)(b * 2 + (vc >> 6)) * 64 + (vc & 63)) * S_ + s0 + rg * 8) = pack8(v);
      }
    }
  }
}
DI void phase_in(PREF p, int l, unsigned char* lds_all) {
  u16* shm = (u16*)lds_all; float* Cs = (float*)lds_all;
  const int tid = tidx();
  const u16* W = p.wts + (size_t)l * WL + O_WIN;
  for (int k = 0;; ++k) {
    int mt, nt;
    if (!xcd_tile256(k, 11, mt, nt)) break;
    f32x4 acc[2][2][4][2]; zero_acc256(acc);
    gemm256<1024, 1024, 1024>(acc, p.X + (size_t)mt * 256 * 1024, W + (size_t)nt * 256 * 1024, shm, p);
    in_quadrant<0, 0>(p, acc, mt, nt, Cs); in_quadrant<0, 1>(p, acc, mt, nt, Cs);
    in_quadrant<1, 0>(p, acc, mt, nt, Cs); in_quadrant<1, 1>(p, acc, mt, nt, Cs);
  }
  __syncthreads();
  const int gtid = vbid() * 256 + tid, gsz = vgrid() * 256;
  const float* ps = p.p + (size_t)l * T_ * 256;
  for (int idx = gtid; idx < T_ * 256 / 8; idx += gsz) {
    const float4* s = (const float4*)(ps + (size_t)idx * 8);
    float4 a = s[0], b = s[1];
    float v[8] = {a.x, a.y, a.z, a.w, b.x, b.y, b.z, b.w};
    *(u32x4*)(p.pb + (size_t)idx * 8) = pack8(v);
  }
}

template <int DQK, bool WIN>
DI void attn_item(const u16* __restrict__ Qb, int ldq, const u16* __restrict__ Kb, int ldk, const u16* __restrict__ Vtb, int qb,
                  float qscale, float sink2, const u16* __restrict__ zb, int ldz, u16* __restrict__ ob, int ldo, u16* lds) {
  constexpr int KST = DQK + 8, NKS = DQK / 16, KCH = DQK / 8;
  constexpr int KBUF = 64 * KST, VBUF = 64 * 72, STG = KBUF + VBUF;
  constexpr int NKL = (64 * KCH) / 256;
  const int tid = tidx(), lane = tid & 63, w = tid >> 6, r = lane & 31, hh = lane >> 5;
  const int q0 = qb * 128 + w * 32;
  const int qrow = q0 + r;
  bf16x8 qf[NKS];
#pragma unroll
  for (int s = 0; s < NKS; ++s) qf[s] = *(const bf16x8*)(Qb + (size_t)qrow * ldq + 16 * s + 8 * hh);
  const int kt_lo = WIN ? (qb > 0 ? 2 * qb - 2 : 0) : 0;
  const int kt_hi = 2 * qb + 1;
  f32x16 o[2];
#pragma unroll
  for (int i = 0; i < 16; ++i) { o[0][i] = 0.f; o[1][i] = 0.f; }
  float m = WIN ? sink2 : -1e30f;
  float lsum = (WIN && hh == 0) ? 1.f : 0.f;
  u32x4 rkA[NKL], rvA[2], rkB[NKL], rvB[2];
  auto gload = [&](u32x4 (&rk)[NKL], u32x4 (&rv)[2], int kt) {
#pragma unroll
    for (int i = 0; i < NKL; ++i) {
      int id = tid + 256 * i; int row = id / KCH, ch = id % KCH;
      rk[i] = *(const u32x4*)(Kb + (size_t)(kt * 64 + row) * ldk + ch * 8);
    }
#pragma unroll
    for (int i = 0; i < 2; ++i) {
      int id = tid + 256 * i; int row = id >> 3, ch = id & 7;
      rv[i] = *(const u32x4*)(Vtb + (size_t)row * S_ + kt * 64 + ch * 8);
    }
  };
  auto swrite = [&](const u32x4 (&rk)[NKL], const u32x4 (&rv)[2], int buf) {
    u16* ks = lds + buf * STG; u16* vs = ks + KBUF;
#pragma unroll
    for (int i = 0; i < NKL; ++i) {
      int id = tid + 256 * i; int row = id / KCH, ch = id % KCH;
      *(u32x4*)(ks + row * KST + ch * 8) = rk[i];
    }
#pragma unroll
    for (int i = 0; i < 2; ++i) {
      int id = tid + 256 * i; int row = id >> 3, ch = id & 7;
      u16* d = vs + row * 72 + (ch >> 1) * 16 + (ch & 1) * 4;
      u32x2 lo = {rv[i].x, rv[i].y}, hi = {rv[i].z, rv[i].w};
      *(u32x2*)d = lo; *(u32x2*)(d + 8) = hi;
    }
  };
  auto tile_body = [&](int kt, int buf, auto mask_tag) {
    constexpr bool MASK = decltype(mask_tag)::value;
    const u16* ks = lds + buf * STG; const u16* vs = ks + KBUF;
    const int k0 = kt * 64;
    bool active = (k0 <= q0 + 31);
    if (WIN) active = active && (k0 + 63 >= q0 - 127);
    if (active) {
      f32x16 st[2];
#pragma unroll
      for (int kb = 0; kb < 2; ++kb) {
#pragma unroll
        for (int i = 0; i < 16; ++i) st[kb][i] = 0.f;
#pragma unroll
        for (int s = 0; s < NKS; ++s) {
          bf16x8 a = *(const bf16x8*)(ks + (kb * 32 + r) * KST + 16 * s + 8 * hh);
          st[kb] = MFMA32(a, qf[s], st[kb]);
        }
      }
      float mx = -INFINITY;
#pragma unroll
      for (int kb = 0; kb < 2; ++kb)
#pragma unroll
        for (int i = 0; i < 16; ++i) {
          float v = st[kb][i];
          if (MASK) {
            int kg = k0 + kb * 32 + (i & 3) + 8 * (i >> 2) + 4 * hh;
            bool ok = kg <= qrow;
            if (WIN) ok = ok && (qrow - kg < 128);
            v = ok ? v : -INFINITY;
            st[kb][i] = v;
          }
          mx = fmaxf(mx, v);
        }
      mx = fmaxf(mx, __shfl_xor(mx, 32));
      const float mn = fmaxf(m, mx);
      if (__any(mn != m)) {
        const float alpha = __builtin_amdgcn_exp2f((m - mn) * qscale);
        lsum *= alpha;
#pragma unroll
        for (int i = 0; i < 16; ++i) { o[0][i] *= alpha; o[1][i] *= alpha; }
      }
      m = mn;
      const float nb = -mn * qscale;
      float ps = 0.f;
#pragma unroll
      for (int kb = 0; kb < 2; ++kb)
#pragma unroll
        for (int i = 0; i < 16; ++i) { float pv = __builtin_amdgcn_exp2f(fmaf(st[kb][i], qscale, nb)); st[kb][i] = pv; ps += pv; }
      lsum += ps;
#pragma unroll
      for (int kb = 0; kb < 2; ++kb)
#pragma unroll
        for (int s2 = 0; s2 < 2; ++s2) {
          union { bf16x8 v; unsigned u[4]; } pf;
#pragma unroll
          for (int j = 0; j < 4; ++j) pf.u[j] = pack2(st[kb][8 * s2 + 2 * j], st[kb][8 * s2 + 2 * j + 1]);
#pragma unroll
          for (int vb = 0; vb < 2; ++vb) {
            const bf16x8 vf = *(const bf16x8*)(vs + (vb * 32 + r) * 72 + (kb * 2 + s2) * 16 + hh * 8);
            o[vb] = MFMA32(vf, pf.v, o[vb]);
          }
        }
    }
  };
  __syncthreads();
  gload(rkA, rvA, kt_lo);
  gload(rkB, rvB, kt_lo + 1);
  swrite(rkA, rvA, 0);
  __syncthreads();
  for (int kt = kt_lo; kt <= kt_hi; kt += 2) {
    if (kt + 2 <= kt_hi) gload(rkA, rvA, kt + 2);
    if (WIN || kt >= 2 * qb) tile_body(kt, 0, std::true_type{}); else tile_body(kt, 0, std::false_type{});
    swrite(rkB, rvB, 1);
    __syncthreads();
    if (kt + 3 <= kt_hi) gload(rkB, rvB, kt + 3);
    if (WIN || kt + 1 >= 2 * qb) tile_body(kt + 1, 1, std::true_type{}); else tile_body(kt + 1, 1, std::false_type{});
    if (kt + 2 <= kt_hi) swrite(rkA, rvA, 0);
    __syncthreads();
  }
  float lt = lsum + __shfl_xor(lsum, 32);
  float inv = 1.f / lt;
  u32x2 zr[8];
#pragma unroll
  for (int e = 0; e < 8; ++e) zr[e] = *(const u32x2*)(zb + (size_t)qrow * ldz + (e >> 2) * 32 + 8 * (e & 3) + 4 * hh);
#pragma unroll
  for (int vb = 0; vb < 2; ++vb)
#pragma unroll
    for (int g4 = 0; g4 < 4; ++g4) {
      int vd0 = vb * 32 + 8 * g4 + 4 * hh;
      u32x2 z = zr[vb * 4 + g4];
      float a0 = o[vb][4 * g4 + 0] * inv * silu(lo2f(z.x));
      float a1 = o[vb][4 * g4 + 1] * inv * silu(hi2f(z.x));
      float a2 = o[vb][4 * g4 + 2] * inv * silu(lo2f(z.y));
      float a3 = o[vb][4 * g4 + 3] * inv * silu(hi2f(z.y));
      u32x2 ov; ov.x = pack2(a0, a1); ov.y = pack2(a2, a3);
      *(u32x2*)(ob + (size_t)qrow * ldo + vd0) = ov;
    }
}

DI void conv_item(PREF p, int l, int tile, unsigned char* ldsb) {
  float* Gs = (float*)ldsb;
  const int tid = tidx(), lane = tid & 63, w = tid >> 6;
  const int t0 = tile * 32, s0 = t0 & 4095;
  __syncthreads();
  for (int id = tid; id < 62 * 32; id += 256) {
    int rr = id >> 5, ch = (id & 31) * 8;
    int s = s0 - 30 + rr;
    float v[8];
#pragma unroll
    for (int j = 0; j < 8; ++j) v[j] = 0.f;
    if (s >= 0) {
      const u16* src = p.hb + (size_t)(t0 - 30 + rr) * HW + ch;
      float a[8], g[8];
      unpack8(*(const u32x4*)(src + OFF_AVAL), a);
      unpack8(*(const u32x4*)(src + OFF_AGATE), g);
#pragma unroll
      for (int j = 0; j < 8; ++j) v[j] = a[j] * sigm(g[j]);
    }
    *(float4*)(Gs + rr * 256 + ch) = make_float4(v[0], v[1], v[2], v[3]);
    *(float4*)(Gs + rr * 256 + ch + 4) = make_float4(v[4], v[5], v[6], v[7]);
  }
  __syncthreads();
  {
    const int c = tid;
    float wv[31];
#pragma unroll
    for (int j = 0; j < 31; ++j) wv[j] = p.conv_w[((size_t)l * 31 + j) * 256 + c];
    const float bias = p.conv_b[l * 256 + c];
    for (int tt = 0; tt < 32; ++tt) {
      float acc = bias;
#pragma unroll
      for (int j = 0; j < 31; ++j) acc += wv[j] * Gs[(tt + j) * 256 + c];
      Gs[tt * 256 + c] = acc;
    }
  }
  __syncthreads();
  const float4 gg = *(const float4*)(p.conv_ng + l * 256 + lane * 4);
  const float4 bb = *(const float4*)(p.conv_nb + l * 256 + lane * 4);
  for (int q = 0; q < 8; ++q) {
    int tt = w * 8 + q;
    float4 v = *(const float4*)(Gs + tt * 256 + lane * 4);
    float mu = wsum(v.x + v.y + v.z + v.w) * (1.f / 256.f);
    float d0 = v.x - mu, d1 = v.y - mu, d2 = v.z - mu, d3 = v.w - mu;
    float var = wsum(d0 * d0 + d1 * d1 + d2 * d2 + d3 * d3) * (1.f / 256.f);
    float rs = rsqrtf(var + 1e-5f);
    float y0 = silu(d0 * rs * gg.x + bb.x), y1 = silu(d1 * rs * gg.y + bb.y);
    float y2 = silu(d2 * rs * gg.z + bb.z), y3 = silu(d3 * rs * gg.w + bb.w);
    u32x2 ov; ov.x = pack2(y0, y1); ov.y = pack2(y2, y3);
    *(u32x2*)(p.cA + (size_t)(t0 + tt) * 256 + lane * 4) = ov;
  }
}

DI void ssm_stage_u(PREF p, int b, int c, int gq, float* uS) {
  const int tid = tidx();
  int row = tid >> 2, cc = (tid & 3) * 16;
  const u16* src = p.hb + (size_t)(b * S_ + c * 64 + row) * HW + OFF_U + gq * 64 + cc;
  float f[16];
  unpack8(*(const u32x4*)src, f); unpack8(*(const u32x4*)(src + 8), f + 8);
#pragma unroll
  for (int j = 0; j < 4; ++j) *(float4*)(uS + row * 64 + cc + 4 * j) = make_float4(f[4 * j], f[4 * j + 1], f[4 * j + 2], f[4 * j + 3]);
}
#define SSM_STEP(t)                                                                                                        \
  {                                                                                                                        \
    const float4* up = (const float4*)(uS + (t) * 64 + w * 16);                                                            \
    float4 u0 = up[0], u1 = up[1], u2 = up[2], u3 = up[3];                                                                 \
    float uu[16] = {u0.x, u0.y, u0.z, u0.w, u1.x, u1.y, u1.z, u1.w, u2.x, u2.y, u2.z, u2.w, u3.x, u3.y, u3.z, u3.w};       \
    float bur = 0.f, bui = 0.f;                                                                                            \
    _Pragma("unroll") for (int j = 0; j < 16; ++j) { bur += bre[j] * uu[j]; bui += bim[j] * uu[j]; }                       \
    float nr = lr * hr - li * hi + bur, ni = lr * hi + li * hr + bui;                                                      \
    hr = nr; hi = ni;                                                                                                      \
  }

DI void ssm1_item(PREF p, int l, int item, unsigned char* ldsb) {
  const int gq = item & 3, c = (item >> 2) & 63, b = item >> 8;
  const int tid = tidx(), w = tid >> 6, lane = tid & 63;
  const int g = gq * 4 + w;
  float* uS = (float*)ldsb;
  __syncthreads();
  ssm_stage_u(p, b, c, gq, uS);
  __syncthreads();
  const size_t pi = (size_t)(l * 16 + g) * 64 + lane;
  float bre[16], bim[16];
#pragma unroll
  for (int j = 0; j < 16; ++j) { bre[j] = p.bbre[pi * 16 + j]; bim[j] = p.bbim[pi * 16 + j]; }
  const float lr = p.lam[pi * 2], li = p.lam[pi * 2 + 1];
  float hr = 0.f, hi = 0.f;
  for (int t = 0; t < 64; ++t) SSM_STEP(t)
  ((float2*)p.hend)[((size_t)(b * 16 + g) * 64 + c) * 64 + lane] = make_float2(hr, hi);
}

DI void ssm2_item(PREF p, int l, int item, unsigned char* ldsb) {
  const int gq = item & 3, c = (item >> 2) & 63, b = item >> 8;
  const int tid = tidx(), w = tid >> 6, lane = tid & 63;
  const int g = gq * 4 + w;
  float* uS = (float*)ldsb;
  u16* Hs = (u16*)(ldsb + 16384) + w * (16 * 136);
  __syncthreads();
  ssm_stage_u(p, b, c, gq, uS);
  __syncthreads();
  const size_t pi = (size_t)(l * 16 + g) * 64 + lane;
  float bre[16], bim[16];
#pragma unroll
  for (int j = 0; j < 16; ++j) { bre[j] = p.bbre[pi * 16 + j]; bim[j] = p.bbim[pi * 16 + j]; }
  const float lr = p.lam[pi * 2], li = p.lam[pi * 2 + 1];
  float pr = lr, pim = li;
#pragma unroll
  for (int q = 0; q < 6; ++q) { float a = pr * pr - pim * pim, bq = 2.f * pr * pim; pr = a; pim = bq; }
  float hr = 0.f, hi = 0.f;
  const float2* he = (const float2*)p.hend + ((size_t)(b * 16 + g) * 64) * 64 + lane;
  for (int cc = 0; cc < c; ++cc) {
    float2 e = he[(size_t)cc * 64];
    float nr = pr * hr - pim * hi + e.x, ni = pr * hi + pim * hr + e.y;
    hr = nr; hi = ni;
  }
  const int hcol = lane & 15, q4 = lane >> 4;
  bf16x8 cf[4];
  {
    const float* cre = p.c_re + ((size_t)(l * 16 + g) * 16 + hcol) * 64;
    const float* cim = p.c_im + ((size_t)(l * 16 + g) * 16 + hcol) * 64;
#pragma unroll
    for (int ks = 0; ks < 4; ++ks) {
      float v[8];
#pragma unroll
      for (int j = 0; j < 8; ++j) {
        int k = 32 * ks + 8 * q4 + j;
        v[j] = (k & 1) ? -cim[k >> 1] : cre[k >> 1];
      }
      union { bf16x8 v8; u32x4 u; } cv; cv.u = pack8(v); cf[ks] = cv.v8;
    }
  }
  const float dch = p.ssm_d[l * 256 + g * 16 + hcol];
  for (int sub = 0; sub < 4; ++sub) {
    for (int tt = 0; tt < 16; ++tt) {
      SSM_STEP(sub * 16 + tt)
      *(unsigned*)(Hs + tt * 136 + 2 * lane) = pack2(hr, hi);
    }
    __syncthreads();
    f32x4 acc = {0.f, 0.f, 0.f, 0.f};
#pragma unroll
    for (int ks = 0; ks < 4; ++ks) {
      bf16x8 a = *(const bf16x8*)(Hs + hcol * 136 + 32 * ks + 8 * q4);
      acc = MFMA16(a, cf[ks], acc);
    }
#pragma unroll
    for (int j = 0; j < 4; ++j) {
      int t = sub * 16 + 4 * q4 + j;
      float uu = uS[t * 64 + w * 16 + hcol];
      float yv = gelu_t(acc[j] + dch * uu);
      p.yss[(size_t)(b * S_ + c * 64 + t) * 256 + g * 16 + hcol] = f2bf(yv);
    }
    __syncthreads();
  }
}

DI void q_tile(PREF p, int l, int idx, unsigned char* ldsb) {
  u16* lds = (u16*)ldsb; float* Cs = (float*)ldsb; float* aux = (float*)(ldsb + LDS_MAIN);
  const int tid = tidx();
  const int mt = idx / 3, nt = idx % 3;
  const int row0 = mt * 128, col0 = nt * 128;
  __syncthreads();
  if (tid < 128) {
    const u16* src = p.hb + (size_t)(row0 + tid) * HW + OFF_CQ;
    float ss = 0.f;
    for (int i = 0; i < 32; ++i) { float f[8]; unpack8(*(const u32x4*)(src + i * 8), f);
#pragma unroll
      for (int j = 0; j < 8; ++j) ss += f[j] * f[j]; }
    aux[tid] = rsqrtf(ss * (1.f / 256.f) + 1e-6f);
  }
  f32x4 acc[4][4]; zero_acc(acc);
  gemm_main(acc, p.hb + (size_t)row0 * HW + OFF_CQ, HW, p.wts + (size_t)l * WL + O_UQ + (size_t)col0 * 256, 256, 256, lds);
  stage_c(acc, Cs);
#pragma unroll
  for (int q = 0; q < 8; ++q) {
    int r = (tid >> 4) + 16 * q, c = (tid & 15) * 8;
    int n = col0 + c; int dd = n % 96;
    float rs = aux[r];
    float v[8]; ld8(Cs + r * CST + c, v);
#pragma unroll
    for (int j = 0; j < 8; ++j) v[j] *= rs;
    if (dd >= 64) {
      int ri0 = dd - 64; int s = (row0 + r) & 4095;
      float pv[8];
      if (ri0 < 16) {
        ld8(Cs + r * CST + c + 16, pv);
        const float* cs = p.rcos + s * 16 + ri0; const float* sn = p.rsin + s * 16 + ri0;
#pragma unroll
        for (int j = 0; j < 8; ++j) v[j] = v[j] * cs[j] - pv[j] * rs * sn[j];
      } else {
        ld8(Cs + r * CST + c - 16, pv);
        const float* cs = p.rcos + s * 16 + ri0 - 16; const float* sn = p.rsin + s * 16 + ri0 - 16;
#pragma unroll
        for (int j = 0; j < 8; ++j) v[j] = v[j] * cs[j] + pv[j] * rs * sn[j];
      }
    }
    *(u32x4*)(p.Qm + (size_t)(row0 + r) * 384 + n) = pack8(v);
  }
}

DI void kv_tile(PREF p, int l, int idx, unsigned char* ldsb) {
  u16* lds = (u16*)ldsb; float* Cs = (float*)ldsb; float* aux = (float*)(ldsb + LDS_MAIN);
  const int tid = tidx();
  const int mt = idx >> 2, head = idx & 3;
  const int row0 = mt * 128;
  __syncthreads();
  if (tid < 128) {
    const u16* src = p.hb + (size_t)(row0 + tid) * HW + OFF_CKV;
    float ss = 0.f;
    for (int i = 0; i < 16; ++i) { float f[8]; unpack8(*(const u32x4*)(src + i * 8), f);
#pragma unroll
      for (int j = 0; j < 8; ++j) ss += f[j] * f[j]; }
    aux[tid] = rsqrtf(ss * (1.f / 128.f) + 1e-6f);
  }
  f32x4 acc[4][4]; zero_acc(acc);
  gemm_main(acc, p.hb + (size_t)row0 * HW + OFF_CKV, HW, p.wts + (size_t)l * WL + O_UKV + (size_t)head * 128 * 128, 128, 128, lds);
  stage_c(acc, Cs);
#pragma unroll
  for (int q = 0; q < 4; ++q) {
    int r = (tid >> 3) + 32 * q, c = (tid & 7) * 8;
    float rs = aux[r];
    float v[8]; ld8(Cs + r * CST + c, v);
#pragma unroll
    for (int j = 0; j < 8; ++j) v[j] *= rs;
    *(u32x4*)(p.Km + (size_t)(row0 + r) * 384 + head * 96 + c) = pack8(v);
  }
  {
    int b = row0 >> 12, s0 = row0 & 4095;
#pragma unroll
    for (int q = 0; q < 4; ++q) {
      int item = tid + 256 * q; int c = item & 63, rg = item >> 6;
      float v[8];
#pragma unroll
      for (int j = 0; j < 8; ++j) v[j] = Cs[(rg * 8 + j) * CST + 64 + c] * aux[rg * 8 + j];
      *(u32x4*)(p.Vmt + ((size_t)(b * 4 + head) * 64 + c) * S_ + s0 + rg * 8) = pack8(v);
    }
  }
  {
    int r = tid >> 1, half = tid & 1;
    int t = row0 + r, s = t & 4095;
    const u16* src = p.hb + (size_t)t * HW + OFF_KR;
    float x1[16], x2[16];
    unpack8(*(const u32x4*)(src), x1); unpack8(*(const u32x4*)(src + 8), x1 + 8);
    unpack8(*(const u32x4*)(src + 16), x2); unpack8(*(const u32x4*)(src + 24), x2 + 8);
    const float* cs = p.rcos + s * 16; const float* sn = p.rsin + s * 16;
    float ov[16];
#pragma unroll
    for (int i = 0; i < 16; ++i) ov[i] = half ? (x2[i] * cs[i] + x1[i] * sn[i]) : (x1[i] * cs[i] - x2[i] * sn[i]);
    u16* dst = p.Km + (size_t)t * 384 + head * 96 + 64 + half * 16;
    *(u32x4*)dst = pack8(ov); *(u32x4*)(dst + 8) = pack8(ov + 8);
  }
}

DI void pw2_tile(PREF p, int l, int idx, unsigned char* ldsb) {
  u16* lds = (u16*)ldsb; float* Cs = (float*)ldsb;
  const int tid = tidx();
  const int mt = idx >> 1, nt = idx & 1;
  const int row0 = mt * 128, col0 = nt * 128;
  f32x4 acc[4][4]; zero_acc(acc);
  gemm_main(acc, p.cA + (size_t)row0 * 256, 256, p.wts + (size_t)l * WL + O_PW2 + (size_t)col0 * 256, 256, 256, lds);
  stage_c(acc, Cs);
  u32x4 zr[8];
#pragma unroll
  for (int q = 0; q < 8; ++q) zr[q] = *(const u32x4*)(p.hb + (size_t)(row0 + (tid >> 4) + 16 * q) * HW + OFF_AZ + col0 + (tid & 15) * 8);
#pragma unroll
  for (int q = 0; q < 8; ++q) {
    int r = (tid >> 4) + 16 * q, c = (tid & 15) * 8;
    float v[8]; ld8(Cs + r * CST + c, v);
    float z[8]; unpack8(zr[q], z);
#pragma unroll
    for (int j = 0; j < 8; ++j) v[j] *= silu(z[j]);
    *(u32x4*)(p.ys + (size_t)(row0 + r) * 1024 + col0 + c) = pack8(v);
  }
}

DI void glu_tile(PREF p, int l, int idx, unsigned char* ldsb) {
  u16* lds = (u16*)ldsb; float* Cs = (float*)ldsb;
  const int tid = tidx();
  const int mt = idx >> 2, nt = idx & 3;
  const int row0 = mt * 128;
  f32x4 acc[4][4]; zero_acc(acc);
  gemm_main(acc, p.yss + (size_t)row0 * 256, 256, p.wts + (size_t)l * WL + O_GLU + (size_t)nt * 128 * 256, 256, 256, lds);
  stage_c(acc, Cs);
  u32x4 zr[4];
#pragma unroll
  for (int q = 0; q < 4; ++q) zr[q] = *(const u32x4*)(p.hb + (size_t)(row0 + (tid >> 3) + 32 * q) * HW + OFF_CZ + nt * 64 + (tid & 7) * 8);
#pragma unroll
  for (int q = 0; q < 4; ++q) {
    int r = (tid >> 3) + 32 * q, c = (tid & 7) * 8;
    float v[8], g[8]; ld8(Cs + r * CST + c, v); ld8(Cs + r * CST + 64 + c, g);
    float z[8]; unpack8(zr[q], z);
#pragma unroll
    for (int j = 0; j < 8; ++j) v[j] = v[j] * sigm(g[j]) * silu(z[j]);
    *(u32x4*)(p.ys + (size_t)(row0 + r) * 1024 + 512 + nt * 64 + c) = pack8(v);
  }
}

template <int AI, int BJ>
DI void glu_quadrant(PREF p, const f32x4 (&acc)[2][2][4][2], int mt, int nt, float* Cs) {
  const int t = tid512();
  const int row0 = mt * 256 + AI * 128, oc0 = (nt * 2 + BJ) * 64, c = (t & 7) * 8;
  u32x4 zr[2];
#pragma unroll
  for (int q = 0; q < 2; ++q) zr[q] = *(const u32x4*)(p.hb + (size_t)(row0 + (t >> 3) + 64 * q) * HW + OFF_CZ + oc0 + c);
  stage_q<AI, BJ>(acc, Cs);
#pragma unroll
  for (int q = 0; q < 2; ++q) {
    const int r = (t >> 3) + 64 * q;
    float v[8], g[8]; ld8(Cs + r * CST + c, v); ld8(Cs + r * CST + 64 + c, g);
    float z[8]; unpack8(zr[q], z);
#pragma unroll
    for (int j = 0; j < 8; ++j) v[j] = v[j] * sigm(g[j]) * silu(z[j]);
    *(u32x4*)(p.ys + (size_t)(row0 + r) * 1024 + 512 + oc0 + c) = pack8(v);
  }
}
DI void glu_phase(PREF p, int l, unsigned char* lds_all) {
  u16* shm = (u16*)lds_all; float* Cs = (float*)lds_all;
  for (int it = blockIdx.x; it < 256; it += gridDim.x) {
    const int mt = it >> 1, nt = it & 1;
    f32x4 acc[2][2][4][2]; zero_acc256(acc);
    gemm256<256, 256, 256>(acc, p.yss + (size_t)mt * 256 * 256, p.wts + (size_t)l * WL + O_GLU + (size_t)nt * 256 * 256, shm, p);
    glu_quadrant<0, 0>(p, acc, mt, nt, Cs); glu_quadrant<0, 1>(p, acc, mt, nt, Cs);
    glu_quadrant<1, 0>(p, acc, mt, nt, Cs); glu_quadrant<1, 1>(p, acc, mt, nt, Cs);
  }
  __syncthreads();
}

DI u32x4* merge_scratch(PREF p, int region) { const int t = tid512(); return (u32x4*)p.fbuf + (size_t)blockIdx.x * 40960 + region * 8192 + (t >> 6) * 1024 + (t & 63); }
DI void br_store(PREF p, const f32x4 (&acc)[2][2][4][2], int slot) {
  u32x4* sb = merge_scratch(p, slot);
#pragma unroll
  for (int ai = 0; ai < 2; ++ai)
#pragma unroll
    for (int bj = 0; bj < 2; ++bj)
#pragma unroll
      for (int m = 0; m < 4; ++m) {
        u32x4 o;
        o.x = pack2(acc[ai][bj][m][0][0], acc[ai][bj][m][0][1]); o.y = pack2(acc[ai][bj][m][0][2], acc[ai][bj][m][0][3]);
        o.z = pack2(acc[ai][bj][m][1][0], acc[ai][bj][m][1][1]); o.w = pack2(acc[ai][bj][m][1][2], acc[ai][bj][m][1][3]);
        sb[((ai * 2 + bj) * 4 + m) * 64] = o;
      }
}
DI void br_flush(PREF p, f32x4 (&acc)[2][2][4][2], int slot) { br_store(p, acc, slot); zero_acc256(acc); }
DI void gate_reg(PREF p, int l, int n, f32x4 (&acc)[2][2][4][2], int dt) {
  const u32x4* sbn = merge_scratch(p, n);
  u32x4* ssum = merge_scratch(p, 4);
  const int t = tid512(), wid = t >> 6, lane = t & 63, wc = wid & 3, fr = lane & 15;
  const float* bm = p.b_merge + (size_t)l * 4096 + n * 1024 + dt * 256 + wc * 32 + fr;
  float bias[2][2];
#pragma unroll
  for (int bj = 0; bj < 2; ++bj)
#pragma unroll
    for (int nn = 0; nn < 2; ++nn) bias[bj][nn] = bm[bj * 128 + nn * 16];
#pragma unroll
  for (int ai = 0; ai < 2; ++ai)
#pragma unroll
    for (int bj = 0; bj < 2; ++bj) {
      __builtin_amdgcn_sched_barrier(0);
      u32x4 bn[4], pv[4];
#pragma unroll
      for (int m = 0; m < 4; ++m) {
        bn[m] = sbn[((ai * 2 + bj) * 4 + m) * 64];
        if (n > 0) pv[m] = ssum[((ai * 2 + bj) * 4 + m) * 64];
      }
#pragma unroll
      for (int m = 0; m < 4; ++m) {
        float b[8]; unpack8(bn[m], b);
        float v[8];
#pragma unroll
        for (int nn = 0; nn < 2; ++nn)
#pragma unroll
          for (int j = 0; j < 4; ++j) v[nn * 4 + j] = sigm(acc[ai][bj][m][nn][j] + bias[bj][nn]) * b[nn * 4 + j];
        if (n > 0) {
          float o[8]; unpack8(pv[m], o);
#pragma unroll
          for (int e = 0; e < 8; ++e) v[e] += o[e];
        }
        if (n < 3) ssum[((ai * 2 + bj) * 4 + m) * 64] = pack8(v);
#pragma unroll
        for (int nn = 0; nn < 2; ++nn)
#pragma unroll
          for (int j = 0; j < 4; ++j) acc[ai][bj][m][nn][j] = v[nn * 4 + j];
      }
    }
}
template <int AI, int BJ>
DI void mg_quadrant(PREF p, const f32x4 (&acc)[2][2][4][2], int mt, int dt, float* Cs) {
  const int t = tid512();
  const int row0 = mt * 256 + AI * 128, col0 = dt * 256 + BJ * 128;
  stage_q<AI, BJ>(acc, Cs);
#pragma unroll
  for (int q = 0; q < 4; ++q) {
    int r = (t >> 4) + 32 * q, c = (t & 15) * 8;
    float v[8]; ld8(Cs + r * CST + c, v);
    *(u32x4*)(p.mg + (size_t)(row0 + r) * 1024 + col0 + c) = pack8(v);
  }
}
DI void merge_phase(PREF p, int l, unsigned char* lds_all) {
  u16* shm = (u16*)lds_all; float* Cs = (float*)lds_all;
  const u16* W = p.wts + (size_t)l * WL;
  for (int k = 0;; ++k) {
    int mt, dt;
    if (!xcd_tile256(k, 4, mt, dt)) break;
    {
      f32x4 acc[2][2][4][2]; zero_acc256(acc);
      gemm256<1024, 256, 1024, 1>(acc, p.ys + (size_t)mt * 256 * 1024, W + O_BR + (size_t)dt * 256 * 256, shm, p);
      br_store(p, acc, 3);
    }
#pragma unroll 1
    for (int n = 0; n < 4; ++n) {
      f32x4 acc[2][2][4][2]; zero_acc256(acc);
      gemm256<1024, 1024, 1024>(acc, p.X + (size_t)mt * 256 * 1024, W + O_WM + ((size_t)n * 1024 + dt * 256) * 1024, shm, p);
      gate_reg(p, l, n, acc, dt);
      if (n == 3) {
        mg_quadrant<0, 0>(p, acc, mt, dt, Cs); mg_quadrant<0, 1>(p, acc, mt, dt, Cs);
        mg_quadrant<1, 0>(p, acc, mt, dt, Cs); mg_quadrant<1, 1>(p, acc, mt, dt, Cs);
      }
    }
  }
  __syncthreads();
}

template <int AI, int BJ>
DI void f1_load(PREF p, int l, int mt, int dt, float4 (&xa)[4], float4 (&xb)[4]) {
  const int t = tid512();
  const int row0 = mt * 256 + AI * 128, col0 = dt * 256 + BJ * 128, c = (t & 15) * 8;
  if (l == 0) {
#pragma unroll
    for (int q = 0; q < 4; ++q) {
      const float4* xs = (const float4*)(p.x + (size_t)(row0 + (t >> 4) + 32 * q) * 1024 + col0 + c);
      xa[q] = xs[0]; xb[q] = xs[1];
    }
  } else {
#pragma unroll
    for (int q = 0; q < 4; ++q) {
      float f[8]; unpack8(*(const u32x4*)(p.X + (size_t)(row0 + (t >> 4) + 32 * q) * 1024 + col0 + c), f);
      xa[q] = make_float4(f[0], f[1], f[2], f[3]); xb[q] = make_float4(f[4], f[5], f[6], f[7]);
    }
  }
}
template <int AI, int BJ>
DI void f1_proc(PREF p, const f32x4 (&acc)[2][2][4][2], int mt, int dt, float* Cs, const float4 (&xa)[4], const float4 (&xb)[4]) {
  const int t = tid512();
  const int row0 = mt * 256 + AI * 128, col0 = dt * 256 + BJ * 128, c = (t & 15) * 8;
  const float alpha = 1.681792830507429f;
  stage_q<AI, BJ>(acc, Cs);
#pragma unroll
  for (int q = 0; q < 4; ++q) {
    int r = (t >> 4) + 32 * q;
    float v[8]; ld8(Cs + r * CST + c, v);
    float4 a = xa[q], b = xb[q];
    float y[8] = {alpha * a.x + v[0], alpha * a.y + v[1], alpha * a.z + v[2], alpha * a.w + v[3],
                  alpha * b.x + v[4], alpha * b.y + v[5], alpha * b.z + v[6], alpha * b.w + v[7]};
    *(u32x4*)((u16*)p.fbuf + (size_t)(row0 + r) * 1024 + col0 + c) = pack8(y);
  }
}
DI void f1_phase(PREF p, int l, unsigned char* lds_all) {
  u16* shm = (u16*)lds_all; float* Cs = (float*)lds_all;
  for (int k = 0;; ++k) {
    int mt, dt;
    if (!xcd_tile256(k, 4, mt, dt)) break;
    f32x4 acc[2][2][4][2]; zero_acc256(acc);
    gemm256<1024, 1024, 1024>(acc, p.mg + (size_t)mt * 256 * 1024, p.wts + (size_t)l * WL + O_OUT + (size_t)dt * 256 * 1024, shm, p);
    {
      float4 aA[4], bA[4];
      f1_load<0, 0>(p, l, mt, dt, aA, bA); f1_proc<0, 0>(p, acc, mt, dt, Cs, aA, bA);
      f1_load<0, 1>(p, l, mt, dt, aA, bA); f1_proc<0, 1>(p, acc, mt, dt, Cs, aA, bA);
      f1_load<1, 0>(p, l, mt, dt, aA, bA); f1_proc<1, 0>(p, acc, mt, dt, Cs, aA, bA);
      f1_load<1, 1>(p, l, mt, dt, aA, bA); f1_proc<1, 1>(p, acc, mt, dt, Cs, aA, bA);
    }
  }
  __syncthreads();
}

template <int AI, int BJ>
DI void f3_load(PREF p, int mt, int dt, u32x4 (&g)[4]) {
  const int t = tid512();
  const int row0 = mt * 256 + AI * 128, col0 = dt * 256 + BJ * 128, c = (t & 15) * 8;
#pragma unroll
  for (int q = 0; q < 4; ++q) g[q] = *(const u32x4*)((const u16*)p.fbuf + (size_t)(row0 + (t >> 4) + 32 * q) * 1024 + col0 + c);
}
template <int AI, int BJ, int PASS>
DI void f3_proc(PREF p, const f32x4 (&acc)[2][2][4][2], int mt, int dt, float* Cs, const u32x4 (&g)[4]) {
  const int t = tid512();
  const int row0 = mt * 256 + AI * 128, col0 = dt * 256 + BJ * 128;
  const int c = (t & 15) * 8;
  stage_q<AI, BJ>(acc, Cs);
#pragma unroll
  for (int q = 0; q < 4; ++q) {
    int r = (t >> 4) + 32 * q;
    float v[8]; ld8(Cs + r * CST + c, v);
    if (PASS == 0) {
#pragma unroll
      for (int j = 0; j < 8; ++j) v[j] = sigm(v[j]);
    } else {
      float gf[8]; unpack8(g[q], gf);
#pragma unroll
      for (int j = 0; j < 8; ++j) v[j] *= gf[j];
    }
    *(u32x4*)((u16*)p.fbuf + (size_t)(row0 + r) * 1024 + col0 + c) = pack8(v);
  }
}
DI void f3_phase(PREF p, int l, unsigned char* lds_all) {
  u16* shm = (u16*)lds_all; float* Cs = (float*)lds_all;
  const u16* W = p.wts + (size_t)l * WL;
  for (int k = 0;; ++k) {
    int mt, dt;
    if (!xcd_tile256(k, 4, mt, dt)) break;
    {
      f32x4 acc[2][2][4][2]; zero_acc256(acc);
      gemm256<1024, 1024, 1024>(acc, p.X + (size_t)mt * 256 * 1024, W + O_PLEG + (size_t)dt * 256 * 1024, shm, p);
      u32x4 gd[4];
      f3_proc<0, 0, 0>(p, acc, mt, dt, Cs, gd); f3_proc<0, 1, 0>(p, acc, mt, dt, Cs, gd);
      f3_proc<1, 0, 0>(p, acc, mt, dt, Cs, gd); f3_proc<1, 1, 0>(p, acc, mt, dt, Cs, gd);
    }
    f32x4 acc[2][2][4][2]; zero_acc256(acc);
    gemm256<256, 256, 256>(acc, p.pb + (size_t)mt * 256 * 256, W + O_PLE + (size_t)dt * 256 * 256, shm, p);
    {
      u32x4 gA[4], gB[4];
      f3_load<0, 0>(p, mt, dt, gA);
      f3_load<0, 1>(p, mt, dt, gB); f3_proc<0, 0, 1>(p, acc, mt, dt, Cs, gA);
      f3_load<1, 0>(p, mt, dt, gA); f3_proc<0, 1, 1>(p, acc, mt, dt, Cs, gB);
      f3_load<1, 1>(p, mt, dt, gB); f3_proc<1, 0, 1>(p, acc, mt, dt, Cs, gA);
      f3_proc<1, 1, 1>(p, acc, mt, dt, Cs, gB);
    }
  }
  __syncthreads();
}

DI void rows_ln(PREF p, int l) {
  const int tid = tidx(), lane = tid & 63, w = tid >> 6;
  float gg[16], bb[16];
#pragma unroll
  for (int h = 0; h < 2; ++h) {
    const int c = h * 512 + lane * 8;
    const float4 g0 = *(const float4*)(p.ln_g + l * 1024 + c), g1 = *(const float4*)(p.ln_g + l * 1024 + c + 4);
    const float4 b0 = *(const float4*)(p.ln_b + l * 1024 + c), b1 = *(const float4*)(p.ln_b + l * 1024 + c + 4);
    gg[h * 8 + 0] = g0.x; gg[h * 8 + 1] = g0.y; gg[h * 8 + 2] = g0.z; gg[h * 8 + 3] = g0.w;
    gg[h * 8 + 4] = g1.x; gg[h * 8 + 5] = g1.y; gg[h * 8 + 6] = g1.z; gg[h * 8 + 7] = g1.w;
    bb[h * 8 + 0] = b0.x; bb[h * 8 + 1] = b0.y; bb[h * 8 + 2] = b0.z; bb[h * 8 + 3] = b0.w;
    bb[h * 8 + 4] = b1.x; bb[h * 8 + 5] = b1.y; bb[h * 8 + 6] = b1.z; bb[h * 8 + 7] = b1.w;
  }
  for (int row = vbid() * 4 + w; row < T_ / 2; row += vgrid() * 4) {
    u32x4 raw[2][2];
#pragma unroll
    for (int k = 0; k < 2; ++k) {
      const u16* src = (const u16*)p.fbuf + (size_t)(row + k * (T_ / 2)) * 1024;
      raw[k][0] = *(const u32x4*)(src + lane * 8);
      raw[k][1] = *(const u32x4*)(src + 512 + lane * 8);
    }
#pragma unroll
    for (int k = 0; k < 2; ++k) {
      float v[16];
      unpack8(raw[k][0], v); unpack8(raw[k][1], v + 8);
      float s = 0.f;
#pragma unroll
      for (int i = 0; i < 16; ++i) s += v[i];
      const float mu = wsum(s) * (1.f / 1024.f);
      float sq = 0.f;
#pragma unroll
      for (int i = 0; i < 16; ++i) { v[i] -= mu; sq += v[i] * v[i]; }
      const float rs = rsqrtf(wsum(sq) * (1.f / 1024.f) + 1e-5f);
#pragma unroll
      for (int h = 0; h < 2; ++h) {
        float y[8];
#pragma unroll
        for (int j = 0; j < 8; ++j) y[j] = v[h * 8 + j] * rs * gg[h * 8 + j] + bb[h * 8 + j];
        *(u32x4*)(p.X + (size_t)(row + k * (T_ / 2)) * 1024 + h * 512 + lane * 8) = pack8(y);
      }
    }
  }
}

DI void rows_ple(PREF p, int l) {
  const int tid = tidx(), lane = tid & 63, w = tid >> 6;
  for (int row = vbid() * 4 + w; row < T_; row += vgrid() * 4) {
    const u16* src = (const u16*)p.fbuf + (size_t)row * 1024;
    float v[16];
    unpack8(*(const u32x4*)(src + lane * 8), v);
    unpack8(*(const u32x4*)(src + 512 + lane * 8), v + 8);
    float xv[16];
    unpack8(*(const u32x4*)(p.X + (size_t)row * 1024 + lane * 8), xv);
    unpack8(*(const u32x4*)(p.X + (size_t)row * 1024 + 512 + lane * 8), xv + 8);
    float sq = 0.f;
#pragma unroll
    for (int i = 0; i < 16; ++i) sq += v[i] * v[i];
    const float rs = rsqrtf(wsum(sq) * (1.f / 1024.f) + 1e-6f);
#pragma unroll
    for (int h = 0; h < 2; ++h) {
      const int c = h * 512 + lane * 8;
      const float4 g0 = *(const float4*)(p.ple_ng + l * 1024 + c), g1 = *(const float4*)(p.ple_ng + l * 1024 + c + 4);
      float y[8];
      y[0] = xv[h * 8 + 0] + v[h * 8 + 0] * rs * g0.x; y[1] = xv[h * 8 + 1] + v[h * 8 + 1] * rs * g0.y;
      y[2] = xv[h * 8 + 2] + v[h * 8 + 2] * rs * g0.z; y[3] = xv[h * 8 + 3] + v[h * 8 + 3] * rs * g0.w;
      y[4] = xv[h * 8 + 4] + v[h * 8 + 4] * rs * g1.x; y[5] = xv[h * 8 + 5] + v[h * 8 + 5] * rs * g1.y;
      y[6] = xv[h * 8 + 6] + v[h * 8 + 6] * rs * g1.z; y[7] = xv[h * 8 + 7] + v[h * 8 + 7] * rs * g1.w;
      if (l == NL - 1) {
        float4* od = (float4*)(p.out + (size_t)row * 1024 + c);
        od[0] = make_float4(y[0], y[1], y[2], y[3]); od[1] = make_float4(y[4], y[5], y[6], y[7]);
      } else {
        *(u32x4*)(p.X + (size_t)row * 1024 + c) = pack8(y);
      }
    }
  }
}

DI void phase_mix1(PREF p, int l, unsigned char* ldsb) {
  for (int it = vbid(); it < 1024; it += vgrid()) {
    int pi = it >> 1, b = pi >> 6, hq = ((pi >> 5) & 1) * 2 + (it & 1), qb = pi & 31;
    const u16* hbb = p.hb + (size_t)b * S_ * HW;
    attn_item<64, true>(hbb + OFF_SQ + hq * 64, HW, hbb + OFF_SK + (hq >> 1) * 64, HW,
                        p.Vst + (size_t)(b * 2 + (hq >> 1)) * 64 * S_, qb, 0.125f * LOG2E, p.sinks[l * 4 + hq] * 8.0f,
                        hbb + OFF_DZ + hq * 64, HW, p.ys + (size_t)b * S_ * 1024 + 768 + hq * 64, 1024, (u16*)ldsb);
  }
  for (int it = vbid(); it < 1024; it += vgrid()) kv_tile(p, l, it, ldsb);
  for (int it = vbid(); it < 768; it += vgrid()) q_tile(p, l, it, ldsb);
  for (int it = vbid(); it < 1024; it += vgrid()) conv_item(p, l, it, ldsb);
  for (int it = vbid(); it < 2048; it += vgrid()) ssm1_item(p, l, it, ldsb);
}
DI void phase_mix2(PREF p, int l, unsigned char* ldsb) {
  for (int it = vbid(); it < 1024; it += vgrid()) {
    int qb = (it < 512) ? 31 - (it >> 5) : ((it - 512) >> 5);
    int bh = it & 31, b = bh >> 2, head = bh & 3;
    attn_item<96, false>(p.Qm + (size_t)b * S_ * 384 + head * 96, 384, p.Km + (size_t)b * S_ * 384 + head * 96, 384,
                         p.Vmt + (size_t)(b * 4 + head) * 64 * S_, qb, 0.10206207261596577f * LOG2E, 0.f,
                         p.hb + (size_t)b * S_ * HW + OFF_BZ + head * 64, HW, p.ys + (size_t)b * S_ * 1024 + 256 + head * 64, 1024,
                         (u16*)ldsb);
  }
  for (int it = vbid(); it < 512; it += vgrid()) pw2_tile(p, l, it, ldsb);
  for (int it = vbid(); it < 2048; it += vgrid()) ssm2_item(p, l, it, ldsb);
}

DI void grid_barrier(unsigned* bar, unsigned gen) {
  asm volatile("s_waitcnt vmcnt(0)" ::: "memory");
  __syncthreads();
  if (threadIdx.x == 0) {
    __builtin_amdgcn_fence(__ATOMIC_RELEASE, "agent");
    const unsigned grp = blockIdx.x & 15u;
    const unsigned nblk = (gridDim.x + 15u - grp) >> 4;
    unsigned old = __hip_atomic_fetch_add(bar + 64 * (1 + grp), 1u, __ATOMIC_RELAXED, __HIP_MEMORY_SCOPE_AGENT);
    if (old + 1u == nblk * gen) {
      unsigned g = __hip_atomic_fetch_add(bar, 1u, __ATOMIC_RELAXED, __HIP_MEMORY_SCOPE_AGENT);
      if (g + 1u == 16u * gen) {
        for (int i = 0; i < 16; ++i) __hip_atomic_store(bar + 64 * (17 + i), gen, __ATOMIC_RELAXED, __HIP_MEMORY_SCOPE_AGENT);
      }
    }
    while (__hip_atomic_load(bar + 64 * (17 + grp), __ATOMIC_RELAXED, __HIP_MEMORY_SCOPE_AGENT) < gen) __builtin_amdgcn_s_sleep(4);
    __builtin_amdgcn_fence(__ATOMIC_ACQUIRE, "agent");
  }
  __syncthreads();
}

template <int J>
DI void run_phase(PREF p, int l, unsigned char* ldsb, unsigned char* lds_all) {
  if (J == 0) phase_in(p, l, lds_all);
  else if (J == 1) phase_mix1(p, l, ldsb);
  else if (J == 2) phase_mix2(p, l, ldsb);
  else if (J == 3) glu_phase(p, l, lds_all);
  else if (J == 4) merge_phase(p, l, lds_all);
  else if (J == 5) f1_phase(p, l, lds_all);
  else if (J == 6) rows_ln(p, l);
  else if (J == 7) f3_phase(p, l, lds_all);
  else if (J == 8) rows_ple(p, l);
  else phase_prep(p, ldsb);
}

#if MULTI_LAUNCH
template <int J>
__global__ void __launch_bounds__(256, 2) phk(Params p, int l) {
  __shared__ __attribute__((aligned(16))) unsigned char ldsb[LDS_BYTES];
  run_phase<J>(p, l, ldsb);
}
#else
__global__ void __launch_bounds__(512, 2) mega(Params p_unused, int ph0, int ph1) {
  __shared__ __attribute__((aligned(16))) unsigned char lds_all[LDS_BYTES];
  unsigned char* ldsb = lds_all + half_() * LDS_HALF;
  cg::grid_group grid = cg::this_grid();
  for (int ph = ph0; ph < ph1; ++ph) {
    const __attribute__((address_space(4))) Params* pp = (const __attribute__((address_space(4))) Params*)__builtin_amdgcn_kernarg_segment_ptr();
    asm volatile("" : "+s"(pp));
    PREF p = *pp;
    if (ph1 < 0) grid.sync();
    if (ph > ph0) grid_barrier(p.bar, (unsigned)(ph - ph0));
    if (ph == 0) { run_phase<9>(p, 0, ldsb, lds_all); continue; }
    int l = (ph - 1) / NPH_LAYER; const int j = (ph - 1) % NPH_LAYER;
    asm volatile("" : "+s"(l));
    if (j == 0) run_phase<0>(p, l, ldsb, lds_all);
    else if (j == 1) run_phase<1>(p, l, ldsb, lds_all);
    else if (j == 2) run_phase<2>(p, l, ldsb, lds_all);
    else if (j == 3) run_phase<3>(p, l, ldsb, lds_all);
    else if (j == 4) run_phase<4>(p, l, ldsb, lds_all);
    else if (j == 5) run_phase<5>(p, l, ldsb, lds_all);
    else if (j == 6) run_phase<6>(p, l, ldsb, lds_all);
    else if (j == 7) run_phase<7>(p, l, ldsb, lds_all);
    else run_phase<8>(p, l, ldsb, lds_all);
  }
}
#endif

extern "C" void kernel_launch(void* const* d_in, const int* in_sizes, int n_in, void* d_out, int out_size, void* d_ws,
                              size_t ws_size, hipStream_t stream) {
  static int grid_blocks = 0;
  if (!grid_blocks) {
    int dev = 0, cus = 0, per_cu = 2;
    (void)hipGetDevice(&dev);
    (void)hipDeviceGetAttribute(&cus, hipDeviceAttributeMultiprocessorCount, dev);
#if !MULTI_LAUNCH
    (void)hipOccupancyMaxActiveBlocksPerMultiprocessor(&per_cu, mega, 512, 0);
    per_cu = 1;
#endif
    if (cus < 1) cus = 256;
    grid_blocks = cus * per_cu;
  }
  Params p{};
  const float** f = (const float**)&p;
  for (int i = 0; i < 31; ++i) f[i] = (const float*)d_in[i];
  p.out = (float*)d_out;
  unsigned char* ws = (unsigned char*)d_ws;
  size_t off = 0;
  auto take = [&](size_t bytes) { unsigned char* r = ws + off; off += (bytes + 255) & ~(size_t)255; return r; };
  p.wts = (u16*)take(WL * NL * 2);
  p.lam = (float*)take((size_t)NL * 16 * 64 * 2 * 4);
  p.bbre = (float*)take((size_t)NL * 16 * 64 * 16 * 4);
  p.bbim = (float*)take((size_t)NL * 16 * 64 * 16 * 4);
  p.rcos = (float*)take((size_t)S_ * 16 * 4);
  p.rsin = (float*)take((size_t)S_ * 16 * 4);
  p.X = (u16*)take((size_t)T_ * 1024 * 2);
  p.pb = (u16*)take((size_t)T_ * 256 * 2);
  p.hb = (u16*)take((size_t)T_ * HW * 2);
  p.ys = (u16*)take((size_t)T_ * 1024 * 2);
  p.cA = (u16*)take((size_t)T_ * 256 * 2);
  p.Qm = (u16*)take((size_t)T_ * 384 * 2);
  p.Km = (u16*)take((size_t)T_ * 384 * 2);
  p.Vmt = (u16*)take((size_t)T_ * 256 * 2);
  p.Vst = (u16*)take((size_t)T_ * 128 * 2);
  p.yss = (u16*)take((size_t)T_ * 256 * 2);
  p.hend = (float*)take((size_t)8 * 16 * 64 * 64 * 2 * 4);
  p.bar = (unsigned*)take(16384);
  p.mg = p.cA;
  p.fbuf = (float*)p.hb;
  if (off > ws_size) fprintf(stderr, "workspace too small: need %zu have %zu\n", off, ws_size);
  const int NPH = 1 + NPH_LAYER * NL;
#if MULTI_LAUNCH
  (void)NPH;
  const dim3 g(grid_blocks), b(256);
  hipLaunchKernelGGL(phk<9>, g, b, 0, stream, p, 0);
  for (int l = 0; l < NL; ++l) {
    hipLaunchKernelGGL(phk<0>, g, b, 0, stream, p, l);
    hipLaunchKernelGGL(phk<1>, g, b, 0, stream, p, l);
    hipLaunchKernelGGL(phk<2>, g, b, 0, stream, p, l);
    hipLaunchKernelGGL(phk<3>, g, b, 0, stream, p, l);
    hipLaunchKernelGGL(phk<4>, g, b, 0, stream, p, l);
    hipLaunchKernelGGL(phk<5>, g, b, 0, stream, p, l);
    hipLaunchKernelGGL(phk<6>, g, b, 0, stream, p, l);
    hipLaunchKernelGGL(phk<7>, g, b, 0, stream, p, l);
    hipLaunchKernelGGL(phk<8>, g, b, 0, stream, p, l);
  }
#else
  int ph0 = 0, ph1 = NPH;
  (void)hipMemsetAsync(p.bar, 0, 16384, stream);
  void* args[] = {&p, &ph0, &ph1};
  hipError_t e = hipLaunchCooperativeKernel((void*)mega, dim3(grid_blocks), dim3(512), args, 0, stream);
  if (e != hipSuccess) fprintf(stderr, "cooperative launch failed: %s (grid %d)\n", hipGetErrorString(e), grid_blocks);
#endif
}
```

```cpp
#include <hip/hip_runtime.h>
#include <hip/hip_cooperative_groups.h>
#include <cstdio>
#include <type_traits>
namespace cg = cooperative_groups;

#ifndef MULTI_LAUNCH
#define MULTI_LAUNCH 0
#endif

typedef unsigned short u16;
typedef __attribute__((ext_vector_type(8))) short bf16x8;
typedef __attribute__((ext_vector_type(4))) float f32x4;
typedef __attribute__((ext_vector_type(16))) float f32x16;
typedef __attribute__((ext_vector_type(4))) unsigned u32x4;
typedef __attribute__((ext_vector_type(2))) unsigned u32x2;
typedef __attribute__((ext_vector_type(2))) float f32x2;
#define DI __device__ __forceinline__
DI int tidx() { int t = threadIdx.x & 255; asm volatile("" : "+v"(t)); return t; }
DI int half_() { return __builtin_amdgcn_readfirstlane((int)(threadIdx.x >> 8)); }
DI int vbid() { return (int)blockIdx.x * 2 + half_(); }
DI int vgrid() { return (int)gridDim.x * 2; }

constexpr int T_ = 32768, S_ = 4096, D_ = 1024, HW = 2720, NL = 4;
constexpr int OFF_AVAL = 0, OFF_AGATE = 256, OFF_AZ = 512, OFF_CQ = 768, OFF_CKV = 1024, OFF_KR = 1152, OFF_BZ = 1184,
              OFF_U = 1440, OFF_CZ = 1696, OFF_SQ = 1952, OFF_SK = 2208, OFF_SV = 2336, OFF_DZ = 2464;
constexpr size_t O_WIN = 0, O_WM = O_WIN + 2816 * 1024, O_PW2 = O_WM + 4096 * 1024, O_UQ = O_PW2 + 65536, O_UKV = O_UQ + 98304,
                 O_GLU = O_UKV + 65536, O_BR = O_GLU + 131072, O_OUT = O_BR + 1048576, O_PLE = O_OUT + 1048576,
                 O_PLEG = O_PLE + 262144, WL = O_PLEG + 1048576;
constexpr int LDT = 64;
constexpr int TILE_E = 128 * LDT;
constexpr int CST = 132;
constexpr int LDS_MAIN = 73728;
constexpr int LDS_HALF = LDS_MAIN + 1024;
constexpr int LDS_BYTES = 2 * LDS_HALF;
constexpr float LOG2E = 1.4426950408889634f;
constexpr int NPH_LAYER = 9;

struct Params {
  const float *x, *p, *w_in, *w_merge, *b_merge, *conv_w, *conv_b, *conv_ng, *conv_nb, *w_pw2, *qng, *kvng, *w_uq, *w_ukv,
      *a_re, *a_im, *log_dt, *b_re, *b_im, *c_re, *c_im, *ssm_d, *w_glu, *sinks, *w_branch, *w_out, *ln_g, *ln_b, *w_ple,
      *w_pleg, *ple_ng;
  float* out;
  u16* wts;
  float *lam, *bbre, *bbim, *rcos, *rsin;
  u16 *X, *pb, *hb, *ys, *cA, *Qm, *Km, *Vmt, *Vst, *yss, *mg;
  float *hend, *fbuf;
  unsigned* bar;
};

typedef const __attribute__((address_space(4))) Params& PREF;

DI unsigned pack2(float a, float b) { unsigned r; asm("v_cvt_pk_bf16_f32 %0, %1, %2\n\ts_nop 1" : "=v"(r) : "v"(a), "v"(b)); return r; }
DI u16 f2bf(float x) { return (u16)(pack2(x, x) & 0xffffu); }
DI float bf2f(u16 v) { return __uint_as_float(((unsigned)v) << 16); }
DI float lo2f(unsigned u) { return __uint_as_float(u << 16); }
DI float hi2f(unsigned u) { return __uint_as_float(u & 0xffff0000u); }
DI float sigm(float x) { return 1.f / (1.f + __expf(-x)); }
DI float silu(float x) { return x / (1.f + __expf(-x)); }
DI float gelu_t(float x) { float u = 0.7978845608028654f * (x + 0.044715f * x * x * x); return x / (1.f + __expf(-2.f * u)); }
DI void unpack8(u32x4 v, float* f) {
  f[0] = lo2f(v.x); f[1] = hi2f(v.x); f[2] = lo2f(v.y); f[3] = hi2f(v.y);
  f[4] = lo2f(v.z); f[5] = hi2f(v.z); f[6] = lo2f(v.w); f[7] = hi2f(v.w);
}
DI u32x4 pack8(const float* f) { u32x4 o; o.x = pack2(f[0], f[1]); o.y = pack2(f[2], f[3]); o.z = pack2(f[4], f[5]); o.w = pack2(f[6], f[7]); return o; }
DI float wsum(float v) {
#pragma unroll
  for (int o = 32; o >= 1; o >>= 1) v += __shfl_xor(v, o);
  return v;
}
#define MFMA32(a, b, c) __builtin_amdgcn_mfma_f32_32x32x16_bf16((a), (b), (c), 0, 0, 0)
#define MFMA16(a, b, c) __builtin_amdgcn_mfma_f32_16x16x32_bf16((a), (b), (c), 0, 0, 0)

DI void zero_acc(f32x4 (&a)[4][4]) {
#pragma unroll
  for (int i = 0; i < 4; ++i)
#pragma unroll
    for (int j = 0; j < 4; ++j)
#pragma unroll
      for (int k = 0; k < 4; ++k) a[i][j][k] = 0.f;
}

#define GM_LOAD(RA, RB, KT)                                                                 \
  _Pragma("unroll") for (int i = 0; i < 4; ++i) {                                           \
    RA[i] = *(const u32x4*)(ag + (size_t)(32 * i) * lda + (KT) * 64);                       \
    RB[i] = *(const u32x4*)(bg + (size_t)(32 * i) * ldb + (KT) * 64);                       \
  }
#define GM_STORE(RA, RB, STG)                                                               \
  {                                                                                         \
    u16* dA_ = lds + (STG) * 2 * TILE_E;                                                    \
    _Pragma("unroll") for (int i = 0; i < 4; ++i) {                                         \
      *(u32x4*)(dA_ + (lrow + 32 * i) * LDT + lsw) = RA[i];                                 \
      *(u32x4*)(dA_ + TILE_E + (lrow + 32 * i) * LDT + lsw) = RB[i];                        \
    }                                                                                       \
  }
#define GM_COMPUTE(STG)                                                                     \
  {                                                                                         \
    const u16* sA = lds + (STG) * 2 * TILE_E + (wm * 64 + fr) * LDT;                        \
    const u16* sB = lds + (STG) * 2 * TILE_E + TILE_E + (wn * 64 + fr) * LDT;               \
    __builtin_amdgcn_s_setprio(1);                                                          \
    _Pragma("unroll") for (int kk = 0; kk < 2; ++kk) {                                      \
      const int co = (((kk * 4 + fq) ^ (fr & 7)) * 8);                                      \
      bf16x8 af[4];                                                                         \
      _Pragma("unroll") for (int m = 0; m < 4; ++m) af[m] = *(const bf16x8*)(sA + m * 16 * LDT + co);   \
      _Pragma("unroll") for (int n = 0; n < 4; ++n) {                                       \
        const bf16x8 bfr = *(const bf16x8*)(sB + n * 16 * LDT + co);                        \
        _Pragma("unroll") for (int m = 0; m < 4; ++m) acc[m][n] = MFMA16(af[m], bfr, acc[m][n]);        \
      }                                                                                     \
    }                                                                                       \
    __builtin_amdgcn_s_setprio(0);                                                          \
  }
template <bool DEEP = true>
DI void gemm_main(f32x4 (&acc)[4][4], const u16* __restrict__ A, int lda, const u16* __restrict__ B, int ldb, int K, u16* lds) {
  const int tid = tidx(), lane = tid & 63, w = tid >> 6;
  const int wm = w >> 1, wn = w & 1, fr = lane & 15, fq = lane >> 4;
  const int lrow = tid >> 3, lch = (tid & 7) * 8, lsw = ((tid & 7) ^ (lrow & 7)) * 8;
  const u16* ag = A + (size_t)lrow * lda + lch;
  const u16* bg = B + (size_t)lrow * ldb + lch;
  const int nk = K >> 6;
  if (DEEP) {
    u32x4 ra0[4], rb0[4], ra1[4], rb1[4];
    GM_LOAD(ra0, rb0, 0)
    GM_LOAD(ra1, rb1, 1)
    __syncthreads();
    GM_STORE(ra0, rb0, 0)
    __syncthreads();
    for (int kt = 0; kt < nk; kt += 2) {
      if (kt + 2 < nk) { GM_LOAD(ra0, rb0, kt + 2) }
      GM_COMPUTE(0)
      __builtin_amdgcn_sched_barrier(0);
      GM_STORE(ra1, rb1, 1)
      __syncthreads();
      if (kt + 3 < nk) { GM_LOAD(ra1, rb1, kt + 3) }
      GM_COMPUTE(1)
      __builtin_amdgcn_sched_barrier(0);
      if (kt + 2 < nk) { GM_STORE(ra0, rb0, 0) }
      __syncthreads();
    }
  } else {
    u32x4 ra0[4], rb0[4];
    GM_LOAD(ra0, rb0, 0)
    __syncthreads();
    GM_STORE(ra0, rb0, 0)
    __syncthreads();
    for (int kt = 0; kt < nk; kt += 2) {
      GM_LOAD(ra0, rb0, kt + 1)
      GM_COMPUTE(0)
      __builtin_amdgcn_sched_barrier(0);
      GM_STORE(ra0, rb0, 1)
      __syncthreads();
      if (kt + 2 < nk) { GM_LOAD(ra0, rb0, kt + 2) }
      GM_COMPUTE(1)
      __builtin_amdgcn_sched_barrier(0);
      if (kt + 2 < nk) { GM_STORE(ra0, rb0, 0) }
      __syncthreads();
    }
  }
}

DI void stage_c(const f32x4 (&acc)[4][4], float* Cs) {
  const int tid = tidx(), lane = tid & 63, w = tid >> 6;
  const int wm = w >> 1, wn = w & 1, fr = lane & 15, fq = lane >> 4;
#pragma unroll
  for (int m = 0; m < 4; ++m)
#pragma unroll
    for (int n = 0; n < 4; ++n)
#pragma unroll
      for (int j = 0; j < 4; ++j) Cs[(wm * 64 + m * 16 + fq * 4 + j) * CST + wn * 64 + n * 16 + fr] = acc[m][n][j];
  __syncthreads();
}
DI void ld8(const float* Cs, float* v) {
  float4 a = *(const float4*)Cs, b = *(const float4*)(Cs + 4);
  v[0] = a.x; v[1] = a.y; v[2] = a.z; v[3] = a.w; v[4] = b.x; v[5] = b.y; v[6] = b.z; v[7] = b.w;
}

DI void prep_w(const float* __restrict__ src, int K, int N, u16* __restrict__ dst, int Npad, const float* __restrict__ g, int perm,
               u16* T) {
  const int tid = tidx();
  const int ntn = Npad >> 6, ntiles = (K >> 6) * ntn;
  for (int it = vbid(); it < ntiles; it += vgrid()) {
    const int kt = it / ntn, k0 = kt * 64, n0 = (it - kt * ntn) * 64;
    int sn0 = n0;
    if (perm) { int tl = n0 >> 7, rr = n0 & 127; sn0 = (rr < 64) ? (tl * 64 + rr) : (256 + tl * 64 + rr - 64); }
    __syncthreads();
    {
      const int nn = tid & 63, kq = tid >> 6;
      const bool valid = (n0 + nn) < N;
      float v[16];
#pragma unroll
      for (int i = 0; i < 16; ++i) v[i] = valid ? src[(size_t)(k0 + kq + 4 * i) * N + sn0 + nn] : 0.f;
      if (g) {
#pragma unroll
        for (int i = 0; i < 16; ++i) v[i] *= g[k0 + kq + 4 * i];
      }
#pragma unroll
      for (int i = 0; i < 16; ++i) T[(kq + 4 * i) * 72 + nn] = f2bf(v[i]);
    }
    __syncthreads();
    {
      const int nn = tid >> 2, kc = (tid & 3) * 16;
      unsigned w[8];
#pragma unroll
      for (int j = 0; j < 8; ++j) w[j] = (unsigned)T[(kc + 2 * j) * 72 + nn] | ((unsigned)T[(kc + 2 * j + 1) * 72 + nn] << 16);
      u32x4 o0 = {w[0], w[1], w[2], w[3]}, o1 = {w[4], w[5], w[6], w[7]};
      u16* d = dst + (size_t)(n0 + nn) * K + k0 + kc;
      *(u32x4*)d = o0; *(u32x4*)(d + 8) = o1;
    }
  }
}

DI void phase_prep(PREF p, unsigned char* ldsb) {
  u16* T = (u16*)ldsb;
  const int gtid = vbid() * 256 + tidx(), gsz = vgrid() * 256;
  for (int l = 0; l < NL; ++l) {
    u16* W = p.wts + (size_t)l * WL;
    prep_w(p.w_in + (size_t)l * 1024 * HW, 1024, HW, W + O_WIN, 2816, nullptr, 0, T);
    prep_w(p.w_merge + (size_t)l * 1024 * 4096, 1024, 4096, W + O_WM, 4096, nullptr, 0, T);
    prep_w(p.w_pw2 + (size_t)l * 65536, 256, 256, W + O_PW2, 256, nullptr, 0, T);
    prep_w(p.w_uq + (size_t)l * 256 * 384, 256, 384, W + O_UQ, 384, p.qng + l * 256, 0, T);
    prep_w(p.w_ukv + (size_t)l * 128 * 512, 128, 512, W + O_UKV, 512, p.kvng + l * 128, 0, T);
    prep_w(p.w_glu + (size_t)l * 256 * 512, 256, 512, W + O_GLU, 512, nullptr, 1, T);
    for (int nb = 0; nb < 4; ++nb)
      prep_w(p.w_branch + ((size_t)l * 4 + nb) * 256 * 1024, 256, 1024, W + O_BR + (size_t)nb * 1024 * 256, 1024, nullptr, 0, T);
    prep_w(p.w_out + (size_t)l * 1048576, 1024, 1024, W + O_OUT, 1024, nullptr, 0, T);
    prep_w(p.w_ple + (size_t)l * 262144, 256, 1024, W + O_PLE, 1024, nullptr, 0, T);
    prep_w(p.w_pleg + (size_t)l * 1048576, 1024, 1024, W + O_PLEG, 1024, nullptr, 0, T);
  }
  for (int idx = gtid; idx < NL * 16 * 64; idx += gsz) {
    int lg = idx >> 6;
    float dt = expf(p.log_dt[lg]);
    float lr = p.a_re[idx], li = p.a_im[idx];
    float mag = expf(lr * dt);
    float lbr = mag * cosf(li * dt), lbi = mag * sinf(li * dt);
    float den = lr * lr + li * li;
    float nr = lbr - 1.f, ni = lbi;
    float fre = (nr * lr + ni * li) / den, fim = (ni * lr - nr * li) / den;
    p.lam[idx * 2] = lbr; p.lam[idx * 2 + 1] = lbi;
    for (int h = 0; h < 16; ++h) {
      float br = p.b_re[(size_t)idx * 16 + h], bi = p.b_im[(size_t)idx * 16 + h];
      p.bbre[(size_t)idx * 16 + h] = fre * br - fim * bi;
      p.bbim[(size_t)idx * 16 + h] = fre * bi + fim * br;
    }
  }
  for (int idx = gtid; idx < S_ * 16; idx += gsz) {
    int pos = idx >> 4, i = idx & 15;
    float inv = powf(10000.f, -(float)(2 * i) / 32.f);
    float ang = (float)pos * inv;
    p.rcos[idx] = cosf(ang); p.rsin[idx] = sinf(ang);
  }
  for (int idx = gtid; idx < T_ * D_ / 8; idx += gsz) {
    const float4* s = (const float4*)(p.x + (size_t)idx * 8);
    float4 a = s[0], b = s[1];
    float v[8] = {a.x, a.y, a.z, a.w, b.x, b.y, b.z, b.w};
    *(u32x4*)(p.X + (size_t)idx * 8) = pack8(v);
  }
}

constexpr int G_HT = 128 * 64;
DI void lds_barrier() { asm volatile("s_waitcnt lgkmcnt(0)\n\ts_barrier" ::: "memory"); }
DI int tid512() { int t = threadIdx.x; asm volatile("" : "+v"(t)); return t; }
DI void g_stage_rc(int b, int& R, int& C) {
  int st = b >> 10, sb = b & 1023, swz = sb ^ (((sb >> 9) & 1) << 5);
  R = (st >> 1) * 16 + (swz >> 6); C = (st & 1) * 32 + ((swz & 63) >> 1);
}
#define G_SA(b, h) (shm + ((b) * 2 + (h)) * G_HT)
#define G_SB(b, h) (shm + (4 + (b) * 2 + (h)) * G_HT)
#define G_STAGE(P, BASE, O0, O1, LD, br, KOFF)                                                                             \
  do {                                                                                                                    \
    const u16* g_ = (BASE) + (size_t)(br) * (LD) + (KOFF);                                                              \
    __builtin_amdgcn_global_load_lds((const unsigned*)(g_ + (O0)), (unsigned*)((char*)(P) + t * 16), 16, 0, 0);          \
    __builtin_amdgcn_global_load_lds((const unsigned*)(g_ + (O1)), (unsigned*)((char*)(P) + t * 16 + 8192), 16, 0, 0);   \
  } while (0)
#define G_LDA(dst, b, h)                                                                                                  \
  _Pragma("unroll") for (int m = 0; m < 4; ++m) _Pragma("unroll") for (int k = 0; k < 2; ++k)                             \
      dst[m][k] = *(const bf16x8*)((const char*)G_SA(b, h) + ((wr * 4 + m) * 2 + k) * 1024 + rdo)
#define G_LDB(dst, b, h)                                                                                                  \
  _Pragma("unroll") for (int n = 0; n < 2; ++n) _Pragma("unroll") for (int k = 0; k < 2; ++k)                             \
      dst[n][k] = *(const bf16x8*)((const char*)G_SB(b, h) + ((wc * 2 + n) * 2 + k) * 1024 + rdo)
#define G_MMA(ai, bj, At, Bt)                                                                                             \
  do {                                                                                                                    \
    __builtin_amdgcn_s_setprio(1);                                                                                        \
    _Pragma("unroll") for (int m = 0; m < 4; ++m) _Pragma("unroll") for (int n = 0; n < 2; ++n)                           \
        _Pragma("unroll") for (int k = 0; k < 2; ++k) acc[ai][bj][m][n] = MFMA16(At[m][k], Bt[n][k], acc[ai][bj][m][n]);  \
    __builtin_amdgcn_s_setprio(0);                                                                                        \
  } while (0)
#define G_WAIT_V(n) asm volatile("s_waitcnt vmcnt(" #n ")" ::: "memory")
#define G_WAIT_L(n) asm volatile("s_waitcnt lgkmcnt(" #n ")" ::: "memory")
#define G_BAR __builtin_amdgcn_s_barrier()
#define G_SCHED __builtin_amdgcn_sched_barrier(0)

DI void br_flush(PREF p, f32x4 (&acc)[2][2][4][2], int slot);
template <int LDA, int LDB, int K, int MODE = 0>
DI void gemm256(f32x4 (&acc)[2][2][4][2], const u16* __restrict__ A, const u16* __restrict__ B, u16* shm, PREF p) {
#define KA(kt) ((kt) * 64)
#define KB(kt) (MODE ? (((kt) >> 2) * (1024 * LDB) + ((kt) & 3) * 64) : (kt) * 64)
  const int t = tid512();
  const int wid = t >> 6, lane = t & 63, wr = wid >> 2, wc = wid & 3, fr = lane & 15, fq = lane >> 4;
  int r0, c0, r1, c1;
  g_stage_rc(t * 16, r0, c0); g_stage_rc(t * 16 + 8192, r1, c1);
  const int oa0 = r0 * LDA + c0, oa1 = r1 * LDA + c1, ob0 = r0 * LDB + c0, ob1 = r1 * LDB + c1;
  const int obr = fr * 64 + fq * 16, rdo = obr ^ (((obr >> 9) & 1) << 5);
  bf16x8 At[4][2], B0[2][2], B1[2][2];
  constexpr int nt = K / 64;
  lds_barrier();
  G_STAGE(G_SB(0, 0), B, ob0, ob1, LDB, 0, KB(0)); G_STAGE(G_SA(0, 0), A, oa0, oa1, LDA, 0, KA(0));
  G_STAGE(G_SB(0, 1), B, ob0, ob1, LDB, 128, KB(0)); G_STAGE(G_SA(0, 1), A, oa0, oa1, LDA, 128, KA(0));
  if (wr == 1) G_BAR;
  G_WAIT_V(4); G_BAR;
  G_STAGE(G_SB(1, 0), B, ob0, ob1, LDB, 0, KB(1)); G_STAGE(G_SA(1, 0), A, oa0, oa1, LDA, 0, KA(1)); G_STAGE(G_SB(1, 1), B, ob0, ob1, LDB, 128, KB(1));
  G_WAIT_V(6); G_BAR;
  for (int tt = 0; tt < nt - 2; tt += 2) {
    G_LDB(B0, 0, 0); G_SCHED; G_LDA(At, 0, 0); G_STAGE(G_SA(1, 1), A, oa0, oa1, LDA, 128, KA(tt + 1));
    G_WAIT_L(8); G_BAR; G_WAIT_L(0); G_MMA(0, 0, At, B0); G_BAR; G_SCHED;
    G_LDB(B1, 0, 1); G_STAGE(G_SB(0, 0), B, ob0, ob1, LDB, 0, KB(tt + 2));
    G_BAR; G_WAIT_L(0); G_MMA(0, 1, At, B1); G_BAR;
    G_LDA(At, 0, 1); G_STAGE(G_SA(0, 0), A, oa0, oa1, LDA, 0, KA(tt + 2));
    G_BAR; G_WAIT_L(0); G_MMA(1, 0, At, B0); G_BAR; G_SCHED;
    G_STAGE(G_SB(0, 1), B, ob0, ob1, LDB, 128, KB(tt + 2));
    G_WAIT_V(6); G_BAR; G_MMA(1, 1, At, B1); G_BAR;
    G_LDB(B0, 1, 0); G_SCHED; G_LDA(At, 1, 0); G_STAGE(G_SA(0, 1), A, oa0, oa1, LDA, 128, KA(tt + 2));
    G_WAIT_L(8); G_BAR; G_WAIT_L(0); G_MMA(0, 0, At, B0); G_BAR; G_SCHED;
    G_LDB(B1, 1, 1); G_STAGE(G_SB(1, 0), B, ob0, ob1, LDB, 0, KB(tt + 3));
    G_BAR; G_WAIT_L(0); G_MMA(0, 1, At, B1); G_BAR;
    G_LDA(At, 1, 1); G_STAGE(G_SA(1, 0), A, oa0, oa1, LDA, 0, KA(tt + 3));
    G_BAR; G_WAIT_L(0); G_MMA(1, 0, At, B0); G_BAR; G_SCHED;
    G_STAGE(G_SB(1, 1), B, ob0, ob1, LDB, 128, KB(tt + 3));
    G_WAIT_V(6); G_BAR; G_MMA(1, 1, At, B1); G_BAR;
    if (MODE && ((tt + 1) & 3) == 3) br_flush(p, acc, (tt + 1) >> 2);
  }
  {
    G_LDB(B0, 0, 0); G_LDA(At, 0, 0); G_STAGE(G_SA(1, 1), A, oa0, oa1, LDA, 128, KA(nt - 1));
    G_BAR; G_WAIT_L(0); G_MMA(0, 0, At, B0); G_BAR;
    G_LDB(B1, 0, 1); G_BAR; G_WAIT_L(0); G_MMA(0, 1, At, B1); G_BAR;
    G_LDA(At, 0, 1); G_WAIT_V(4); G_BAR; G_WAIT_L(0); G_MMA(1, 0, At, B0); G_MMA(1, 1, At, B1); G_BAR;
  }
  {
    G_LDB(B0, 1, 0); G_LDA(At, 1, 0); G_WAIT_V(2); G_BAR; G_WAIT_L(0); G_MMA(0, 0, At, B0); G_BAR;
    G_LDB(B1, 1, 1); G_WAIT_V(0); G_BAR; G_WAIT_L(0); G_MMA(0, 1, At, B1); G_BAR;
    G_LDA(At, 1, 1); G_BAR; G_WAIT_L(0); G_MMA(1, 0, At, B0); G_MMA(1, 1, At, B1); G_BAR;
  }
  if (wr == 0) G_BAR;
#undef KA
#undef KB
}
DI void zero_acc256(f32x4 (&a)[2][2][4][2]) {
#pragma unroll
  for (int i = 0; i < 2; ++i)
#pragma unroll
    for (int j = 0; j < 2; ++j)
#pragma unroll
      for (int m = 0; m < 4; ++m)
#pragma unroll
        for (int n = 0; n < 2; ++n)
#pragma unroll
          for (int e = 0; e < 4; ++e) a[i][j][m][n][e] = 0.f;
}
template <int AI, int BJ>
DI void stage_q(const f32x4 (&acc)[2][2][4][2], float* Cs) {
  const int t = tid512(), wid = t >> 6, lane = t & 63, wr = wid >> 2, wc = wid & 3, fr = lane & 15, fq = lane >> 4;
  lds_barrier();
#pragma unroll
  for (int m = 0; m < 4; ++m)
#pragma unroll
    for (int n = 0; n < 2; ++n)
#pragma unroll
      for (int j = 0; j < 4; ++j) Cs[(wr * 64 + m * 16 + fq * 4 + j) * CST + wc * 32 + n * 16 + fr] = acc[AI][BJ][m][n][j];
  lds_barrier();
}
DI bool xcd_tile256(int k, int NT, int& m, int& n) {
  const int x = blockIdx.x & 7, slots = gridDim.x >> 3;
  const int idx = (int)(blockIdx.x >> 3) + slots * k;
  if (idx >= 16 * NT) return false;
  const int mg = idx / (8 * NT), rem = idx - mg * 8 * NT;
  n = rem >> 3; m = x * 16 + mg * 8 + (rem & 7);
  return true;
}

DI bool xcd_tile(int k, int NT, int& m, int& n) {
  const int x = (vbid() >> 1) & 7, slots = vgrid() >> 3;
  const int idx = (((vbid() >> 4) << 1) | (vbid() & 1)) + slots * k;
  if (idx >= 32 * NT) return false;
  const int mg = idx / (8 * NT), rem = idx - mg * 8 * NT;
  n = rem >> 3; m = x * 32 + mg * 8 + (rem & 7);
  return true;
}

template <int AI, int BJ>
DI void in_quadrant(PREF p, const f32x4 (&acc)[2][2][4][2], int mt, int nt, float* Cs) {
  const int t = tid512();
  const int row0 = mt * 256 + AI * 128, col0 = nt * 256 + BJ * 128;
  if (col0 >= HW) return;
  stage_q<AI, BJ>(acc, Cs);
#pragma unroll
  for (int q = 0; q < 4; ++q) {
    int r = (t >> 4) + 32 * q, c = (t & 15) * 8;
    if (col0 + c < HW) {
      float v[8]; ld8(Cs + r * CST + c, v);
      *(u32x4*)(p.hb + (size_t)(row0 + r) * HW + col0 + c) = pack8(v);
    }
  }
  if (col0 + 128 > OFF_SV && col0 < OFF_SV + 128) {
    int b = row0 >> 12, s0 = row0 & 4095;
#pragma unroll
    for (int q = 0; q < 4; ++q) {
      int item = t + 512 * q; int c = item & 127, rg = item >> 7;
      int vc = col0 + c - OFF_SV;
      if (vc >= 0 && vc < 128) {
        float v[8];
#pragma unroll
        for (int j = 0; j < 8; ++j) v[j] = Cs[(rg * 8 + j) * CST + c];
        *(u32x4*)(p.Vst + ((size_t)(b * 2 + (vc >> 6)) * 64 + (vc & 63)) * S_ + s0 + rg * 8) = pack8(v);
      }
    }
  }
}
DI void phase_in(PREF p, int l, unsigned char* lds_all) {
  u16* shm = (u16*)lds_all; float* Cs = (float*)lds_all;
  const int tid = tidx();
  const u16* W = p.wts + (size_t)l * WL + O_WIN;
  for (int k = 0;; ++k) {
    int mt, nt;
    if (!xcd_tile256(k, 11, mt, nt)) break;
    f32x4 acc[2][2][4][2]; zero_acc256(acc);
    gemm256<1024, 1024, 1024>(acc, p.X + (size_t)mt * 256 * 1024, W + (size_t)nt * 256 * 1024, shm, p);
    in_quadrant<0, 0>(p, acc, mt, nt, Cs); in_quadrant<0, 1>(p, acc, mt, nt, Cs);
    in_quadrant<1, 0>(p, acc, mt, nt, Cs); in_quadrant<1, 1>(p, acc, mt, nt, Cs);
  }
  __syncthreads();
  const int gtid = vbid() * 256 + tid, gsz = vgrid() * 256;
  const float* ps = p.p + (size_t)l * T_ * 256;
  for (int idx = gtid; idx < T_ * 256 / 8; idx += gsz) {
    const float4* s = (const float4*)(ps + (size_t)idx * 8);
    float4 a = s[0], b = s[1];
    float v[8] = {a.x, a.y, a.z, a.w, b.x, b.y, b.z, b.w};
    *(u32x4*)(p.pb + (size_t)idx * 8) = pack8(v);
  }
}

template <int DQK, bool WIN>
DI void attn_item(const u16* __restrict__ Qb, int ldq, const u16* __restrict__ Kb, int ldk, const u16* __restrict__ Vtb, int qb,
                  float qscale, float sink2, const u16* __restrict__ zb, int ldz, u16* __restrict__ ob, int ldo, u16* lds) {
  constexpr int KST = DQK + 8, NKS = DQK / 16, KCH = DQK / 8;
  constexpr int KBUF = 64 * KST, VBUF = 64 * 72, STG = KBUF + VBUF;
  constexpr int NKL = (64 * KCH) / 256;
  const int tid = tidx(), lane = tid & 63, w = tid >> 6, r = lane & 31, hh = lane >> 5;
  const int q0 = qb * 128 + w * 32;
  const int qrow = q0 + r;
  bf16x8 qf[NKS];
#pragma unroll
  for (int s = 0; s < NKS; ++s) qf[s] = *(const bf16x8*)(Qb + (size_t)qrow * ldq + 16 * s + 8 * hh);
  const int kt_lo = WIN ? (qb > 0 ? 2 * qb - 2 : 0) : 0;
  const int kt_hi = 2 * qb + 1;
  f32x16 o[2];
#pragma unroll
  for (int i = 0; i < 16; ++i) { o[0][i] = 0.f; o[1][i] = 0.f; }
  float m = WIN ? sink2 : -1e30f;
  float lsum = (WIN && hh == 0) ? 1.f : 0.f;
  u32x4 rkA[NKL], rvA[2], rkB[NKL], rvB[2];
  auto gload = [&](u32x4 (&rk)[NKL], u32x4 (&rv)[2], int kt) {
#pragma unroll
    for (int i = 0; i < NKL; ++i) {
      int id = tid + 256 * i; int row = id / KCH, ch = id % KCH;
      rk[i] = *(const u32x4*)(Kb + (size_t)(kt * 64 + row) * ldk + ch * 8);
    }
#pragma unroll
    for (int i = 0; i < 2; ++i) {
      int id = tid + 256 * i; int row = id >> 3, ch = id & 7;
      rv[i] = *(const u32x4*)(Vtb + (size_t)row * S_ + kt * 64 + ch * 8);
    }
  };
  auto swrite = [&](const u32x4 (&rk)[NKL], const u32x4 (&rv)[2], int buf) {
    u16* ks = lds + buf * STG; u16* vs = ks + KBUF;
#pragma unroll
    for (int i = 0; i < NKL; ++i) {
      int id = tid + 256 * i; int row = id / KCH, ch = id % KCH;
      *(u32x4*)(ks + row * KST + ch * 8) = rk[i];
    }
#pragma unroll
    for (int i = 0; i < 2; ++i) {
      int id = tid + 256 * i; int row = id >> 3, ch = id & 7;
      u16* d = vs + row * 72 + (ch >> 1) * 16 + (ch & 1) * 4;
      u32x2 lo = {rv[i].x, rv[i].y}, hi = {rv[i].z, rv[i].w};
      *(u32x2*)d = lo; *(u32x2*)(d + 8) = hi;
    }
  };
  auto tile_body = [&](int kt, int buf, auto mask_tag) {
    constexpr bool MASK = decltype(mask_tag)::value;
    const u16* ks = lds + buf * STG; const u16* vs = ks + KBUF;
    const int k0 = kt * 64;
    bool active = (k0 <= q0 + 31);
    if (WIN) active = active && (k0 + 63 >= q0 - 127);
    if (active) {
      f32x16 st[2];
#pragma unroll
      for (int kb = 0; kb < 2; ++kb) {
#pragma unroll
        for (int i = 0; i < 16; ++i) st[kb][i] = 0.f;
#pragma unroll
        for (int s = 0; s < NKS; ++s) {
          bf16x8 a = *(const bf16x8*)(ks + (kb * 32 + r) * KST + 16 * s + 8 * hh);
          st[kb] = MFMA32(a, qf[s], st[kb]);
        }
      }
      float mx = -INFINITY;
#pragma unroll
      for (int kb = 0; kb < 2; ++kb)
#pragma unroll
        for (int i = 0; i < 16; ++i) {
          float v = st[kb][i];
          if (MASK) {
            int kg = k0 + kb * 32 + (i & 3) + 8 * (i >> 2) + 4 * hh;
            bool ok = kg <= qrow;
            if (WIN) ok = ok && (qrow - kg < 128);
            v = ok ? v : -INFINITY;
            st[kb][i] = v;
          }
          mx = fmaxf(mx, v);
        }
      mx = fmaxf(mx, __shfl_xor(mx, 32));
      const float mn = fmaxf(m, mx);
      if (__any(mn != m)) {
        const float alpha = __builtin_amdgcn_exp2f((m - mn) * qscale);
        lsum *= alpha;
#pragma unroll
        for (int i = 0; i < 16; ++i) { o[0][i] *= alpha; o[1][i] *= alpha; }
      }
      m = mn;
      const float nb = -mn * qscale;
      float ps = 0.f;
#pragma unroll
      for (int kb = 0; kb < 2; ++kb)
#pragma unroll
        for (int i = 0; i < 16; ++i) { float pv = __builtin_amdgcn_exp2f(fmaf(st[kb][i], qscale, nb)); st[kb][i] = pv; ps += pv; }
      lsum += ps;
#pragma unroll
      for (int kb = 0; kb < 2; ++kb)
#pragma unroll
        for (int s2 = 0; s2 < 2; ++s2) {
          union { bf16x8 v; unsigned u[4]; } pf;
#pragma unroll
          for (int j = 0; j < 4; ++j) pf.u[j] = pack2(st[kb][8 * s2 + 2 * j], st[kb][8 * s2 + 2 * j + 1]);
#pragma unroll
          for (int vb = 0; vb < 2; ++vb) {
            const bf16x8 vf = *(const bf16x8*)(vs + (vb * 32 + r) * 72 + (kb * 2 + s2) * 16 + hh * 8);
            o[vb] = MFMA32(vf, pf.v, o[vb]);
          }
        }
    }
  };
  __syncthreads();
  gload(rkA, rvA, kt_lo);
  gload(rkB, rvB, kt_lo + 1);
  swrite(rkA, rvA, 0);
  __syncthreads();
  for (int kt = kt_lo; kt <= kt_hi; kt += 2) {
    if (kt + 2 <= kt_hi) gload(rkA, rvA, kt + 2);
    if (WIN || kt >= 2 * qb) tile_body(kt, 0, std::true_type{}); else tile_body(kt, 0, std::false_type{});
    swrite(rkB, rvB, 1);
    __syncthreads();
    if (kt + 3 <= kt_hi) gload(rkB, rvB, kt + 3);
    if (WIN || kt + 1 >= 2 * qb) tile_body(kt + 1, 1, std::true_type{}); else tile_body(kt + 1, 1, std::false_type{});
    if (kt + 2 <= kt_hi) swrite(rkA, rvA, 0);
    __syncthreads();
  }
  float lt = lsum + __shfl_xor(lsum, 32);
  float inv = 1.f / lt;
  u32x2 zr[8];
#pragma unroll
  for (int e = 0; e < 8; ++e) zr[e] = *(const u32x2*)(zb + (size_t)qrow * ldz + (e >> 2) * 32 + 8 * (e & 3) + 4 * hh);
#pragma unroll
  for (int vb = 0; vb < 2; ++vb)
#pragma unroll
    for (int g4 = 0; g4 < 4; ++g4) {
      int vd0 = vb * 32 + 8 * g4 + 4 * hh;
      u32x2 z = zr[vb * 4 + g4];
      float a0 = o[vb][4 * g4 + 0] * inv * silu(lo2f(z.x));
      float a1 = o[vb][4 * g4 + 1] * inv * silu(hi2f(z.x));
      float a2 = o[vb][4 * g4 + 2] * inv * silu(lo2f(z.y));
      float a3 = o[vb][4 * g4 + 3] * inv * silu(hi2f(z.y));
      u32x2 ov; ov.x = pack2(a0, a1); ov.y = pack2(a2, a3);
      *(u32x2*)(ob + (size_t)qrow * ldo + vd0) = ov;
    }
}

DI void conv_item(PREF p, int l, int tile, unsigned char* ldsb) {
  float* Gs = (float*)ldsb;
  const int tid = tidx(), lane = tid & 63, w = tid >> 6;
  const int t0 = tile * 32, s0 = t0 & 4095;
  __syncthreads();
  for (int id = tid; id < 62 * 32; id += 256) {
    int rr = id >> 5, ch = (id & 31) * 8;
    int s = s0 - 30 + rr;
    float v[8];
#pragma unroll
    for (int j = 0; j < 8; ++j) v[j] = 0.f;
    if (s >= 0) {
      const u16* src = p.hb + (size_t)(t0 - 30 + rr) * HW + ch;
      float a[8], g[8];
      unpack8(*(const u32x4*)(src + OFF_AVAL), a);
      unpack8(*(const u32x4*)(src + OFF_AGATE), g);
#pragma unroll
      for (int j = 0; j < 8; ++j) v[j] = a[j] * sigm(g[j]);
    }
    *(float4*)(Gs + rr * 256 + ch) = make_float4(v[0], v[1], v[2], v[3]);
    *(float4*)(Gs + rr * 256 + ch + 4) = make_float4(v[4], v[5], v[6], v[7]);
  }
  __syncthreads();
  {
    const int c = tid;
    float wv[31];
#pragma unroll
    for (int j = 0; j < 31; ++j) wv[j] = p.conv_w[((size_t)l * 31 + j) * 256 + c];
    const float bias = p.conv_b[l * 256 + c];
    for (int tt = 0; tt < 32; ++tt) {
      float acc = bias;
#pragma unroll
      for (int j = 0; j < 31; ++j) acc += wv[j] * Gs[(tt + j) * 256 + c];
      Gs[tt * 256 + c] = acc;
    }
  }
  __syncthreads();
  const float4 gg = *(const float4*)(p.conv_ng + l * 256 + lane * 4);
  const float4 bb = *(const float4*)(p.conv_nb + l * 256 + lane * 4);
  for (int q = 0; q < 8; ++q) {
    int tt = w * 8 + q;
    float4 v = *(const float4*)(Gs + tt * 256 + lane * 4);
    float mu = wsum(v.x + v.y + v.z + v.w) * (1.f / 256.f);
    float d0 = v.x - mu, d1 = v.y - mu, d2 = v.z - mu, d3 = v.w - mu;
    float var = wsum(d0 * d0 + d1 * d1 + d2 * d2 + d3 * d3) * (1.f / 256.f);
    float rs = rsqrtf(var + 1e-5f);
    float y0 = silu(d0 * rs * gg.x + bb.x), y1 = silu(d1 * rs * gg.y + bb.y);
    float y2 = silu(d2 * rs * gg.z + bb.z), y3 = silu(d3 * rs * gg.w + bb.w);
    u32x2 ov; ov.x = pack2(y0, y1); ov.y = pack2(y2, y3);
    *(u32x2*)(p.cA + (size_t)(t0 + tt) * 256 + lane * 4) = ov;
  }
}

DI void ssm_stage_u(PREF p, int b, int c, int gq, float* uS) {
  const int tid = tidx();
  int row = tid >> 2, cc = (tid & 3) * 16;
  const u16* src = p.hb + (size_t)(b * S_ + c * 64 + row) * HW + OFF_U + gq * 64 + cc;
  float f[16];
  unpack8(*(const u32x4*)src, f); unpack8(*(const u32x4*)(src + 8), f + 8);
#pragma unroll
  for (int j = 0; j < 4; ++j) *(float4*)(uS + row * 64 + cc + 4 * j) = make_float4(f[4 * j], f[4 * j + 1], f[4 * j + 2], f[4 * j + 3]);
}
#define SSM_STEP(t)                                                                                                        \
  {                                                                                                                        \
    const float4* up = (const float4*)(uS + (t) * 64 + w * 16);                                                            \
    float4 u0 = up[0], u1 = up[1], u2 = up[2], u3 = up[3];                                                                 \
    float uu[16] = {u0.x, u0.y, u0.z, u0.w, u1.x, u1.y, u1.z, u1.w, u2.x, u2.y, u2.z, u2.w, u3.x, u3.y, u3.z, u3.w};       \
    float bur = 0.f, bui = 0.f;                                                                                            \
    _Pragma("unroll") for (int j = 0; j < 16; ++j) { bur += bre[j] * uu[j]; bui += bim[j] * uu[j]; }                       \
    float nr = lr * hr - li * hi + bur, ni = lr * hi + li * hr + bui;                                                      \
    hr = nr; hi = ni;                                                                                                      \
  }

DI void ssm1_item(PREF p, int l, int item, unsigned char* ldsb) {
  const int gq = item & 3, c = (item >> 2) & 63, b = item >> 8;
  const int tid = tidx(), w = tid >> 6, lane = tid & 63;
  const int g = gq * 4 + w;
  float* uS = (float*)ldsb;
  __syncthreads();
  ssm_stage_u(p, b, c, gq, uS);
  __syncthreads();
  const size_t pi = (size_t)(l * 16 + g) * 64 + lane;
  float bre[16], bim[16];
#pragma unroll
  for (int j = 0; j < 16; ++j) { bre[j] = p.bbre[pi * 16 + j]; bim[j] = p.bbim[pi * 16 + j]; }
  const float lr = p.lam[pi * 2], li = p.lam[pi * 2 + 1];
  float hr = 0.f, hi = 0.f;
  for (int t = 0; t < 64; ++t) SSM_STEP(t)
  ((float2*)p.hend)[((size_t)(b * 16 + g) * 64 + c) * 64 + lane] = make_float2(hr, hi);
}

DI void ssm2_item(PREF p, int l, int item, unsigned char* ldsb) {
  const int gq = item & 3, c = (item >> 2) & 63, b = item >> 8;
  const int tid = tidx(), w = tid >> 6, lane = tid & 63;
  const int g = gq * 4 + w;
  float* uS = (float*)ldsb;
  u16* Hs = (u16*)(ldsb + 16384) + w * (16 * 136);
  __syncthreads();
  ssm_stage_u(p, b, c, gq, uS);
  __syncthreads();
  const size_t pi = (size_t)(l * 16 + g) * 64 + lane;
  float bre[16], bim[16];
#pragma unroll
  for (int j = 0; j < 16; ++j) { bre[j] = p.bbre[pi * 16 + j]; bim[j] = p.bbim[pi * 16 + j]; }
  const float lr = p.lam[pi * 2], li = p.lam[pi * 2 + 1];
  float pr = lr, pim = li;
#pragma unroll
  for (int q = 0; q < 6; ++q) { float a = pr * pr - pim * pim, bq = 2.f * pr * pim; pr = a; pim = bq; }
  float hr = 0.f, hi = 0.f;
  const float2* he = (const float2*)p.hend + ((size_t)(b * 16 + g) * 64) * 64 + lane;
  {
    int cc = 0;
    for (; cc + 8 <= c; cc += 8) {
      f32x2 e[8];
#pragma unroll
      for (int u = 0; u < 8; ++u) e[u] = *(const f32x2*)(he + (size_t)(cc + u) * 64);
#pragma unroll
      for (int u = 0; u < 8; ++u) {
        float nr = pr * hr - pim * hi + e[u][0], ni = pr * hi + pim * hr + e[u][1];
        hr = nr; hi = ni;
      }
    }
    for (; cc < c; ++cc) {
      const f32x2 e = *(const f32x2*)(he + (size_t)cc * 64);
      float nr = pr * hr - pim * hi + e[0], ni = pr * hi + pim * hr + e[1];
      hr = nr; hi = ni;
    }
  }
  const int hcol = lane & 15, q4 = lane >> 4;
  bf16x8 cf[4];
  {
    const float* cre = p.c_re + ((size_t)(l * 16 + g) * 16 + hcol) * 64;
    const float* cim = p.c_im + ((size_t)(l * 16 + g) * 16 + hcol) * 64;
#pragma unroll
    for (int ks = 0; ks < 4; ++ks) {
      float v[8];
#pragma unroll
      for (int j = 0; j < 8; ++j) {
        int k = 32 * ks + 8 * q4 + j;
        v[j] = (k & 1) ? -cim[k >> 1] : cre[k >> 1];
      }
      union { bf16x8 v8; u32x4 u; } cv; cv.u = pack8(v); cf[ks] = cv.v8;
    }
  }
  const float dch = p.ssm_d[l * 256 + g * 16 + hcol];
  for (int sub = 0; sub < 4; ++sub) {
    for (int tt = 0; tt < 16; ++tt) {
      SSM_STEP(sub * 16 + tt)
      *(unsigned*)(Hs + tt * 136 + 2 * lane) = pack2(hr, hi);
    }
    __syncthreads();
    f32x4 acc = {0.f, 0.f, 0.f, 0.f};
#pragma unroll
    for (int ks = 0; ks < 4; ++ks) {
      bf16x8 a = *(const bf16x8*)(Hs + hcol * 136 + 32 * ks + 8 * q4);
      acc = MFMA16(a, cf[ks], acc);
    }
#pragma unroll
    for (int j = 0; j < 4; ++j) {
      int t = sub * 16 + 4 * q4 + j;
      float uu = uS[t * 64 + w * 16 + hcol];
      float yv = gelu_t(acc[j] + dch * uu);
      p.yss[(size_t)(b * S_ + c * 64 + t) * 256 + g * 16 + hcol] = f2bf(yv);
    }
    __syncthreads();
  }
}

DI void q_tile(PREF p, int l, int idx, unsigned char* ldsb) {
  u16* lds = (u16*)ldsb; float* Cs = (float*)ldsb; float* aux = (float*)(ldsb + LDS_MAIN);
  const int tid = tidx();
  const int mt = idx / 3, nt = idx % 3;
  const int row0 = mt * 128, col0 = nt * 128;
  __syncthreads();
  if (tid < 128) {
    const u16* src = p.hb + (size_t)(row0 + tid) * HW + OFF_CQ;
    float ss = 0.f;
    for (int i = 0; i < 32; ++i) { float f[8]; unpack8(*(const u32x4*)(src + i * 8), f);
#pragma unroll
      for (int j = 0; j < 8; ++j) ss += f[j] * f[j]; }
    aux[tid] = rsqrtf(ss * (1.f / 256.f) + 1e-6f);
  }
  f32x4 acc[4][4]; zero_acc(acc);
  gemm_main(acc, p.hb + (size_t)row0 * HW + OFF_CQ, HW, p.wts + (size_t)l * WL + O_UQ + (size_t)col0 * 256, 256, 256, lds);
  stage_c(acc, Cs);
#pragma unroll
  for (int q = 0; q < 8; ++q) {
    int r = (tid >> 4) + 16 * q, c = (tid & 15) * 8;
    int n = col0 + c; int dd = n % 96;
    float rs = aux[r];
    float v[8]; ld8(Cs + r * CST + c, v);
#pragma unroll
    for (int j = 0; j < 8; ++j) v[j] *= rs;
    if (dd >= 64) {
      int ri0 = dd - 64; int s = (row0 + r) & 4095;
      float pv[8];
      if (ri0 < 16) {
        ld8(Cs + r * CST + c + 16, pv);
        const float* cs = p.rcos + s * 16 + ri0; const float* sn = p.rsin + s * 16 + ri0;
#pragma unroll
        for (int j = 0; j < 8; ++j) v[j] = v[j] * cs[j] - pv[j] * rs * sn[j];
      } else {
        ld8(Cs + r * CST + c - 16, pv);
        const float* cs = p.rcos + s * 16 + ri0 - 16; const float* sn = p.rsin + s * 16 + ri0 - 16;
#pragma unroll
        for (int j = 0; j < 8; ++j) v[j] = v[j] * cs[j] + pv[j] * rs * sn[j];
      }
    }
    *(u32x4*)(p.Qm + (size_t)(row0 + r) * 384 + n) = pack8(v);
  }
}

DI void kv_tile(PREF p, int l, int idx, unsigned char* ldsb) {
  u16* lds = (u16*)ldsb; float* Cs = (float*)ldsb; float* aux = (float*)(ldsb + LDS_MAIN);
  const int tid = tidx();
  const int mt = idx >> 2, head = idx & 3;
  const int row0 = mt * 128;
  __syncthreads();
  if (tid < 128) {
    const u16* src = p.hb + (size_t)(row0 + tid) * HW + OFF_CKV;
    float ss = 0.f;
    for (int i = 0; i < 16; ++i) { float f[8]; unpack8(*(const u32x4*)(src + i * 8), f);
#pragma unroll
      for (int j = 0; j < 8; ++j) ss += f[j] * f[j]; }
    aux[tid] = rsqrtf(ss * (1.f / 128.f) + 1e-6f);
  }
  f32x4 acc[4][4]; zero_acc(acc);
  gemm_main(acc, p.hb + (size_t)row0 * HW + OFF_CKV, HW, p.wts + (size_t)l * WL + O_UKV + (size_t)head * 128 * 128, 128, 128, lds);
  stage_c(acc, Cs);
#pragma unroll
  for (int q = 0; q < 4; ++q) {
    int r = (tid >> 3) + 32 * q, c = (tid & 7) * 8;
    float rs = aux[r];
    float v[8]; ld8(Cs + r * CST + c, v);
#pragma unroll
    for (int j = 0; j < 8; ++j) v[j] *= rs;
    *(u32x4*)(p.Km + (size_t)(row0 + r) * 384 + head * 96 + c) = pack8(v);
  }
  {
    int b = row0 >> 12, s0 = row0 & 4095;
#pragma unroll
    for (int q = 0; q < 4; ++q) {
      int item = tid + 256 * q; int c = item & 63, rg = item >> 6;
      float v[8];
#pragma unroll
      for (int j = 0; j < 8; ++j) v[j] = Cs[(rg * 8 + j) * CST + 64 + c] * aux[rg * 8 + j];
      *(u32x4*)(p.Vmt + ((size_t)(b * 4 + head) * 64 + c) * S_ + s0 + rg * 8) = pack8(v);
    }
  }
  {
    int r = tid >> 1, half = tid & 1;
    int t = row0 + r, s = t & 4095;
    const u16* src = p.hb + (size_t)t * HW + OFF_KR;
    float x1[16], x2[16];
    unpack8(*(const u32x4*)(src), x1); unpack8(*(const u32x4*)(src + 8), x1 + 8);
    unpack8(*(const u32x4*)(src + 16), x2); unpack8(*(const u32x4*)(src + 24), x2 + 8);
    const float* cs = p.rcos + s * 16; const float* sn = p.rsin + s * 16;
    float ov[16];
#pragma unroll
    for (int i = 0; i < 16; ++i) ov[i] = half ? (x2[i] * cs[i] + x1[i] * sn[i]) : (x1[i] * cs[i] - x2[i] * sn[i]);
    u16* dst = p.Km + (size_t)t * 384 + head * 96 + 64 + half * 16;
    *(u32x4*)dst = pack8(ov); *(u32x4*)(dst + 8) = pack8(ov + 8);
  }
}

DI void pw2_tile(PREF p, int l, int idx, unsigned char* ldsb) {
  u16* lds = (u16*)ldsb; float* Cs = (float*)ldsb;
  const int tid = tidx();
  const int mt = idx >> 1, nt = idx & 1;
  const int row0 = mt * 128, col0 = nt * 128;
  f32x4 acc[4][4]; zero_acc(acc);
  gemm_main(acc, p.cA + (size_t)row0 * 256, 256, p.wts + (size_t)l * WL + O_PW2 + (size_t)col0 * 256, 256, 256, lds);
  stage_c(acc, Cs);
  u32x4 zr[8];
#pragma unroll
  for (int q = 0; q < 8; ++q) zr[q] = *(const u32x4*)(p.hb + (size_t)(row0 + (tid >> 4) + 16 * q) * HW + OFF_AZ + col0 + (tid & 15) * 8);
#pragma unroll
  for (int q = 0; q < 8; ++q) {
    int r = (tid >> 4) + 16 * q, c = (tid & 15) * 8;
    float v[8]; ld8(Cs + r * CST + c, v);
    float z[8]; unpack8(zr[q], z);
#pragma unroll
    for (int j = 0; j < 8; ++j) v[j] *= silu(z[j]);
    *(u32x4*)(p.ys + (size_t)(row0 + r) * 1024 + col0 + c) = pack8(v);
  }
}

DI void glu_tile(PREF p, int l, int idx, unsigned char* ldsb) {
  u16* lds = (u16*)ldsb; float* Cs = (float*)ldsb;
  const int tid = tidx();
  const int mt = idx >> 2, nt = idx & 3;
  const int row0 = mt * 128;
  f32x4 acc[4][4]; zero_acc(acc);
  gemm_main(acc, p.yss + (size_t)row0 * 256, 256, p.wts + (size_t)l * WL + O_GLU + (size_t)nt * 128 * 256, 256, 256, lds);
  stage_c(acc, Cs);
  u32x4 zr[4];
#pragma unroll
  for (int q = 0; q < 4; ++q) zr[q] = *(const u32x4*)(p.hb + (size_t)(row0 + (tid >> 3) + 32 * q) * HW + OFF_CZ + nt * 64 + (tid & 7) * 8);
#pragma unroll
  for (int q = 0; q < 4; ++q) {
    int r = (tid >> 3) + 32 * q, c = (tid & 7) * 8;
    float v[8], g[8]; ld8(Cs + r * CST + c, v); ld8(Cs + r * CST + 64 + c, g);
    float z[8]; unpack8(zr[q], z);
#pragma unroll
    for (int j = 0; j < 8; ++j) v[j] = v[j] * sigm(g[j]) * silu(z[j]);
    *(u32x4*)(p.ys + (size_t)(row0 + r) * 1024 + 512 + nt * 64 + c) = pack8(v);
  }
}

template <int AI, int BJ>
DI void glu_quadrant(PREF p, const f32x4 (&acc)[2][2][4][2], int mt, int nt, float* Cs) {
  const int t = tid512();
  const int row0 = mt * 256 + AI * 128, oc0 = (nt * 2 + BJ) * 64, c = (t & 7) * 8;
  u32x4 zr[2];
#pragma unroll
  for (int q = 0; q < 2; ++q) zr[q] = *(const u32x4*)(p.hb + (size_t)(row0 + (t >> 3) + 64 * q) * HW + OFF_CZ + oc0 + c);
  stage_q<AI, BJ>(acc, Cs);
#pragma unroll
  for (int q = 0; q < 2; ++q) {
    const int r = (t >> 3) + 64 * q;
    float v[8], g[8]; ld8(Cs + r * CST + c, v); ld8(Cs + r * CST + 64 + c, g);
    float z[8]; unpack8(zr[q], z);
#pragma unroll
    for (int j = 0; j < 8; ++j) v[j] = v[j] * sigm(g[j]) * silu(z[j]);
    *(u32x4*)(p.ys + (size_t)(row0 + r) * 1024 + 512 + oc0 + c) = pack8(v);
  }
}
DI void glu_phase(PREF p, int l, unsigned char* lds_all) {
  u16* shm = (u16*)lds_all; float* Cs = (float*)lds_all;
  for (int it = blockIdx.x; it < 256; it += gridDim.x) {
    const int mt = it >> 1, nt = it & 1;
    f32x4 acc[2][2][4][2]; zero_acc256(acc);
    gemm256<256, 256, 256>(acc, p.yss + (size_t)mt * 256 * 256, p.wts + (size_t)l * WL + O_GLU + (size_t)nt * 256 * 256, shm, p);
    glu_quadrant<0, 0>(p, acc, mt, nt, Cs); glu_quadrant<0, 1>(p, acc, mt, nt, Cs);
    glu_quadrant<1, 0>(p, acc, mt, nt, Cs); glu_quadrant<1, 1>(p, acc, mt, nt, Cs);
  }
  __syncthreads();
}

DI u32x4* merge_scratch(PREF p, int region) { const int t = tid512(); return (u32x4*)p.fbuf + (size_t)blockIdx.x * 40960 + region * 8192 + (t >> 6) * 1024 + (t & 63); }
DI void br_store(PREF p, const f32x4 (&acc)[2][2][4][2], int slot) {
  u32x4* sb = merge_scratch(p, slot);
#pragma unroll
  for (int ai = 0; ai < 2; ++ai)
#pragma unroll
    for (int bj = 0; bj < 2; ++bj)
#pragma unroll
      for (int m = 0; m < 4; ++m) {
        u32x4 o;
        o.x = pack2(acc[ai][bj][m][0][0], acc[ai][bj][m][0][1]); o.y = pack2(acc[ai][bj][m][0][2], acc[ai][bj][m][0][3]);
        o.z = pack2(acc[ai][bj][m][1][0], acc[ai][bj][m][1][1]); o.w = pack2(acc[ai][bj][m][1][2], acc[ai][bj][m][1][3]);
        sb[((ai * 2 + bj) * 4 + m) * 64] = o;
      }
}
DI void br_flush(PREF p, f32x4 (&acc)[2][2][4][2], int slot) { br_store(p, acc, slot); zero_acc256(acc); }
DI void gate_reg(PREF p, int l, int n, f32x4 (&acc)[2][2][4][2], int dt) {
  const u32x4* sbn = merge_scratch(p, n);
  u32x4* ssum = merge_scratch(p, 4);
  const int t = tid512(), wid = t >> 6, lane = t & 63, wc = wid & 3, fr = lane & 15;
  const float* bm = p.b_merge + (size_t)l * 4096 + n * 1024 + dt * 256 + wc * 32 + fr;
  float bias[2][2];
#pragma unroll
  for (int bj = 0; bj < 2; ++bj)
#pragma unroll
    for (int nn = 0; nn < 2; ++nn) bias[bj][nn] = bm[bj * 128 + nn * 16];
#pragma unroll
  for (int ai = 0; ai < 2; ++ai)
#pragma unroll
    for (int bj = 0; bj < 2; ++bj) {
      __builtin_amdgcn_sched_barrier(0);
      u32x4 bn[4], pv[4];
#pragma unroll
      for (int m = 0; m < 4; ++m) {
        bn[m] = sbn[((ai * 2 + bj) * 4 + m) * 64];
        if (n > 0) pv[m] = ssum[((ai * 2 + bj) * 4 + m) * 64];
      }
#pragma unroll
      for (int m = 0; m < 4; ++m) {
        float b[8]; unpack8(bn[m], b);
        float v[8];
#pragma unroll
        for (int nn = 0; nn < 2; ++nn)
#pragma unroll
          for (int j = 0; j < 4; ++j) v[nn * 4 + j] = sigm(acc[ai][bj][m][nn][j] + bias[bj][nn]) * b[nn * 4 + j];
        if (n > 0) {
          float o[8]; unpack8(pv[m], o);
#pragma unroll
          for (int e = 0; e < 8; ++e) v[e] += o[e];
        }
        if (n < 3) ssum[((ai * 2 + bj) * 4 + m) * 64] = pack8(v);
#pragma unroll
        for (int nn = 0; nn < 2; ++nn)
#pragma unroll
          for (int j = 0; j < 4; ++j) acc[ai][bj][m][nn][j] = v[nn * 4 + j];
      }
    }
}
template <int AI, int BJ>
DI void mg_quadrant(PREF p, const f32x4 (&acc)[2][2][4][2], int mt, int dt, float* Cs) {
  const int t = tid512();
  const int row0 = mt * 256 + AI * 128, col0 = dt * 256 + BJ * 128;
  stage_q<AI, BJ>(acc, Cs);
#pragma unroll
  for (int q = 0; q < 4; ++q) {
    int r = (t >> 4) + 32 * q, c = (t & 15) * 8;
    float v[8]; ld8(Cs + r * CST + c, v);
    *(u32x4*)(p.mg + (size_t)(row0 + r) * 1024 + col0 + c) = pack8(v);
  }
}
DI void merge_phase(PREF p, int l, unsigned char* lds_all) {
  u16* shm = (u16*)lds_all; float* Cs = (float*)lds_all;
  const u16* W = p.wts + (size_t)l * WL;
  for (int k = 0;; ++k) {
    int mt, dt;
    if (!xcd_tile256(k, 4, mt, dt)) break;
    {
      f32x4 acc[2][2][4][2]; zero_acc256(acc);
      gemm256<1024, 256, 1024, 1>(acc, p.ys + (size_t)mt * 256 * 1024, W + O_BR + (size_t)dt * 256 * 256, shm, p);
      br_store(p, acc, 3);
    }
#pragma unroll 1
    for (int n = 0; n < 4; ++n) {
      f32x4 acc[2][2][4][2]; zero_acc256(acc);
      gemm256<1024, 1024, 1024>(acc, p.X + (size_t)mt * 256 * 1024, W + O_WM + ((size_t)n * 1024 + dt * 256) * 1024, shm, p);
      gate_reg(p, l, n, acc, dt);
      if (n == 3) {
        mg_quadrant<0, 0>(p, acc, mt, dt, Cs); mg_quadrant<0, 1>(p, acc, mt, dt, Cs);
        mg_quadrant<1, 0>(p, acc, mt, dt, Cs); mg_quadrant<1, 1>(p, acc, mt, dt, Cs);
      }
    }
  }
  __syncthreads();
}

template <int AI, int BJ>
DI void f1_load(PREF p, int l, int mt, int dt, float4 (&xa)[4], float4 (&xb)[4]) {
  const int t = tid512();
  const int row0 = mt * 256 + AI * 128, col0 = dt * 256 + BJ * 128, c = (t & 15) * 8;
  if (l == 0) {
#pragma unroll
    for (int q = 0; q < 4; ++q) {
      const float4* xs = (const float4*)(p.x + (size_t)(row0 + (t >> 4) + 32 * q) * 1024 + col0 + c);
      xa[q] = xs[0]; xb[q] = xs[1];
    }
  } else {
#pragma unroll
    for (int q = 0; q < 4; ++q) {
      float f[8]; unpack8(*(const u32x4*)(p.X + (size_t)(row0 + (t >> 4) + 32 * q) * 1024 + col0 + c), f);
      xa[q] = make_float4(f[0], f[1], f[2], f[3]); xb[q] = make_float4(f[4], f[5], f[6], f[7]);
    }
  }
}
template <int AI, int BJ>
DI void f1_proc(PREF p, const f32x4 (&acc)[2][2][4][2], int mt, int dt, float* Cs, const float4 (&xa)[4], const float4 (&xb)[4]) {
  const int t = tid512();
  const int row0 = mt * 256 + AI * 128, col0 = dt * 256 + BJ * 128, c = (t & 15) * 8;
  const float alpha = 1.681792830507429f;
  stage_q<AI, BJ>(acc, Cs);
#pragma unroll
  for (int q = 0; q < 4; ++q) {
    int r = (t >> 4) + 32 * q;
    float v[8]; ld8(Cs + r * CST + c, v);
    float4 a = xa[q], b = xb[q];
    float y[8] = {alpha * a.x + v[0], alpha * a.y + v[1], alpha * a.z + v[2], alpha * a.w + v[3],
                  alpha * b.x + v[4], alpha * b.y + v[5], alpha * b.z + v[6], alpha * b.w + v[7]};
    *(u32x4*)((u16*)p.fbuf + (size_t)(row0 + r) * 1024 + col0 + c) = pack8(y);
  }
}
DI void f1_phase(PREF p, int l, unsigned char* lds_all) {
  u16* shm = (u16*)lds_all; float* Cs = (float*)lds_all;
  for (int k = 0;; ++k) {
    int mt, dt;
    if (!xcd_tile256(k, 4, mt, dt)) break;
    f32x4 acc[2][2][4][2]; zero_acc256(acc);
    gemm256<1024, 1024, 1024>(acc, p.mg + (size_t)mt * 256 * 1024, p.wts + (size_t)l * WL + O_OUT + (size_t)dt * 256 * 1024, shm, p);
    {
      float4 aA[4], bA[4];
      f1_load<0, 0>(p, l, mt, dt, aA, bA); f1_proc<0, 0>(p, acc, mt, dt, Cs, aA, bA);
      f1_load<0, 1>(p, l, mt, dt, aA, bA); f1_proc<0, 1>(p, acc, mt, dt, Cs, aA, bA);
      f1_load<1, 0>(p, l, mt, dt, aA, bA); f1_proc<1, 0>(p, acc, mt, dt, Cs, aA, bA);
      f1_load<1, 1>(p, l, mt, dt, aA, bA); f1_proc<1, 1>(p, acc, mt, dt, Cs, aA, bA);
    }
  }
  __syncthreads();
}

template <int AI, int BJ>
DI void f3_load(PREF p, int mt, int dt, u32x4 (&g)[4]) {
  const int t = tid512();
  const int row0 = mt * 256 + AI * 128, col0 = dt * 256 + BJ * 128, c = (t & 15) * 8;
#pragma unroll
  for (int q = 0; q < 4; ++q) g[q] = *(const u32x4*)((const u16*)p.fbuf + (size_t)(row0 + (t >> 4) + 32 * q) * 1024 + col0 + c);
}
template <int AI, int BJ, int PASS>
DI void f3_proc(PREF p, const f32x4 (&acc)[2][2][4][2], int mt, int dt, float* Cs, const u32x4 (&g)[4]) {
  const int t = tid512();
  const int row0 = mt * 256 + AI * 128, col0 = dt * 256 + BJ * 128;
  const int c = (t & 15) * 8;
  stage_q<AI, BJ>(acc, Cs);
#pragma unroll
  for (int q = 0; q < 4; ++q) {
    int r = (t >> 4) + 32 * q;
    float v[8]; ld8(Cs + r * CST + c, v);
    if (PASS == 0) {
#pragma unroll
      for (int j = 0; j < 8; ++j) v[j] = sigm(v[j]);
    } else {
      float gf[8]; unpack8(g[q], gf);
#pragma unroll
      for (int j = 0; j < 8; ++j) v[j] *= gf[j];
    }
    *(u32x4*)((u16*)p.fbuf + (size_t)(row0 + r) * 1024 + col0 + c) = pack8(v);
  }
}
DI void f3_phase(PREF p, int l, unsigned char* lds_all) {
  u16* shm = (u16*)lds_all; float* Cs = (float*)lds_all;
  const u16* W = p.wts + (size_t)l * WL;
  for (int k = 0;; ++k) {
    int mt, dt;
    if (!xcd_tile256(k, 4, mt, dt)) break;
    {
      f32x4 acc[2][2][4][2]; zero_acc256(acc);
      gemm256<1024, 1024, 1024>(acc, p.X + (size_t)mt * 256 * 1024, W + O_PLEG + (size_t)dt * 256 * 1024, shm, p);
      u32x4 gd[4];
      f3_proc<0, 0, 0>(p, acc, mt, dt, Cs, gd); f3_proc<0, 1, 0>(p, acc, mt, dt, Cs, gd);
      f3_proc<1, 0, 0>(p, acc, mt, dt, Cs, gd); f3_proc<1, 1, 0>(p, acc, mt, dt, Cs, gd);
    }
    f32x4 acc[2][2][4][2]; zero_acc256(acc);
    gemm256<256, 256, 256>(acc, p.pb + (size_t)mt * 256 * 256, W + O_PLE + (size_t)dt * 256 * 256, shm, p);
    {
      u32x4 gA[4], gB[4];
      f3_load<0, 0>(p, mt, dt, gA);
      f3_load<0, 1>(p, mt, dt, gB); f3_proc<0, 0, 1>(p, acc, mt, dt, Cs, gA);
      f3_load<1, 0>(p, mt, dt, gA); f3_proc<0, 1, 1>(p, acc, mt, dt, Cs, gB);
      f3_load<1, 1>(p, mt, dt, gB); f3_proc<1, 0, 1>(p, acc, mt, dt, Cs, gA);
      f3_proc<1, 1, 1>(p, acc, mt, dt, Cs, gB);
    }
  }
  __syncthreads();
}

DI void rows_ln(PREF p, int l) {
  const int tid = tidx(), lane = tid & 63, w = tid >> 6;
  float gg[16], bb[16];
#pragma unroll
  for (int h = 0; h < 2; ++h) {
    const int c = h * 512 + lane * 8;
    const float4 g0 = *(const float4*)(p.ln_g + l * 1024 + c), g1 = *(const float4*)(p.ln_g + l * 1024 + c + 4);
    const float4 b0 = *(const float4*)(p.ln_b + l * 1024 + c), b1 = *(const float4*)(p.ln_b + l * 1024 + c + 4);
    gg[h * 8 + 0] = g0.x; gg[h * 8 + 1] = g0.y; gg[h * 8 + 2] = g0.z; gg[h * 8 + 3] = g0.w;
    gg[h * 8 + 4] = g1.x; gg[h * 8 + 5] = g1.y; gg[h * 8 + 6] = g1.z; gg[h * 8 + 7] = g1.w;
    bb[h * 8 + 0] = b0.x; bb[h * 8 + 1] = b0.y; bb[h * 8 + 2] = b0.z; bb[h * 8 + 3] = b0.w;
    bb[h * 8 + 4] = b1.x; bb[h * 8 + 5] = b1.y; bb[h * 8 + 6] = b1.z; bb[h * 8 + 7] = b1.w;
  }
  for (int row = vbid() * 4 + w; row < T_ / 2; row += vgrid() * 4) {
    u32x4 raw[2][2];
#pragma unroll
    for (int k = 0; k < 2; ++k) {
      const u16* src = (const u16*)p.fbuf + (size_t)(row + k * (T_ / 2)) * 1024;
      raw[k][0] = *(const u32x4*)(src + lane * 8);
      raw[k][1] = *(const u32x4*)(src + 512 + lane * 8);
    }
#pragma unroll
    for (int k = 0; k < 2; ++k) {
      float v[16];
      unpack8(raw[k][0], v); unpack8(raw[k][1], v + 8);
      float s = 0.f;
#pragma unroll
      for (int i = 0; i < 16; ++i) s += v[i];
      const float mu = wsum(s) * (1.f / 1024.f);
      float sq = 0.f;
#pragma unroll
      for (int i = 0; i < 16; ++i) { v[i] -= mu; sq += v[i] * v[i]; }
      const float rs = rsqrtf(wsum(sq) * (1.f / 1024.f) + 1e-5f);
#pragma unroll
      for (int h = 0; h < 2; ++h) {
        float y[8];
#pragma unroll
        for (int j = 0; j < 8; ++j) y[j] = v[h * 8 + j] * rs * gg[h * 8 + j] + bb[h * 8 + j];
        *(u32x4*)(p.X + (size_t)(row + k * (T_ / 2)) * 1024 + h * 512 + lane * 8) = pack8(y);
      }
    }
  }
}

DI void rows_ple(PREF p, int l) {
  const int tid = tidx(), lane = tid & 63, w = tid >> 6;
  for (int row = vbid() * 4 + w; row < T_; row += vgrid() * 4) {
    const u16* src = (const u16*)p.fbuf + (size_t)row * 1024;
    float v[16];
    unpack8(*(const u32x4*)(src + lane * 8), v);
    unpack8(*(const u32x4*)(src + 512 + lane * 8), v + 8);
    float xv[16];
    unpack8(*(const u32x4*)(p.X + (size_t)row * 1024 + lane * 8), xv);
    unpack8(*(const u32x4*)(p.X + (size_t)row * 1024 + 512 + lane * 8), xv + 8);
    float sq = 0.f;
#pragma unroll
    for (int i = 0; i < 16; ++i) sq += v[i] * v[i];
    const float rs = rsqrtf(wsum(sq) * (1.f / 1024.f) + 1e-6f);
#pragma unroll
    for (int h = 0; h < 2; ++h) {
      const int c = h * 512 + lane * 8;
      const float4 g0 = *(const float4*)(p.ple_ng + l * 1024 + c), g1 = *(const float4*)(p.ple_ng + l * 1024 + c + 4);
      float y[8];
      y[0] = xv[h * 8 + 0] + v[h * 8 + 0] * rs * g0.x; y[1] = xv[h * 8 + 1] + v[h * 8 + 1] * rs * g0.y;
      y[2] = xv[h * 8 + 2] + v[h * 8 + 2] * rs * g0.z; y[3] = xv[h * 8 + 3] + v[h * 8 + 3] * rs * g0.w;
      y[4] = xv[h * 8 + 4] + v[h * 8 + 4] * rs * g1.x; y[5] = xv[h * 8 + 5] + v[h * 8 + 5] * rs * g1.y;
      y[6] = xv[h * 8 + 6] + v[h * 8 + 6] * rs * g1.z; y[7] = xv[h * 8 + 7] + v[h * 8 + 7] * rs * g1.w;
      if (l == NL - 1) {
        float4* od = (float4*)(p.out + (size_t)row * 1024 + c);
        od[0] = make_float4(y[0], y[1], y[2], y[3]); od[1] = make_float4(y[4], y[5], y[6], y[7]);
      } else {
        *(u32x4*)(p.X + (size_t)row * 1024 + c) = pack8(y);
      }
    }
  }
}

DI void phase_mix1(PREF p, int l, unsigned char* ldsb) {
  for (int it = vbid(); it < 1024; it += vgrid()) {
    int pi = it >> 1, b = pi >> 6, hq = ((pi >> 5) & 1) * 2 + (it & 1), qb = pi & 31;
    const u16* hbb = p.hb + (size_t)b * S_ * HW;
    attn_item<64, true>(hbb + OFF_SQ + hq * 64, HW, hbb + OFF_SK + (hq >> 1) * 64, HW,
                        p.Vst + (size_t)(b * 2 + (hq >> 1)) * 64 * S_, qb, 0.125f * LOG2E, p.sinks[l * 4 + hq] * 8.0f,
                        hbb + OFF_DZ + hq * 64, HW, p.ys + (size_t)b * S_ * 1024 + 768 + hq * 64, 1024, (u16*)ldsb);
  }
  for (int it = vbid(); it < 1024; it += vgrid()) kv_tile(p, l, it, ldsb);
  for (int it = vbid(); it < 768; it += vgrid()) q_tile(p, l, it, ldsb);
  for (int it = vbid(); it < 1024; it += vgrid()) conv_item(p, l, it, ldsb);
  for (int it = vbid(); it < 2048; it += vgrid()) ssm1_item(p, l, it, ldsb);
}
DI void phase_mix2(PREF p, int l, unsigned char* ldsb) {
  for (int it = vbid(); it < 1024; it += vgrid()) {
    int qb = (it < 512) ? 31 - (it >> 5) : ((it - 512) >> 5);
    int bh = it & 31, b = bh >> 2, head = bh & 3;
    attn_item<96, false>(p.Qm + (size_t)b * S_ * 384 + head * 96, 384, p.Km + (size_t)b * S_ * 384 + head * 96, 384,
                         p.Vmt + (size_t)(b * 4 + head) * 64 * S_, qb, 0.10206207261596577f * LOG2E, 0.f,
                         p.hb + (size_t)b * S_ * HW + OFF_BZ + head * 64, HW, p.ys + (size_t)b * S_ * 1024 + 256 + head * 64, 1024,
                         (u16*)ldsb);
  }
  for (int it = vbid(); it < 512; it += vgrid()) pw2_tile(p, l, it, ldsb);
  for (int it = vbid(); it < 2048; it += vgrid()) ssm2_item(p, l, it, ldsb);
}

DI void grid_barrier(unsigned* bar, unsigned gen) {
  asm volatile("s_waitcnt vmcnt(0)" ::: "memory");
  __syncthreads();
  if (threadIdx.x == 0) {
    __builtin_amdgcn_fence(__ATOMIC_RELEASE, "agent");
    const unsigned grp = blockIdx.x & 15u;
    const unsigned nblk = (gridDim.x + 15u - grp) >> 4;
    unsigned old = __hip_atomic_fetch_add(bar + 64 * (1 + grp), 1u, __ATOMIC_RELAXED, __HIP_MEMORY_SCOPE_AGENT);
    if (old + 1u == nblk * gen) {
      unsigned g = __hip_atomic_fetch_add(bar, 1u, __ATOMIC_RELAXED, __HIP_MEMORY_SCOPE_AGENT);
      if (g + 1u == 16u * gen) {
        for (int i = 0; i < 16; ++i) __hip_atomic_store(bar + 64 * (17 + i), gen, __ATOMIC_RELAXED, __HIP_MEMORY_SCOPE_AGENT);
      }
    }
    while (__hip_atomic_load(bar + 64 * (17 + grp), __ATOMIC_RELAXED, __HIP_MEMORY_SCOPE_AGENT) < gen) __builtin_amdgcn_s_sleep(4);
    __builtin_amdgcn_fence(__ATOMIC_ACQUIRE, "agent");
  }
  __syncthreads();
}

template <int J>
DI void run_phase(PREF p, int l, unsigned char* ldsb, unsigned char* lds_all) {
  if (J == 0) phase_in(p, l, lds_all);
  else if (J == 1) phase_mix1(p, l, ldsb);
  else if (J == 2) phase_mix2(p, l, ldsb);
  else if (J == 3) glu_phase(p, l, lds_all);
  else if (J == 4) merge_phase(p, l, lds_all);
  else if (J == 5) f1_phase(p, l, lds_all);
  else if (J == 6) rows_ln(p, l);
  else if (J == 7) f3_phase(p, l, lds_all);
  else if (J == 8) rows_ple(p, l);
  else phase_prep(p, ldsb);
}

#if MULTI_LAUNCH
template <int J>
__global__ void __launch_bounds__(256, 2) phk(Params p, int l) {
  __shared__ __attribute__((aligned(16))) unsigned char ldsb[LDS_BYTES];
  run_phase<J>(p, l, ldsb);
}
#else
__global__ void __launch_bounds__(512, 2) mega(Params p_unused, int ph0, int ph1) {
  __shared__ __attribute__((aligned(16))) unsigned char lds_all[LDS_BYTES];
  unsigned char* ldsb = lds_all + half_() * LDS_HALF;
  cg::grid_group grid = cg::this_grid();
  for (int ph = ph0; ph < ph1; ++ph) {
    const __attribute__((address_space(4))) Params* pp = (const __attribute__((address_space(4))) Params*)__builtin_amdgcn_kernarg_segment_ptr();
    asm volatile("" : "+s"(pp));
    PREF p = *pp;
    if (ph1 < 0) grid.sync();
    if (ph > ph0) grid_barrier(p.bar, (unsigned)(ph - ph0));
    if (ph == 0) { run_phase<9>(p, 0, ldsb, lds_all); continue; }
    int l = (ph - 1) / NPH_LAYER; const int j = (ph - 1) % NPH_LAYER;
    asm volatile("" : "+s"(l));
    if (j == 0) run_phase<0>(p, l, ldsb, lds_all);
    else if (j == 1) run_phase<1>(p, l, ldsb, lds_all);
    else if (j == 2) run_phase<2>(p, l, ldsb, lds_all);
    else if (j == 3) run_phase<3>(p, l, ldsb, lds_all);
    else if (j == 4) run_phase<4>(p, l, ldsb, lds_all);
    else if (j == 5) run_phase<5>(p, l, ldsb, lds_all);
    else if (j == 6) run_phase<6>(p, l, ldsb, lds_all);
    else if (j == 7) run_phase<7>(p, l, ldsb, lds_all);
    else run_phase<8>(p, l, ldsb, lds_all);
  }
}
#endif

extern "C" void kernel_launch(void* const* d_in, const int* in_sizes, int n_in, void* d_out, int out_size, void* d_ws,
                              size_t ws_size, hipStream_t stream) {
  static int grid_blocks = 0;
  if (!grid_blocks) {
    int dev = 0, cus = 0, per_cu = 2;
    (void)hipGetDevice(&dev);
    (void)hipDeviceGetAttribute(&cus, hipDeviceAttributeMultiprocessorCount, dev);
#if !MULTI_LAUNCH
    (void)hipOccupancyMaxActiveBlocksPerMultiprocessor(&per_cu, mega, 512, 0);
    per_cu = 1;
#endif
    if (cus < 1) cus = 256;
    grid_blocks = cus * per_cu;
  }
  Params p{};
  const float** f = (const float**)&p;
  for (int i = 0; i < 31; ++i) f[i] = (const float*)d_in[i];
  p.out = (float*)d_out;
  unsigned char* ws = (unsigned char*)d_ws;
  size_t off = 0;
  auto take = [&](size_t bytes) { unsigned char* r = ws + off; off += (bytes + 255) & ~(size_t)255; return r; };
  p.wts = (u16*)take(WL * NL * 2);
  p.lam = (float*)take((size_t)NL * 16 * 64 * 2 * 4);
  p.bbre = (float*)take((size_t)NL * 16 * 64 * 16 * 4);
  p.bbim = (float*)take((size_t)NL * 16 * 64 * 16 * 4);
  p.rcos = (float*)take((size_t)S_ * 16 * 4);
  p.rsin = (float*)take((size_t)S_ * 16 * 4);
  p.X = (u16*)take((size_t)T_ * 1024 * 2);
  p.pb = (u16*)take((size_t)T_ * 256 * 2);
  p.hb = (u16*)take((size_t)T_ * HW * 2);
  p.ys = (u16*)take((size_t)T_ * 1024 * 2);
  p.cA = (u16*)take((size_t)T_ * 256 * 2);
  p.Qm = (u16*)take((size_t)T_ * 384 * 2);
  p.Km = (u16*)take((size_t)T_ * 384 * 2);
  p.Vmt = (u16*)take((size_t)T_ * 256 * 2);
  p.Vst = (u16*)take((size_t)T_ * 128 * 2);
  p.yss = (u16*)take((size_t)T_ * 256 * 2);
  p.hend = (float*)take((size_t)8 * 16 * 64 * 64 * 2 * 4);
  p.bar = (unsigned*)take(16384);
  p.mg = p.cA;
  p.fbuf = (float*)p.hb;
  if (off > ws_size) fprintf(stderr, "workspace too small: need %zu have %zu\n", off, ws_size);
  const int NPH = 1 + NPH_LAYER * NL;
#if MULTI_LAUNCH
  (void)NPH;
  const dim3 g(grid_blocks), b(256);
  hipLaunchKernelGGL(phk<9>, g, b, 0, stream, p, 0);
  for (int l = 0; l < NL; ++l) {
    hipLaunchKernelGGL(phk<0>, g, b, 0, stream, p, l);
    hipLaunchKernelGGL(phk<1>, g, b, 0, stream, p, l);
    hipLaunchKernelGGL(phk<2>, g, b, 0, stream, p, l);
    hipLaunchKernelGGL(phk<3>, g, b, 0, stream, p, l);
    hipLaunchKernelGGL(phk<4>, g, b, 0, stream, p, l);
    hipLaunchKernelGGL(phk<5>, g, b, 0, stream, p, l);
    hipLaunchKernelGGL(phk<6>, g, b, 0, stream, p, l);
    hipLaunchKernelGGL(phk<7>, g, b, 0, stream, p, l);
    hipLaunchKernelGGL(phk<8>, g, b, 0, stream, p, l);
  }
#else
  int ph0 = 0, ph1 = NPH;
  (void)hipMemsetAsync(p.bar, 0, 16384, stream);
  void* args[] = {&p, &ph0, &ph1};
  hipError_t e = hipLaunchCooperativeKernel((void*)mega, dim3(grid_blocks), dim3(512), args, 0, stream);
  if (e != hipSuccess) fprintf(stderr, "cooperative launch failed: %s (grid %d)\n", hipGetErrorString(e), grid_blocks);
#endif
}
```

```cpp
#include <hip/hip_runtime.h>
#include <hip/hip_cooperative_groups.h>
#include <cstdio>
#include <type_traits>
namespace cg = cooperative_groups;

#ifndef MULTI_LAUNCH
#define MULTI_LAUNCH 0
#endif

typedef unsigned short u16;
typedef __attribute__((ext_vector_type(8))) short bf16x8;
typedef __attribute__((ext_vector_type(4))) float f32x4;
typedef __attribute__((ext_vector_type(16))) float f32x16;
typedef __attribute__((ext_vector_type(4))) unsigned u32x4;
typedef __attribute__((ext_vector_type(2))) unsigned u32x2;
typedef __attribute__((ext_vector_type(2))) float f32x2;
#define DI __device__ __forceinline__
DI int tidx() { int t = threadIdx.x & 255; asm volatile("" : "+v"(t)); return t; }
DI int half_() { return __builtin_amdgcn_readfirstlane((int)(threadIdx.x >> 8)); }
DI int vbid() { return (int)blockIdx.x * 2 + half_(); }
DI int vgrid() { return (int)gridDim.x * 2; }

constexpr int T_ = 32768, S_ = 4096, D_ = 1024, HW = 2720, NL = 4;
constexpr int OFF_AVAL = 0, OFF_AGATE = 256, OFF_AZ = 512, OFF_CQ = 768, OFF_CKV = 1024, OFF_KR = 1152, OFF_BZ = 1184,
              OFF_U = 1440, OFF_CZ = 1696, OFF_SQ = 1952, OFF_SK = 2208, OFF_SV = 2336, OFF_DZ = 2464;
constexpr size_t O_WIN = 0, O_WM = O_WIN + 2816 * 1024, O_PW2 = O_WM + 4096 * 1024, O_UQ = O_PW2 + 65536, O_UKV = O_UQ + 98304,
                 O_GLU = O_UKV + 65536, O_BR = O_GLU + 131072, O_OUT = O_BR + 1048576, O_PLE = O_OUT + 1048576,
                 O_PLEG = O_PLE + 262144, WL = O_PLEG + 1048576;
constexpr int LDT = 64;
constexpr int TILE_E = 128 * LDT;
constexpr int CST = 132;
constexpr int LDS_MAIN = 73728;
constexpr int LDS_HALF = LDS_MAIN + 1024;
constexpr int LDS_BYTES = 2 * LDS_HALF;
constexpr float LOG2E = 1.4426950408889634f;
constexpr int NPH_LAYER = 9;

struct Params {
  const float *x, *p, *w_in, *w_merge, *b_merge, *conv_w, *conv_b, *conv_ng, *conv_nb, *w_pw2, *qng, *kvng, *w_uq, *w_ukv,
      *a_re, *a_im, *log_dt, *b_re, *b_im, *c_re, *c_im, *ssm_d, *w_glu, *sinks, *w_branch, *w_out, *ln_g, *ln_b, *w_ple,
      *w_pleg, *ple_ng;
  float* out;
  u16* wts;
  float *lam, *bbre, *bbim, *rcos, *rsin;
  u16 *X, *pb, *hb, *ys, *cA, *Qm, *Km, *Vmt, *Vst, *yss, *mg;
  float *hend, *fbuf;
  unsigned* bar;
};

typedef const __attribute__((address_space(4))) Params& PREF;

DI unsigned pack2(float a, float b) { unsigned r; asm("v_cvt_pk_bf16_f32 %0, %1, %2\n\ts_nop 1" : "=v"(r) : "v"(a), "v"(b)); return r; }
DI u16 f2bf(float x) { return (u16)(pack2(x, x) & 0xffffu); }
DI float bf2f(u16 v) { return __uint_as_float(((unsigned)v) << 16); }
DI float lo2f(unsigned u) { return __uint_as_float(u << 16); }
DI float hi2f(unsigned u) { return __uint_as_float(u & 0xffff0000u); }
DI float sigm(float x) { return 1.f / (1.f + __expf(-x)); }
DI float silu(float x) { return x / (1.f + __expf(-x)); }
DI float gelu_t(float x) { float u = 0.7978845608028654f * (x + 0.044715f * x * x * x); return x / (1.f + __expf(-2.f * u)); }
DI void unpack8(u32x4 v, float* f) {
  f[0] = lo2f(v.x); f[1] = hi2f(v.x); f[2] = lo2f(v.y); f[3] = hi2f(v.y);
  f[4] = lo2f(v.z); f[5] = hi2f(v.z); f[6] = lo2f(v.w); f[7] = hi2f(v.w);
}
DI u32x4 pack8(const float* f) { u32x4 o; o.x = pack2(f[0], f[1]); o.y = pack2(f[2], f[3]); o.z = pack2(f[4], f[5]); o.w = pack2(f[6], f[7]); return o; }
DI float wsum(float v) {
#pragma unroll
  for (int o = 32; o >= 1; o >>= 1) v += __shfl_xor(v, o);
  return v;
}
#define MFMA32(a, b, c) __builtin_amdgcn_mfma_f32_32x32x16_bf16((a), (b), (c), 0, 0, 0)
#define MFMA16(a, b, c) __builtin_amdgcn_mfma_f32_16x16x32_bf16((a), (b), (c), 0, 0, 0)

DI void zero_acc(f32x4 (&a)[4][4]) {
#pragma unroll
  for (int i = 0; i < 4; ++i)
#pragma unroll
    for (int j = 0; j < 4; ++j)
#pragma unroll
      for (int k = 0; k < 4; ++k) a[i][j][k] = 0.f;
}

#define GM_LOAD(RA, RB, KT)                                                                 \
  _Pragma("unroll") for (int i = 0; i < 4; ++i) {                                           \
    RA[i] = *(const u32x4*)(ag + (size_t)(32 * i) * lda + (KT) * 64);                       \
    RB[i] = *(const u32x4*)(bg + (size_t)(32 * i) * ldb + (KT) * 64);                       \
  }
#define GM_STORE(RA, RB, STG)                                                               \
  {                                                                                         \
    u16* dA_ = lds + (STG) * 2 * TILE_E;                                                    \
    _Pragma("unroll") for (int i = 0; i < 4; ++i) {                                         \
      *(u32x4*)(dA_ + (lrow + 32 * i) * LDT + lsw) = RA[i];                                 \
      *(u32x4*)(dA_ + TILE_E + (lrow + 32 * i) * LDT + lsw) = RB[i];                        \
    }                                                                                       \
  }
#define GM_COMPUTE(STG)                                                                     \
  {                                                                                         \
    const u16* sA = lds + (STG) * 2 * TILE_E + (wm * 64 + fr) * LDT;                        \
    const u16* sB = lds + (STG) * 2 * TILE_E + TILE_E + (wn * 64 + fr) * LDT;               \
    __builtin_amdgcn_s_setprio(1);                                                          \
    _Pragma("unroll") for (int kk = 0; kk < 2; ++kk) {                                      \
      const int co = (((kk * 4 + fq) ^ (fr & 7)) * 8);                                      \
      bf16x8 af[4];                                                                         \
      _Pragma("unroll") for (int m = 0; m < 4; ++m) af[m] = *(const bf16x8*)(sA + m * 16 * LDT + co);   \
      _Pragma("unroll") for (int n = 0; n < 4; ++n) {                                       \
        const bf16x8 bfr = *(const bf16x8*)(sB + n * 16 * LDT + co);                        \
        _Pragma("unroll") for (int m = 0; m < 4; ++m) acc[m][n] = MFMA16(af[m], bfr, acc[m][n]);        \
      }                                                                                     \
    }                                                                                       \
    __builtin_amdgcn_s_setprio(0);                                                          \
  }
template <bool DEEP = true>
DI void gemm_main(f32x4 (&acc)[4][4], const u16* __restrict__ A, int lda, const u16* __restrict__ B, int ldb, int K, u16* lds) {
  const int tid = tidx(), lane = tid & 63, w = tid >> 6;
  const int wm = w >> 1, wn = w & 1, fr = lane & 15, fq = lane >> 4;
  const int lrow = tid >> 3, lch = (tid & 7) * 8, lsw = ((tid & 7) ^ (lrow & 7)) * 8;
  const u16* ag = A + (size_t)lrow * lda + lch;
  const u16* bg = B + (size_t)lrow * ldb + lch;
  const int nk = K >> 6;
  if (DEEP) {
    u32x4 ra0[4], rb0[4], ra1[4], rb1[4];
    GM_LOAD(ra0, rb0, 0)
    GM_LOAD(ra1, rb1, 1)
    __syncthreads();
    GM_STORE(ra0, rb0, 0)
    __syncthreads();
    for (int kt = 0; kt < nk; kt += 2) {
      if (kt + 2 < nk) { GM_LOAD(ra0, rb0, kt + 2) }
      GM_COMPUTE(0)
      __builtin_amdgcn_sched_barrier(0);
      GM_STORE(ra1, rb1, 1)
      __syncthreads();
      if (kt + 3 < nk) { GM_LOAD(ra1, rb1, kt + 3) }
      GM_COMPUTE(1)
      __builtin_amdgcn_sched_barrier(0);
      if (kt + 2 < nk) { GM_STORE(ra0, rb0, 0) }
      __syncthreads();
    }
  } else {
    u32x4 ra0[4], rb0[4];
    GM_LOAD(ra0, rb0, 0)
    __syncthreads();
    GM_STORE(ra0, rb0, 0)
    __syncthreads();
    for (int kt = 0; kt < nk; kt += 2) {
      GM_LOAD(ra0, rb0, kt + 1)
      GM_COMPUTE(0)
      __builtin_amdgcn_sched_barrier(0);
      GM_STORE(ra0, rb0, 1)
      __syncthreads();
      if (kt + 2 < nk) { GM_LOAD(ra0, rb0, kt + 2) }
      GM_COMPUTE(1)
      __builtin_amdgcn_sched_barrier(0);
      if (kt + 2 < nk) { GM_STORE(ra0, rb0, 0) }
      __syncthreads();
    }
  }
}

DI void stage_c(const f32x4 (&acc)[4][4], float* Cs) {
  const int tid = tidx(), lane = tid & 63, w = tid >> 6;
  const int wm = w >> 1, wn = w & 1, fr = lane & 15, fq = lane >> 4;
#pragma unroll
  for (int m = 0; m < 4; ++m)
#pragma unroll
    for (int n = 0; n < 4; ++n)
#pragma unroll
      for (int j = 0; j < 4; ++j) Cs[(wm * 64 + m * 16 + fq * 4 + j) * CST + wn * 64 + n * 16 + fr] = acc[m][n][j];
  __syncthreads();
}
DI void ld8(const float* Cs, float* v) {
  float4 a = *(const float4*)Cs, b = *(const float4*)(Cs + 4);
  v[0] = a.x; v[1] = a.y; v[2] = a.z; v[3] = a.w; v[4] = b.x; v[5] = b.y; v[6] = b.z; v[7] = b.w;
}

DI void prep_w(const float* __restrict__ src, int K, int N, u16* __restrict__ dst, int Npad, const float* __restrict__ g, int perm,
               u16* T) {
  const int tid = tidx();
  const int ntn = Npad >> 6, ntiles = (K >> 6) * ntn;
  for (int it = vbid(); it < ntiles; it += vgrid()) {
    const int kt = it / ntn, k0 = kt * 64, n0 = (it - kt * ntn) * 64;
    int sn0 = n0;
    if (perm) { int tl = n0 >> 7, rr = n0 & 127; sn0 = (rr < 64) ? (tl * 64 + rr) : (256 + tl * 64 + rr - 64); }
    __syncthreads();
    {
      const int nn = tid & 63, kq = tid >> 6;
      const bool valid = (n0 + nn) < N;
      float v[16];
#pragma unroll
      for (int i = 0; i < 16; ++i) v[i] = valid ? src[(size_t)(k0 + kq + 4 * i) * N + sn0 + nn] : 0.f;
      if (g) {
#pragma unroll
        for (int i = 0; i < 16; ++i) v[i] *= g[k0 + kq + 4 * i];
      }
#pragma unroll
      for (int i = 0; i < 16; ++i) T[(kq + 4 * i) * 72 + nn] = f2bf(v[i]);
    }
    __syncthreads();
    {
      const int nn = tid >> 2, kc = (tid & 3) * 16;
      unsigned w[8];
#pragma unroll
      for (int j = 0; j < 8; ++j) w[j] = (unsigned)T[(kc + 2 * j) * 72 + nn] | ((unsigned)T[(kc + 2 * j + 1) * 72 + nn] << 16);
      u32x4 o0 = {w[0], w[1], w[2], w[3]}, o1 = {w[4], w[5], w[6], w[7]};
      u16* d = dst + (size_t)(n0 + nn) * K + k0 + kc;
      *(u32x4*)d = o0; *(u32x4*)(d + 8) = o1;
    }
  }
}

DI void phase_prep(PREF p, unsigned char* ldsb) {
  u16* T = (u16*)ldsb;
  const int gtid = vbid() * 256 + tidx(), gsz = vgrid() * 256;
  for (int l = 0; l < NL; ++l) {
    u16* W = p.wts + (size_t)l * WL;
    prep_w(p.w_in + (size_t)l * 1024 * HW, 1024, HW, W + O_WIN, 2816, nullptr, 0, T);
    prep_w(p.w_merge + (size_t)l * 1024 * 4096, 1024, 4096, W + O_WM, 4096, nullptr, 0, T);
    prep_w(p.w_pw2 + (size_t)l * 65536, 256, 256, W + O_PW2, 256, nullptr, 0, T);
    prep_w(p.w_uq + (size_t)l * 256 * 384, 256, 384, W + O_UQ, 384, p.qng + l * 256, 0, T);
    prep_w(p.w_ukv + (size_t)l * 128 * 512, 128, 512, W + O_UKV, 512, p.kvng + l * 128, 0, T);
    prep_w(p.w_glu + (size_t)l * 256 * 512, 256, 512, W + O_GLU, 512, nullptr, 1, T);
    for (int nb = 0; nb < 4; ++nb)
      prep_w(p.w_branch + ((size_t)l * 4 + nb) * 256 * 1024, 256, 1024, W + O_BR + (size_t)nb * 1024 * 256, 1024, nullptr, 0, T);
    prep_w(p.w_out + (size_t)l * 1048576, 1024, 1024, W + O_OUT, 1024, nullptr, 0, T);
    prep_w(p.w_ple + (size_t)l * 262144, 256, 1024, W + O_PLE, 1024, nullptr, 0, T);
    prep_w(p.w_pleg + (size_t)l * 1048576, 1024, 1024, W + O_PLEG, 1024, nullptr, 0, T);
  }
  for (int idx = gtid; idx < NL * 16 * 64; idx += gsz) {
    int lg = idx >> 6;
    float dt = expf(p.log_dt[lg]);
    float lr = p.a_re[idx], li = p.a_im[idx];
    float mag = expf(lr * dt);
    float lbr = mag * cosf(li * dt), lbi = mag * sinf(li * dt);
    float den = lr * lr + li * li;
    float nr = lbr - 1.f, ni = lbi;
    float fre = (nr * lr + ni * li) / den, fim = (ni * lr - nr * li) / den;
    p.lam[idx * 2] = lbr; p.lam[idx * 2 + 1] = lbi;
    for (int h = 0; h < 16; ++h) {
      float br = p.b_re[(size_t)idx * 16 + h], bi = p.b_im[(size_t)idx * 16 + h];
      p.bbre[(size_t)idx * 16 + h] = fre * br - fim * bi;
      p.bbim[(size_t)idx * 16 + h] = fre * bi + fim * br;
    }
  }
  for (int idx = gtid; idx < S_ * 16; idx += gsz) {
    int pos = idx >> 4, i = idx & 15;
    float inv = powf(10000.f, -(float)(2 * i) / 32.f);
    float ang = (float)pos * inv;
    p.rcos[idx] = cosf(ang); p.rsin[idx] = sinf(ang);
  }
  for (int idx = gtid; idx < T_ * D_ / 8; idx += gsz) {
    const float4* s = (const float4*)(p.x + (size_t)idx * 8);
    float4 a = s[0], b = s[1];
    float v[8] = {a.x, a.y, a.z, a.w, b.x, b.y, b.z, b.w};
    *(u32x4*)(p.X + (size_t)idx * 8) = pack8(v);
  }
}

constexpr int G_HT = 128 * 64;
DI void lds_barrier() { asm volatile("s_waitcnt lgkmcnt(0)\n\ts_barrier" ::: "memory"); }
DI int tid512() { int t = threadIdx.x; asm volatile("" : "+v"(t)); return t; }
DI void g_stage_rc(int b, int& R, int& C) {
  int st = b >> 10, sb = b & 1023, swz = sb ^ (((sb >> 9) & 1) << 5);
  R = (st >> 1) * 16 + (swz >> 6); C = (st & 1) * 32 + ((swz & 63) >> 1);
}
#define G_SA(b, h) (shm + ((b) * 2 + (h)) * G_HT)
#define G_SB(b, h) (shm + (4 + (b) * 2 + (h)) * G_HT)
#define G_STAGE(P, BASE, O0, O1, LD, br, KOFF)                                                                             \
  do {                                                                                                                    \
    const u16* g_ = (BASE) + (size_t)(br) * (LD) + (KOFF);                                                              \
    __builtin_amdgcn_global_load_lds((const unsigned*)(g_ + (O0)), (unsigned*)((char*)(P) + t * 16), 16, 0, 0);          \
    __builtin_amdgcn_global_load_lds((const unsigned*)(g_ + (O1)), (unsigned*)((char*)(P) + t * 16 + 8192), 16, 0, 0);   \
  } while (0)
#define G_LDA(dst, b, h)                                                                                                  \
  _Pragma("unroll") for (int m = 0; m < 4; ++m) _Pragma("unroll") for (int k = 0; k < 2; ++k)                             \
      dst[m][k] = *(const bf16x8*)((const char*)G_SA(b, h) + ((wr * 4 + m) * 2 + k) * 1024 + rdo)
#define G_LDB(dst, b, h)                                                                                                  \
  _Pragma("unroll") for (int n = 0; n < 2; ++n) _Pragma("unroll") for (int k = 0; k < 2; ++k)                             \
      dst[n][k] = *(const bf16x8*)((const char*)G_SB(b, h) + ((wc * 2 + n) * 2 + k) * 1024 + rdo)
#define G_MMA(ai, bj, At, Bt)                                                                                             \
  do {                                                                                                                    \
    __builtin_amdgcn_s_setprio(1);                                                                                        \
    _Pragma("unroll") for (int m = 0; m < 4; ++m) _Pragma("unroll") for (int n = 0; n < 2; ++n)                           \
        _Pragma("unroll") for (int k = 0; k < 2; ++k) acc[ai][bj][m][n] = MFMA16(At[m][k], Bt[n][k], acc[ai][bj][m][n]);  \
    __builtin_amdgcn_s_setprio(0);                                                                                        \
  } while (0)
#define G_WAIT_V(n) asm volatile("s_waitcnt vmcnt(" #n ")" ::: "memory")
#define G_WAIT_L(n) asm volatile("s_waitcnt lgkmcnt(" #n ")" ::: "memory")
#define G_BAR __builtin_amdgcn_s_barrier()
#define G_SCHED __builtin_amdgcn_sched_barrier(0)

DI void br_flush(PREF p, f32x4 (&acc)[2][2][4][2], int slot);
template <int LDA, int LDB, int K, int MODE = 0>
DI void gemm256(f32x4 (&acc)[2][2][4][2], const u16* __restrict__ A, const u16* __restrict__ B, u16* shm, PREF p) {
#define KA(kt) ((kt) * 64)
#define KB(kt) (MODE ? (((kt) >> 2) * (1024 * LDB) + ((kt) & 3) * 64) : (kt) * 64)
  const int t = tid512();
  const int wid = t >> 6, lane = t & 63, wr = wid >> 2, wc = wid & 3, fr = lane & 15, fq = lane >> 4;
  int r0, c0, r1, c1;
  g_stage_rc(t * 16, r0, c0); g_stage_rc(t * 16 + 8192, r1, c1);
  const int oa0 = r0 * LDA + c0, oa1 = r1 * LDA + c1, ob0 = r0 * LDB + c0, ob1 = r1 * LDB + c1;
  const int obr = fr * 64 + fq * 16, rdo = obr ^ (((obr >> 9) & 1) << 5);
  bf16x8 At[4][2], B0[2][2], B1[2][2];
  constexpr int nt = K / 64;
  lds_barrier();
  G_STAGE(G_SB(0, 0), B, ob0, ob1, LDB, 0, KB(0)); G_STAGE(G_SA(0, 0), A, oa0, oa1, LDA, 0, KA(0));
  G_STAGE(G_SB(0, 1), B, ob0, ob1, LDB, 128, KB(0)); G_STAGE(G_SA(0, 1), A, oa0, oa1, LDA, 128, KA(0));
  if (wr == 1) G_BAR;
  G_WAIT_V(4); G_BAR;
  G_STAGE(G_SB(1, 0), B, ob0, ob1, LDB, 0, KB(1)); G_STAGE(G_SA(1, 0), A, oa0, oa1, LDA, 0, KA(1)); G_STAGE(G_SB(1, 1), B, ob0, ob1, LDB, 128, KB(1));
  G_WAIT_V(6); G_BAR;
  for (int tt = 0; tt < nt - 2; tt += 2) {
    G_LDB(B0, 0, 0); G_SCHED; G_LDA(At, 0, 0); G_STAGE(G_SA(1, 1), A, oa0, oa1, LDA, 128, KA(tt + 1));
    G_WAIT_L(8); G_BAR; G_WAIT_L(0); G_MMA(0, 0, At, B0); G_BAR; G_SCHED;
    G_LDB(B1, 0, 1); G_STAGE(G_SB(0, 0), B, ob0, ob1, LDB, 0, KB(tt + 2));
    G_BAR; G_WAIT_L(0); G_MMA(0, 1, At, B1); G_BAR;
    G_LDA(At, 0, 1); G_STAGE(G_SA(0, 0), A, oa0, oa1, LDA, 0, KA(tt + 2));
    G_BAR; G_WAIT_L(0); G_MMA(1, 0, At, B0); G_BAR; G_SCHED;
    G_STAGE(G_SB(0, 1), B, ob0, ob1, LDB, 128, KB(tt + 2));
    G_WAIT_V(6); G_BAR; G_MMA(1, 1, At, B1); G_BAR;
    G_LDB(B0, 1, 0); G_SCHED; G_LDA(At, 1, 0); G_STAGE(G_SA(0, 1), A, oa0, oa1, LDA, 128, KA(tt + 2));
    G_WAIT_L(8); G_BAR; G_WAIT_L(0); G_MMA(0, 0, At, B0); G_BAR; G_SCHED;
    G_LDB(B1, 1, 1); G_STAGE(G_SB(1, 0), B, ob0, ob1, LDB, 0, KB(tt + 3));
    G_BAR; G_WAIT_L(0); G_MMA(0, 1, At, B1); G_BAR;
    G_LDA(At, 1, 1); G_STAGE(G_SA(1, 0), A, oa0, oa1, LDA, 0, KA(tt + 3));
    G_BAR; G_WAIT_L(0); G_MMA(1, 0, At, B0); G_BAR; G_SCHED;
    G_STAGE(G_SB(1, 1), B, ob0, ob1, LDB, 128, KB(tt + 3));
    G_WAIT_V(6); G_BAR; G_MMA(1, 1, At, B1); G_BAR;
    if (MODE && ((tt + 1) & 3) == 3) br_flush(p, acc, (tt + 1) >> 2);
  }
  {
    G_LDB(B0, 0, 0); G_LDA(At, 0, 0); G_STAGE(G_SA(1, 1), A, oa0, oa1, LDA, 128, KA(nt - 1));
    G_BAR; G_WAIT_L(0); G_MMA(0, 0, At, B0); G_BAR;
    G_LDB(B1, 0, 1); G_BAR; G_WAIT_L(0); G_MMA(0, 1, At, B1); G_BAR;
    G_LDA(At, 0, 1); G_WAIT_V(4); G_BAR; G_WAIT_L(0); G_MMA(1, 0, At, B0); G_MMA(1, 1, At, B1); G_BAR;
  }
  {
    G_LDB(B0, 1, 0); G_LDA(At, 1, 0); G_WAIT_V(2); G_BAR; G_WAIT_L(0); G_MMA(0, 0, At, B0); G_BAR;
    G_LDB(B1, 1, 1); G_WAIT_V(0); G_BAR; G_WAIT_L(0); G_MMA(0, 1, At, B1); G_BAR;
    G_LDA(At, 1, 1); G_BAR; G_WAIT_L(0); G_MMA(1, 0, At, B0); G_MMA(1, 1, At, B1); G_BAR;
  }
  if (wr == 0) G_BAR;
#undef KA
#undef KB
}
DI void zero_acc256(f32x4 (&a)[2][2][4][2]) {
#pragma unroll
  for (int i = 0; i < 2; ++i)
#pragma unroll
    for (int j = 0; j < 2; ++j)
#pragma unroll
      for (int m = 0; m < 4; ++m)
#pragma unroll
        for (int n = 0; n < 2; ++n)
#pragma unroll
          for (int e = 0; e < 4; ++e) a[i][j][m][n][e] = 0.f;
}
template <int AI, int BJ>
DI void stage_q(const f32x4 (&acc)[2][2][4][2], float* Cs) {
  const int t = tid512(), wid = t >> 6, lane = t & 63, wr = wid >> 2, wc = wid & 3, fr = lane & 15, fq = lane >> 4;
  lds_barrier();
#pragma unroll
  for (int m = 0; m < 4; ++m)
#pragma unroll
    for (int n = 0; n < 2; ++n)
#pragma unroll
      for (int j = 0; j < 4; ++j) Cs[(wr * 64 + m * 16 + fq * 4 + j) * CST + wc * 32 + n * 16 + fr] = acc[AI][BJ][m][n][j];
  lds_barrier();
}
DI bool xcd_tile256(int k, int NT, int& m, int& n) {
  const int x = blockIdx.x & 7, slots = gridDim.x >> 3;
  const int idx = (int)(blockIdx.x >> 3) + slots * k;
  if (idx >= 16 * NT) return false;
  const int mg = idx / (8 * NT), rem = idx - mg * 8 * NT;
  n = rem >> 3; m = x * 16 + mg * 8 + (rem & 7);
  return true;
}

DI bool xcd_tile(int k, int NT, int& m, int& n) {
  const int x = (vbid() >> 1) & 7, slots = vgrid() >> 3;
  const int idx = (((vbid() >> 4) << 1) | (vbid() & 1)) + slots * k;
  if (idx >= 32 * NT) return false;
  const int mg = idx / (8 * NT), rem = idx - mg * 8 * NT;
  n = rem >> 3; m = x * 32 + mg * 8 + (rem & 7);
  return true;
}

template <int AI, int BJ>
DI void in_quadrant(PREF p, const f32x4 (&acc)[2][2][4][2], int mt, int nt, float* Cs) {
  const int t = tid512();
  const int row0 = mt * 256 + AI * 128, col0 = nt * 256 + BJ * 128;
  if (col0 >= HW) return;
  stage_q<AI, BJ>(acc, Cs);
#pragma unroll
  for (int q = 0; q < 4; ++q) {
    int r = (t >> 4) + 32 * q, c = (t & 15) * 8;
    if (col0 + c < HW) {
      float v[8]; ld8(Cs + r * CST + c, v);
      *(u32x4*)(p.hb + (size_t)(row0 + r) * HW + col0 + c) = pack8(v);
    }
  }
  if (col0 + 128 > OFF_SV && col0 < OFF_SV + 128) {
    int b = row0 >> 12, s0 = row0 & 4095;
#pragma unroll
    for (int q = 0; q < 4; ++q) {
      int item = t + 512 * q; int c = item & 127, rg = item >> 7;
      int vc = col0 + c - OFF_SV;
      if (vc >= 0 && vc < 128) {
        float v[8];
#pragma unroll
        for (int j = 0; j < 8; ++j) v[j] = Cs[(rg * 8 + j) * CST + c];
        *(u32x4*)(p.Vst + ((size_t)(b * 2 + (vc >> 6)) * 64 + (vc & 63)) * S_ + s0 + rg * 8) = pack8(v);
      }
    }
  }
}
DI void phase_in(PREF p, int l, unsigned char* lds_all) {
  u16* shm = (u16*)lds_all; float* Cs = (float*)lds_all;
  const int tid = tidx();
  const u16* W = p.wts + (size_t)l * WL + O_WIN;
  for (int k = 0;; ++k) {
    int mt, nt;
    if (!xcd_tile256(k, 11, mt, nt)) break;
    f32x4 acc[2][2][4][2]; zero_acc256(acc);
    gemm256<1024, 1024, 1024>(acc, p.X + (size_t)mt * 256 * 1024, W + (size_t)nt * 256 * 1024, shm, p);
    in_quadrant<0, 0>(p, acc, mt, nt, Cs); in_quadrant<0, 1>(p, acc, mt, nt, Cs);
    in_quadrant<1, 0>(p, acc, mt, nt, Cs); in_quadrant<1, 1>(p, acc, mt, nt, Cs);
  }
  __syncthreads();
  const int gtid = vbid() * 256 + tid, gsz = vgrid() * 256;
  const float* ps = p.p + (size_t)l * T_ * 256;
  for (int idx = gtid; idx < T_ * 256 / 8; idx += gsz) {
    const float4* s = (const float4*)(ps + (size_t)idx * 8);
    float4 a = s[0], b = s[1];
    float v[8] = {a.x, a.y, a.z, a.w, b.x, b.y, b.z, b.w};
    *(u32x4*)(p.pb + (size_t)idx * 8) = pack8(v);
  }
}

template <int DQK, bool WIN>
DI void attn_item(const u16* __restrict__ Qb, int ldq, const u16* __restrict__ Kb, int ldk, const u16* __restrict__ Vtb, int qb,
                  float qscale, float sink2, const u16* __restrict__ zb, int ldz, u16* __restrict__ ob, int ldo, u16* lds) {
  constexpr int KST = DQK + 8, NKS = DQK / 16, KCH = DQK / 8;
  constexpr int KBUF = 64 * KST, VBUF = 64 * 72, STG = KBUF + VBUF;
  constexpr int NKL = (64 * KCH) / 256;
  const int tid = tidx(), lane = tid & 63, w = tid >> 6, r = lane & 31, hh = lane >> 5;
  const int q0 = qb * 128 + w * 32;
  const int qrow = q0 + r;
  bf16x8 qf[NKS];
#pragma unroll
  for (int s = 0; s < NKS; ++s) qf[s] = *(const bf16x8*)(Qb + (size_t)qrow * ldq + 16 * s + 8 * hh);
  const int kt_lo = WIN ? (qb > 0 ? 2 * qb - 2 : 0) : 0;
  const int kt_hi = 2 * qb + 1;
  f32x16 o[2];
#pragma unroll
  for (int i = 0; i < 16; ++i) { o[0][i] = 0.f; o[1][i] = 0.f; }
  float m = WIN ? sink2 : -1e30f;
  float lsum = (WIN && hh == 0) ? 1.f : 0.f;
  u32x4 rkA[NKL], rvA[2], rkB[NKL], rvB[2];
  auto gload = [&](u32x4 (&rk)[NKL], u32x4 (&rv)[2], int kt) {
#pragma unroll
    for (int i = 0; i < NKL; ++i) {
      int id = tid + 256 * i; int row = id / KCH, ch = id % KCH;
      rk[i] = *(const u32x4*)(Kb + (size_t)(kt * 64 + row) * ldk + ch * 8);
    }
#pragma unroll
    for (int i = 0; i < 2; ++i) {
      int id = tid + 256 * i; int row = id >> 3, ch = id & 7;
      rv[i] = *(const u32x4*)(Vtb + (size_t)row * S_ + kt * 64 + ch * 8);
    }
  };
  auto swrite = [&](const u32x4 (&rk)[NKL], const u32x4 (&rv)[2], int buf) {
    u16* ks = lds + buf * STG; u16* vs = ks + KBUF;
#pragma unroll
    for (int i = 0; i < NKL; ++i) {
      int id = tid + 256 * i; int row = id / KCH, ch = id % KCH;
      *(u32x4*)(ks + row * KST + ch * 8) = rk[i];
    }
#pragma unroll
    for (int i = 0; i < 2; ++i) {
      int id = tid + 256 * i; int row = id >> 3, ch = id & 7;
      u16* d = vs + row * 72 + (ch >> 1) * 16 + (ch & 1) * 4;
      u32x2 lo = {rv[i].x, rv[i].y}, hi = {rv[i].z, rv[i].w};
      *(u32x2*)d = lo; *(u32x2*)(d + 8) = hi;
    }
  };
  auto tile_body = [&](int kt, int buf, auto mask_tag) {
    constexpr bool MASK = decltype(mask_tag)::value;
    const u16* ks = lds + buf * STG; const u16* vs = ks + KBUF;
    const int k0 = kt * 64;
    bool active = (k0 <= q0 + 31);
    if (WIN) active = active && (k0 + 63 >= q0 - 127);
    if (active) {
      f32x16 st[2];
#pragma unroll
      for (int kb = 0; kb < 2; ++kb) {
#pragma unroll
        for (int i = 0; i < 16; ++i) st[kb][i] = 0.f;
#pragma unroll
        for (int s = 0; s < NKS; ++s) {
          bf16x8 a = *(const bf16x8*)(ks + (kb * 32 + r) * KST + 16 * s + 8 * hh);
          st[kb] = MFMA32(a, qf[s], st[kb]);
        }
      }
      float mx = -INFINITY;
#pragma unroll
      for (int kb = 0; kb < 2; ++kb)
#pragma unroll
        for (int i = 0; i < 16; ++i) {
          float v = st[kb][i];
          if (MASK) {
            int kg = k0 + kb * 32 + (i & 3) + 8 * (i >> 2) + 4 * hh;
            bool ok = kg <= qrow;
            if (WIN) ok = ok && (qrow - kg < 128);
            v = ok ? v : -INFINITY;
            st[kb][i] = v;
          }
          mx = fmaxf(mx, v);
        }
      mx = fmaxf(mx, __shfl_xor(mx, 32));
      const float mn = fmaxf(m, mx);
      if (__any(mn != m)) {
        const float alpha = __builtin_amdgcn_exp2f((m - mn) * qscale);
        lsum *= alpha;
#pragma unroll
        for (int i = 0; i < 16; ++i) { o[0][i] *= alpha; o[1][i] *= alpha; }
      }
      m = mn;
      const float nb = -mn * qscale;
      float ps = 0.f;
#pragma unroll
      for (int kb = 0; kb < 2; ++kb)
#pragma unroll
        for (int i = 0; i < 16; ++i) { float pv = __builtin_amdgcn_exp2f(fmaf(st[kb][i], qscale, nb)); st[kb][i] = pv; ps += pv; }
      lsum += ps;
#pragma unroll
      for (int kb = 0; kb < 2; ++kb)
#pragma unroll
        for (int s2 = 0; s2 < 2; ++s2) {
          union { bf16x8 v; unsigned u[4]; } pf;
#pragma unroll
          for (int j = 0; j < 4; ++j) pf.u[j] = pack2(st[kb][8 * s2 + 2 * j], st[kb][8 * s2 + 2 * j + 1]);
#pragma unroll
          for (int vb = 0; vb < 2; ++vb) {
            const bf16x8 vf = *(const bf16x8*)(vs + (vb * 32 + r) * 72 + (kb * 2 + s2) * 16 + hh * 8);
            o[vb] = MFMA32(vf, pf.v, o[vb]);
          }
        }
    }
  };
  __syncthreads();
  gload(rkA, rvA, kt_lo);
  gload(rkB, rvB, kt_lo + 1);
  swrite(rkA, rvA, 0);
  __syncthreads();
  for (int kt = kt_lo; kt <= kt_hi; kt += 2) {
    if (kt + 2 <= kt_hi) gload(rkA, rvA, kt + 2);
    if (WIN || kt >= 2 * qb) tile_body(kt, 0, std::true_type{}); else tile_body(kt, 0, std::false_type{});
    swrite(rkB, rvB, 1);
    __syncthreads();
    if (kt + 3 <= kt_hi) gload(rkB, rvB, kt + 3);
    if (WIN || kt + 1 >= 2 * qb) tile_body(kt + 1, 1, std::true_type{}); else tile_body(kt + 1, 1, std::false_type{});
    if (kt + 2 <= kt_hi) swrite(rkA, rvA, 0);
    __syncthreads();
  }
  float lt = lsum + __shfl_xor(lsum, 32);
  float inv = 1.f / lt;
  u32x2 zr[8];
#pragma unroll
  for (int e = 0; e < 8; ++e) zr[e] = *(const u32x2*)(zb + (size_t)qrow * ldz + (e >> 2) * 32 + 8 * (e & 3) + 4 * hh);
#pragma unroll
  for (int vb = 0; vb < 2; ++vb)
#pragma unroll
    for (int g4 = 0; g4 < 4; ++g4) {
      int vd0 = vb * 32 + 8 * g4 + 4 * hh;
      u32x2 z = zr[vb * 4 + g4];
      float a0 = o[vb][4 * g4 + 0] * inv * silu(lo2f(z.x));
      float a1 = o[vb][4 * g4 + 1] * inv * silu(hi2f(z.x));
      float a2 = o[vb][4 * g4 + 2] * inv * silu(lo2f(z.y));
      float a3 = o[vb][4 * g4 + 3] * inv * silu(hi2f(z.y));
      u32x2 ov; ov.x = pack2(a0, a1); ov.y = pack2(a2, a3);
      *(u32x2*)(ob + (size_t)qrow * ldo + vd0) = ov;
    }
}

DI void conv_item(PREF p, int l, int tile, unsigned char* ldsb) {
  float* Gs = (float*)ldsb;
  const int tid = tidx(), lane = tid & 63, w = tid >> 6;
  const int t0 = tile * 32, s0 = t0 & 4095;
  __syncthreads();
  for (int id = tid; id < 62 * 32; id += 256) {
    int rr = id >> 5, ch = (id & 31) * 8;
    int s = s0 - 30 + rr;
    float v[8];
#pragma unroll
    for (int j = 0; j < 8; ++j) v[j] = 0.f;
    if (s >= 0) {
      const u16* src = p.hb + (size_t)(t0 - 30 + rr) * HW + ch;
      float a[8], g[8];
      unpack8(*(const u32x4*)(src + OFF_AVAL), a);
      unpack8(*(const u32x4*)(src + OFF_AGATE), g);
#pragma unroll
      for (int j = 0; j < 8; ++j) v[j] = a[j] * sigm(g[j]);
    }
    *(float4*)(Gs + rr * 256 + ch) = make_float4(v[0], v[1], v[2], v[3]);
    *(float4*)(Gs + rr * 256 + ch + 4) = make_float4(v[4], v[5], v[6], v[7]);
  }
  __syncthreads();
  {
    const int c = tid;
    float wv[31];
#pragma unroll
    for (int j = 0; j < 31; ++j) wv[j] = p.conv_w[((size_t)l * 31 + j) * 256 + c];
    const float bias = p.conv_b[l * 256 + c];
    for (int tt = 0; tt < 32; ++tt) {
      float acc = bias;
#pragma unroll
      for (int j = 0; j < 31; ++j) acc += wv[j] * Gs[(tt + j) * 256 + c];
      Gs[tt * 256 + c] = acc;
    }
  }
  __syncthreads();
  const float4 gg = *(const float4*)(p.conv_ng + l * 256 + lane * 4);
  const float4 bb = *(const float4*)(p.conv_nb + l * 256 + lane * 4);
  for (int q = 0; q < 8; ++q) {
    int tt = w * 8 + q;
    float4 v = *(const float4*)(Gs + tt * 256 + lane * 4);
    float mu = wsum(v.x + v.y + v.z + v.w) * (1.f / 256.f);
    float d0 = v.x - mu, d1 = v.y - mu, d2 = v.z - mu, d3 = v.w - mu;
    float var = wsum(d0 * d0 + d1 * d1 + d2 * d2 + d3 * d3) * (1.f / 256.f);
    float rs = rsqrtf(var + 1e-5f);
    float y0 = silu(d0 * rs * gg.x + bb.x), y1 = silu(d1 * rs * gg.y + bb.y);
    float y2 = silu(d2 * rs * gg.z + bb.z), y3 = silu(d3 * rs * gg.w + bb.w);
    u32x2 ov; ov.x = pack2(y0, y1); ov.y = pack2(y2, y3);
    *(u32x2*)(p.cA + (size_t)(t0 + tt) * 256 + lane * 4) = ov;
  }
}

DI void ssm_stage_u(PREF p, int b, int c, int gq, float* uS) {
  const int tid = tidx();
  int row = tid >> 2, cc = (tid & 3) * 16;
  const u16* src = p.hb + (size_t)(b * S_ + c * 64 + row) * HW + OFF_U + gq * 64 + cc;
  float f[16];
  unpack8(*(const u32x4*)src, f); unpack8(*(const u32x4*)(src + 8), f + 8);
#pragma unroll
  for (int j = 0; j < 4; ++j) *(float4*)(uS + row * 64 + cc + 4 * j) = make_float4(f[4 * j], f[4 * j + 1], f[4 * j + 2], f[4 * j + 3]);
}
#define SSM_STEP(t)                                                                                                        \
  {                                                                                                                        \
    const float4* up = (const float4*)(uS + (t) * 64 + w * 16);                                                            \
    float4 u0 = up[0], u1 = up[1], u2 = up[2], u3 = up[3];                                                                 \
    float uu[16] = {u0.x, u0.y, u0.z, u0.w, u1.x, u1.y, u1.z, u1.w, u2.x, u2.y, u2.z, u2.w, u3.x, u3.y, u3.z, u3.w};       \
    float bur = 0.f, bui = 0.f;                                                                                            \
    _Pragma("unroll") for (int j = 0; j < 16; ++j) { bur += bre[j] * uu[j]; bui += bim[j] * uu[j]; }                       \
    float nr = lr * hr - li * hi + bur, ni = lr * hi + li * hr + bui;                                                      \
    hr = nr; hi = ni;                                                                                                      \
  }

DI void ssm1_item(PREF p, int l, int item, unsigned char* ldsb) {
  const int gq = item & 3, c = (item >> 2) & 63, b = item >> 8;
  const int tid = tidx(), w = tid >> 6, lane = tid & 63;
  const int g = gq * 4 + w;
  float* uS = (float*)ldsb;
  __syncthreads();
  ssm_stage_u(p, b, c, gq, uS);
  __syncthreads();
  const size_t pi = (size_t)(l * 16 + g) * 64 + lane;
  float bre[16], bim[16];
#pragma unroll
  for (int j = 0; j < 16; ++j) { bre[j] = p.bbre[pi * 16 + j]; bim[j] = p.bbim[pi * 16 + j]; }
  const float lr = p.lam[pi * 2], li = p.lam[pi * 2 + 1];
  float hr = 0.f, hi = 0.f;
  for (int t = 0; t < 64; ++t) SSM_STEP(t)
  ((float2*)p.hend)[((size_t)(b * 16 + g) * 64 + c) * 64 + lane] = make_float2(hr, hi);
}

DI void ssm2_item(PREF p, int l, int item, unsigned char* ldsb) {
  const int gq = item & 3, c = (item >> 2) & 63, b = item >> 8;
  const int tid = tidx(), w = tid >> 6, lane = tid & 63;
  const int g = gq * 4 + w;
  float* uS = (float*)ldsb;
  u16* Hs = (u16*)(ldsb + 16384) + w * (16 * 136);
  __syncthreads();
  ssm_stage_u(p, b, c, gq, uS);
  __syncthreads();
  const size_t pi = (size_t)(l * 16 + g) * 64 + lane;
  float bre[16], bim[16];
#pragma unroll
  for (int j = 0; j < 16; ++j) { bre[j] = p.bbre[pi * 16 + j]; bim[j] = p.bbim[pi * 16 + j]; }
  const float lr = p.lam[pi * 2], li = p.lam[pi * 2 + 1];
  float pr = lr, pim = li;
#pragma unroll
  for (int q = 0; q < 6; ++q) { float a = pr * pr - pim * pim, bq = 2.f * pr * pim; pr = a; pim = bq; }
  float hr = 0.f, hi = 0.f;
  const float2* he = (const float2*)p.hend + ((size_t)(b * 16 + g) * 64) * 64 + lane;
  {
    for (int cc = 0; cc < c; cc += 16) {
      f32x2 e[16];
#pragma unroll
      for (int u = 0; u < 16; ++u) {
        if (cc + u < c) e[u] = *(const f32x2*)(he + (size_t)(cc + u) * 64);
      }
#pragma unroll
      for (int u = 0; u < 16; ++u) {
        if (cc + u < c) {
          float nr = pr * hr - pim * hi + e[u][0], ni = pr * hi + pim * hr + e[u][1];
          hr = nr; hi = ni;
        }
      }
    }
  }
  const int hcol = lane & 15, q4 = lane >> 4;
  bf16x8 cf[4];
  {
    const float* cre = p.c_re + ((size_t)(l * 16 + g) * 16 + hcol) * 64;
    const float* cim = p.c_im + ((size_t)(l * 16 + g) * 16 + hcol) * 64;
#pragma unroll
    for (int ks = 0; ks < 4; ++ks) {
      float v[8];
#pragma unroll
      for (int j = 0; j < 8; ++j) {
        int k = 32 * ks + 8 * q4 + j;
        v[j] = (k & 1) ? -cim[k >> 1] : cre[k >> 1];
      }
      union { bf16x8 v8; u32x4 u; } cv; cv.u = pack8(v); cf[ks] = cv.v8;
    }
  }
  const float dch = p.ssm_d[l * 256 + g * 16 + hcol];
  for (int sub = 0; sub < 4; ++sub) {
    for (int tt = 0; tt < 16; ++tt) {
      SSM_STEP(sub * 16 + tt)
      *(unsigned*)(Hs + tt * 136 + 2 * lane) = pack2(hr, hi);
    }
    __syncthreads();
    f32x4 acc = {0.f, 0.f, 0.f, 0.f};
#pragma unroll
    for (int ks = 0; ks < 4; ++ks) {
      bf16x8 a = *(const bf16x8*)(Hs + hcol * 136 + 32 * ks + 8 * q4);
      acc = MFMA16(a, cf[ks], acc);
    }
#pragma unroll
    for (int j = 0; j < 4; ++j) {
      int t = sub * 16 + 4 * q4 + j;
      float uu = uS[t * 64 + w * 16 + hcol];
      float yv = gelu_t(acc[j] + dch * uu);
      p.yss[(size_t)(b * S_ + c * 64 + t) * 256 + g * 16 + hcol] = f2bf(yv);
    }
    __syncthreads();
  }
}

DI void q_tile(PREF p, int l, int idx, unsigned char* ldsb) {
  u16* lds = (u16*)ldsb; float* Cs = (float*)ldsb; float* aux = (float*)(ldsb + LDS_MAIN);
  const int tid = tidx();
  const int mt = idx / 3, nt = idx % 3;
  const int row0 = mt * 128, col0 = nt * 128;
  __syncthreads();
  if (tid < 128) {
    const u16* src = p.hb + (size_t)(row0 + tid) * HW + OFF_CQ;
    float ss = 0.f;
    for (int i = 0; i < 32; ++i) { float f[8]; unpack8(*(const u32x4*)(src + i * 8), f);
#pragma unroll
      for (int j = 0; j < 8; ++j) ss += f[j] * f[j]; }
    aux[tid] = rsqrtf(ss * (1.f / 256.f) + 1e-6f);
  }
  f32x4 acc[4][4]; zero_acc(acc);
  gemm_main(acc, p.hb + (size_t)row0 * HW + OFF_CQ, HW, p.wts + (size_t)l * WL + O_UQ + (size_t)col0 * 256, 256, 256, lds);
  stage_c(acc, Cs);
#pragma unroll
  for (int q = 0; q < 8; ++q) {
    int r = (tid >> 4) + 16 * q, c = (tid & 15) * 8;
    int n = col0 + c; int dd = n % 96;
    float rs = aux[r];
    float v[8]; ld8(Cs + r * CST + c, v);
#pragma unroll
    for (int j = 0; j < 8; ++j) v[j] *= rs;
    if (dd >= 64) {
      int ri0 = dd - 64; int s = (row0 + r) & 4095;
      float pv[8];
      if (ri0 < 16) {
        ld8(Cs + r * CST + c + 16, pv);
        const float* cs = p.rcos + s * 16 + ri0; const float* sn = p.rsin + s * 16 + ri0;
#pragma unroll
        for (int j = 0; j < 8; ++j) v[j] = v[j] * cs[j] - pv[j] * rs * sn[j];
      } else {
        ld8(Cs + r * CST + c - 16, pv);
        const float* cs = p.rcos + s * 16 + ri0 - 16; const float* sn = p.rsin + s * 16 + ri0 - 16;
#pragma unroll
        for (int j = 0; j < 8; ++j) v[j] = v[j] * cs[j] + pv[j] * rs * sn[j];
      }
    }
    *(u32x4*)(p.Qm + (size_t)(row0 + r) * 384 + n) = pack8(v);
  }
}

DI void kv_tile(PREF p, int l, int idx, unsigned char* ldsb) {
  u16* lds = (u16*)ldsb; float* Cs = (float*)ldsb; float* aux = (float*)(ldsb + LDS_MAIN);
  const int tid = tidx();
  const int mt = idx >> 2, head = idx & 3;
  const int row0 = mt * 128;
  __syncthreads();
  if (tid < 128) {
    const u16* src = p.hb + (size_t)(row0 + tid) * HW + OFF_CKV;
    float ss = 0.f;
    for (int i = 0; i < 16; ++i) { float f[8]; unpack8(*(const u32x4*)(src + i * 8), f);
#pragma unroll
      for (int j = 0; j < 8; ++j) ss += f[j] * f[j]; }
    aux[tid] = rsqrtf(ss * (1.f / 128.f) + 1e-6f);
  }
  f32x4 acc[4][4]; zero_acc(acc);
  gemm_main(acc, p.hb + (size_t)row0 * HW + OFF_CKV, HW, p.wts + (size_t)l * WL + O_UKV + (size_t)head * 128 * 128, 128, 128, lds);
  stage_c(acc, Cs);
#pragma unroll
  for (int q = 0; q < 4; ++q) {
    int r = (tid >> 3) + 32 * q, c = (tid & 7) * 8;
    float rs = aux[r];
    float v[8]; ld8(Cs + r * CST + c, v);
#pragma unroll
    for (int j = 0; j < 8; ++j) v[j] *= rs;
    *(u32x4*)(p.Km + (size_t)(row0 + r) * 384 + head * 96 + c) = pack8(v);
  }
  {
    int b = row0 >> 12, s0 = row0 & 4095;
#pragma unroll
    for (int q = 0; q < 4; ++q) {
      int item = tid + 256 * q; int c = item & 63, rg = item >> 6;
      float v[8];
#pragma unroll
      for (int j = 0; j < 8; ++j) v[j] = Cs[(rg * 8 + j) * CST + 64 + c] * aux[rg * 8 + j];
      *(u32x4*)(p.Vmt + ((size_t)(b * 4 + head) * 64 + c) * S_ + s0 + rg * 8) = pack8(v);
    }
  }
  {
    int r = tid >> 1, half = tid & 1;
    int t = row0 + r, s = t & 4095;
    const u16* src = p.hb + (size_t)t * HW + OFF_KR;
    float x1[16], x2[16];
    unpack8(*(const u32x4*)(src), x1); unpack8(*(const u32x4*)(src + 8), x1 + 8);
    unpack8(*(const u32x4*)(src + 16), x2); unpack8(*(const u32x4*)(src + 24), x2 + 8);
    const float* cs = p.rcos + s * 16; const float* sn = p.rsin + s * 16;
    float ov[16];
#pragma unroll
    for (int i = 0; i < 16; ++i) ov[i] = half ? (x2[i] * cs[i] + x1[i] * sn[i]) : (x1[i] * cs[i] - x2[i] * sn[i]);
    u16* dst = p.Km + (size_t)t * 384 + head * 96 + 64 + half * 16;
    *(u32x4*)dst = pack8(ov); *(u32x4*)(dst + 8) = pack8(ov + 8);
  }
}

DI void pw2_tile(PREF p, int l, int idx, unsigned char* ldsb) {
  u16* lds = (u16*)ldsb; float* Cs = (float*)ldsb;
  const int tid = tidx();
  const int mt = idx >> 1, nt = idx & 1;
  const int row0 = mt * 128, col0 = nt * 128;
  f32x4 acc[4][4]; zero_acc(acc);
  gemm_main(acc, p.cA + (size_t)row0 * 256, 256, p.wts + (size_t)l * WL + O_PW2 + (size_t)col0 * 256, 256, 256, lds);
  stage_c(acc, Cs);
  u32x4 zr[8];
#pragma unroll
  for (int q = 0; q < 8; ++q) zr[q] = *(const u32x4*)(p.hb + (size_t)(row0 + (tid >> 4) + 16 * q) * HW + OFF_AZ + col0 + (tid & 15) * 8);
#pragma unroll
  for (int q = 0; q < 8; ++q) {
    int r = (tid >> 4) + 16 * q, c = (tid & 15) * 8;
    float v[8]; ld8(Cs + r * CST + c, v);
    float z[8]; unpack8(zr[q], z);
#pragma unroll
    for (int j = 0; j < 8; ++j) v[j] *= silu(z[j]);
    *(u32x4*)(p.ys + (size_t)(row0 + r) * 1024 + col0 + c) = pack8(v);
  }
}

DI void glu_tile(PREF p, int l, int idx, unsigned char* ldsb) {
  u16* lds = (u16*)ldsb; float* Cs = (float*)ldsb;
  const int tid = tidx();
  const int mt = idx >> 2, nt = idx & 3;
  const int row0 = mt * 128;
  f32x4 acc[4][4]; zero_acc(acc);
  gemm_main(acc, p.yss + (size_t)row0 * 256, 256, p.wts + (size_t)l * WL + O_GLU + (size_t)nt * 128 * 256, 256, 256, lds);
  stage_c(acc, Cs);
  u32x4 zr[4];
#pragma unroll
  for (int q = 0; q < 4; ++q) zr[q] = *(const u32x4*)(p.hb + (size_t)(row0 + (tid >> 3) + 32 * q) * HW + OFF_CZ + nt * 64 + (tid & 7) * 8);
#pragma unroll
  for (int q = 0; q < 4; ++q) {
    int r = (tid >> 3) + 32 * q, c = (tid & 7) * 8;
    float v[8], g[8]; ld8(Cs + r * CST + c, v); ld8(Cs + r * CST + 64 + c, g);
    float z[8]; unpack8(zr[q], z);
#pragma unroll
    for (int j = 0; j < 8; ++j) v[j] = v[j] * sigm(g[j]) * silu(z[j]);
    *(u32x4*)(p.ys + (size_t)(row0 + r) * 1024 + 512 + nt * 64 + c) = pack8(v);
  }
}

template <int AI, int BJ>
DI void glu_quadrant(PREF p, const f32x4 (&acc)[2][2][4][2], int mt, int nt, float* Cs) {
  const int t = tid512();
  const int row0 = mt * 256 + AI * 128, oc0 = (nt * 2 + BJ) * 64, c = (t & 7) * 8;
  u32x4 zr[2];
#pragma unroll
  for (int q = 0; q < 2; ++q) zr[q] = *(const u32x4*)(p.hb + (size_t)(row0 + (t >> 3) + 64 * q) * HW + OFF_CZ + oc0 + c);
  stage_q<AI, BJ>(acc, Cs);
#pragma unroll
  for (int q = 0; q < 2; ++q) {
    const int r = (t >> 3) + 64 * q;
    float v[8], g[8]; ld8(Cs + r * CST + c, v); ld8(Cs + r * CST + 64 + c, g);
    float z[8]; unpack8(zr[q], z);
#pragma unroll
    for (int j = 0; j < 8; ++j) v[j] = v[j] * sigm(g[j]) * silu(z[j]);
    *(u32x4*)(p.ys + (size_t)(row0 + r) * 1024 + 512 + oc0 + c) = pack8(v);
  }
}
DI void glu_phase(PREF p, int l, unsigned char* lds_all) {
  u16* shm = (u16*)lds_all; float* Cs = (float*)lds_all;
  for (int it = blockIdx.x; it < 256; it += gridDim.x) {
    const int mt = it >> 1, nt = it & 1;
    f32x4 acc[2][2][4][2]; zero_acc256(acc);
    gemm256<256, 256, 256>(acc, p.yss + (size_t)mt * 256 * 256, p.wts + (size_t)l * WL + O_GLU + (size_t)nt * 256 * 256, shm, p);
    glu_quadrant<0, 0>(p, acc, mt, nt, Cs); glu_quadrant<0, 1>(p, acc, mt, nt, Cs);
    glu_quadrant<1, 0>(p, acc, mt, nt, Cs); glu_quadrant<1, 1>(p, acc, mt, nt, Cs);
  }
  __syncthreads();
}

DI u32x4* merge_scratch(PREF p, int region) { const int t = tid512(); return (u32x4*)p.fbuf + (size_t)blockIdx.x * 40960 + region * 8192 + (t >> 6) * 1024 + (t & 63); }
DI void br_store(PREF p, const f32x4 (&acc)[2][2][4][2], int slot) {
  u32x4* sb = merge_scratch(p, slot);
#pragma unroll
  for (int ai = 0; ai < 2; ++ai)
#pragma unroll
    for (int bj = 0; bj < 2; ++bj)
#pragma unroll
      for (int m = 0; m < 4; ++m) {
        u32x4 o;
        o.x = pack2(acc[ai][bj][m][0][0], acc[ai][bj][m][0][1]); o.y = pack2(acc[ai][bj][m][0][2], acc[ai][bj][m][0][3]);
        o.z = pack2(acc[ai][bj][m][1][0], acc[ai][bj][m][1][1]); o.w = pack2(acc[ai][bj][m][1][2], acc[ai][bj][m][1][3]);
        sb[((ai * 2 + bj) * 4 + m) * 64] = o;
      }
}
DI void br_flush(PREF p, f32x4 (&acc)[2][2][4][2], int slot) { br_store(p, acc, slot); zero_acc256(acc); }
DI void gate_reg(PREF p, int l, int n, f32x4 (&acc)[2][2][4][2], int dt) {
  const u32x4* sbn = merge_scratch(p, n);
  u32x4* ssum = merge_scratch(p, 4);
  const int t = tid512(), wid = t >> 6, lane = t & 63, wc = wid & 3, fr = lane & 15;
  const float* bm = p.b_merge + (size_t)l * 4096 + n * 1024 + dt * 256 + wc * 32 + fr;
  float bias[2][2];
#pragma unroll
  for (int bj = 0; bj < 2; ++bj)
#pragma unroll
    for (int nn = 0; nn < 2; ++nn) bias[bj][nn] = bm[bj * 128 + nn * 16];
#pragma unroll
  for (int ai = 0; ai < 2; ++ai)
#pragma unroll
    for (int bj = 0; bj < 2; ++bj) {
      __builtin_amdgcn_sched_barrier(0);
      u32x4 bn[4], pv[4];
#pragma unroll
      for (int m = 0; m < 4; ++m) {
        bn[m] = sbn[((ai * 2 + bj) * 4 + m) * 64];
        if (n > 0) pv[m] = ssum[((ai * 2 + bj) * 4 + m) * 64];
      }
#pragma unroll
      for (int m = 0; m < 4; ++m) {
        float b[8]; unpack8(bn[m], b);
        float v[8];
#pragma unroll
        for (int nn = 0; nn < 2; ++nn)
#pragma unroll
          for (int j = 0; j < 4; ++j) v[nn * 4 + j] = sigm(acc[ai][bj][m][nn][j] + bias[bj][nn]) * b[nn * 4 + j];
        if (n > 0) {
          float o[8]; unpack8(pv[m], o);
#pragma unroll
          for (int e = 0; e < 8; ++e) v[e] += o[e];
        }
        if (n < 3) ssum[((ai * 2 + bj) * 4 + m) * 64] = pack8(v);
#pragma unroll
        for (int nn = 0; nn < 2; ++nn)
#pragma unroll
          for (int j = 0; j < 4; ++j) acc[ai][bj][m][nn][j] = v[nn * 4 + j];
      }
    }
}
template <int AI, int BJ>
DI void mg_quadrant(PREF p, const f32x4 (&acc)[2][2][4][2], int mt, int dt, float* Cs) {
  const int t = tid512();
  const int row0 = mt * 256 + AI * 128, col0 = dt * 256 + BJ * 128;
  stage_q<AI, BJ>(acc, Cs);
#pragma unroll
  for (int q = 0; q < 4; ++q) {
    int r = (t >> 4) + 32 * q, c = (t & 15) * 8;
    float v[8]; ld8(Cs + r * CST + c, v);
    *(u32x4*)(p.mg + (size_t)(row0 + r) * 1024 + col0 + c) = pack8(v);
  }
}
DI void merge_phase(PREF p, int l, unsigned char* lds_all) {
  u16* shm = (u16*)lds_all; float* Cs = (float*)lds_all;
  const u16* W = p.wts + (size_t)l * WL;
  for (int k = 0;; ++k) {
    int mt, dt;
    if (!xcd_tile256(k, 4, mt, dt)) break;
    {
      f32x4 acc[2][2][4][2]; zero_acc256(acc);
      gemm256<1024, 256, 1024, 1>(acc, p.ys + (size_t)mt * 256 * 1024, W + O_BR + (size_t)dt * 256 * 256, shm, p);
      br_store(p, acc, 3);
    }
#pragma unroll 1
    for (int n = 0; n < 4; ++n) {
      f32x4 acc[2][2][4][2]; zero_acc256(acc);
      gemm256<1024, 1024, 1024>(acc, p.X + (size_t)mt * 256 * 1024, W + O_WM + ((size_t)n * 1024 + dt * 256) * 1024, shm, p);
      gate_reg(p, l, n, acc, dt);
      if (n == 3) {
        mg_quadrant<0, 0>(p, acc, mt, dt, Cs); mg_quadrant<0, 1>(p, acc, mt, dt, Cs);
        mg_quadrant<1, 0>(p, acc, mt, dt, Cs); mg_quadrant<1, 1>(p, acc, mt, dt, Cs);
      }
    }
  }
  __syncthreads();
}

template <int AI, int BJ>
DI void f1_load(PREF p, int l, int mt, int dt, float4 (&xa)[4], float4 (&xb)[4]) {
  const int t = tid512();
  const int row0 = mt * 256 + AI * 128, col0 = dt * 256 + BJ * 128, c = (t & 15) * 8;
  if (l == 0) {
#pragma unroll
    for (int q = 0; q < 4; ++q) {
      const float4* xs = (const float4*)(p.x + (size_t)(row0 + (t >> 4) + 32 * q) * 1024 + col0 + c);
      xa[q] = xs[0]; xb[q] = xs[1];
    }
  } else {
#pragma unroll
    for (int q = 0; q < 4; ++q) {
      float f[8]; unpack8(*(const u32x4*)(p.X + (size_t)(row0 + (t >> 4) + 32 * q) * 1024 + col0 + c), f);
      xa[q] = make_float4(f[0], f[1], f[2], f[3]); xb[q] = make_float4(f[4], f[5], f[6], f[7]);
    }
  }
}
template <int AI, int BJ>
DI void f1_proc(PREF p, const f32x4 (&acc)[2][2][4][2], int mt, int dt, float* Cs, const float4 (&xa)[4], const float4 (&xb)[4]) {
  const int t = tid512();
  const int row0 = mt * 256 + AI * 128, col0 = dt * 256 + BJ * 128, c = (t & 15) * 8;
  const float alpha = 1.681792830507429f;
  stage_q<AI, BJ>(acc, Cs);
#pragma unroll
  for (int q = 0; q < 4; ++q) {
    int r = (t >> 4) + 32 * q;
    float v[8]; ld8(Cs + r * CST + c, v);
    float4 a = xa[q], b = xb[q];
    float y[8] = {alpha * a.x + v[0], alpha * a.y + v[1], alpha * a.z + v[2], alpha * a.w + v[3],
                  alpha * b.x + v[4], alpha * b.y + v[5], alpha * b.z + v[6], alpha * b.w + v[7]};
    *(u32x4*)((u16*)p.fbuf + (size_t)(row0 + r) * 1024 + col0 + c) = pack8(y);
  }
}
DI void f1_phase(PREF p, int l, unsigned char* lds_all) {
  u16* shm = (u16*)lds_all; float* Cs = (float*)lds_all;
  for (int k = 0;; ++k) {
    int mt, dt;
    if (!xcd_tile256(k, 4, mt, dt)) break;
    f32x4 acc[2][2][4][2]; zero_acc256(acc);
    gemm256<1024, 1024, 1024>(acc, p.mg + (size_t)mt * 256 * 1024, p.wts + (size_t)l * WL + O_OUT + (size_t)dt * 256 * 1024, shm, p);
    {
      float4 aA[4], bA[4];
      f1_load<0, 0>(p, l, mt, dt, aA, bA); f1_proc<0, 0>(p, acc, mt, dt, Cs, aA, bA);
      f1_load<0, 1>(p, l, mt, dt, aA, bA); f1_proc<0, 1>(p, acc, mt, dt, Cs, aA, bA);
      f1_load<1, 0>(p, l, mt, dt, aA, bA); f1_proc<1, 0>(p, acc, mt, dt, Cs, aA, bA);
      f1_load<1, 1>(p, l, mt, dt, aA, bA); f1_proc<1, 1>(p, acc, mt, dt, Cs, aA, bA);
    }
  }
  __syncthreads();
}

template <int AI, int BJ>
DI void f3_load(PREF p, int mt, int dt, u32x4 (&g)[4]) {
  const int t = tid512();
  const int row0 = mt * 256 + AI * 128, col0 = dt * 256 + BJ * 128, c = (t & 15) * 8;
#pragma unroll
  for (int q = 0; q < 4; ++q) g[q] = *(const u32x4*)((const u16*)p.fbuf + (size_t)(row0 + (t >> 4) + 32 * q) * 1024 + col0 + c);
}
template <int AI, int BJ, int PASS>
DI void f3_proc(PREF p, const f32x4 (&acc)[2][2][4][2], int mt, int dt, float* Cs, const u32x4 (&g)[4]) {
  const int t = tid512();
  const int row0 = mt * 256 + AI * 128, col0 = dt * 256 + BJ * 128;
  const int c = (t & 15) * 8;
  stage_q<AI, BJ>(acc, Cs);
#pragma unroll
  for (int q = 0; q < 4; ++q) {
    int r = (t >> 4) + 32 * q;
    float v[8]; ld8(Cs + r * CST + c, v);
    if (PASS == 0) {
#pragma unroll
      for (int j = 0; j < 8; ++j) v[j] = sigm(v[j]);
    } else {
      float gf[8]; unpack8(g[q], gf);
#pragma unroll
      for (int j = 0; j < 8; ++j) v[j] *= gf[j];
    }
    *(u32x4*)((u16*)p.fbuf + (size_t)(row0 + r) * 1024 + col0 + c) = pack8(v);
  }
}
DI void f3_phase(PREF p, int l, unsigned char* lds_all) {
  u16* shm = (u16*)lds_all; float* Cs = (float*)lds_all;
  const u16* W = p.wts + (size_t)l * WL;
  for (int k = 0;; ++k) {
    int mt, dt;
    if (!xcd_tile256(k, 4, mt, dt)) break;
    {
      f32x4 acc[2][2][4][2]; zero_acc256(acc);
      gemm256<1024, 1024, 1024>(acc, p.X + (size_t)mt * 256 * 1024, W + O_PLEG + (size_t)dt * 256 * 1024, shm, p);
      u32x4 gd[4];
      f3_proc<0, 0, 0>(p, acc, mt, dt, Cs, gd); f3_proc<0, 1, 0>(p, acc, mt, dt, Cs, gd);
      f3_proc<1, 0, 0>(p, acc, mt, dt, Cs, gd); f3_proc<1, 1, 0>(p, acc, mt, dt, Cs, gd);
    }
    f32x4 acc[2][2][4][2]; zero_acc256(acc);
    gemm256<256, 256, 256>(acc, p.pb + (size_t)mt * 256 * 256, W + O_PLE + (size_t)dt * 256 * 256, shm, p);
    {
      u32x4 gA[4], gB[4];
      f3_load<0, 0>(p, mt, dt, gA);
      f3_load<0, 1>(p, mt, dt, gB); f3_proc<0, 0, 1>(p, acc, mt, dt, Cs, gA);
      f3_load<1, 0>(p, mt, dt, gA); f3_proc<0, 1, 1>(p, acc, mt, dt, Cs, gB);
      f3_load<1, 1>(p, mt, dt, gB); f3_proc<1, 0, 1>(p, acc, mt, dt, Cs, gA);
      f3_proc<1, 1, 1>(p, acc, mt, dt, Cs, gB);
    }
  }
  __syncthreads();
}

DI void rows_ln(PREF p, int l) {
  const int tid = tidx(), lane = tid & 63, w = tid >> 6;
  float gg[16], bb[16];
#pragma unroll
  for (int h = 0; h < 2; ++h) {
    const int c = h * 512 + lane * 8;
    const float4 g0 = *(const float4*)(p.ln_g + l * 1024 + c), g1 = *(const float4*)(p.ln_g + l * 1024 + c + 4);
    const float4 b0 = *(const float4*)(p.ln_b + l * 1024 + c), b1 = *(const float4*)(p.ln_b + l * 1024 + c + 4);
    gg[h * 8 + 0] = g0.x; gg[h * 8 + 1] = g0.y; gg[h * 8 + 2] = g0.z; gg[h * 8 + 3] = g0.w;
    gg[h * 8 + 4] = g1.x; gg[h * 8 + 5] = g1.y; gg[h * 8 + 6] = g1.z; gg[h * 8 + 7] = g1.w;
    bb[h * 8 + 0] = b0.x; bb[h * 8 + 1] = b0.y; bb[h * 8 + 2] = b0.z; bb[h * 8 + 3] = b0.w;
    bb[h * 8 + 4] = b1.x; bb[h * 8 + 5] = b1.y; bb[h * 8 + 6] = b1.z; bb[h * 8 + 7] = b1.w;
  }
  for (int row = vbid() * 4 + w; row < T_ / 2; row += vgrid() * 4) {
    u32x4 raw[2][2];
#pragma unroll
    for (int k = 0; k < 2; ++k) {
      const u16* src = (const u16*)p.fbuf + (size_t)(row + k * (T_ / 2)) * 1024;
      raw[k][0] = *(const u32x4*)(src + lane * 8);
      raw[k][1] = *(const u32x4*)(src + 512 + lane * 8);
    }
#pragma unroll
    for (int k = 0; k < 2; ++k) {
      float v[16];
      unpack8(raw[k][0], v); unpack8(raw[k][1], v + 8);
      float s = 0.f;
#pragma unroll
      for (int i = 0; i < 16; ++i) s += v[i];
      const float mu = wsum(s) * (1.f / 1024.f);
      float sq = 0.f;
#pragma unroll
      for (int i = 0; i < 16; ++i) { v[i] -= mu; sq += v[i] * v[i]; }
      const float rs = rsqrtf(wsum(sq) * (1.f / 1024.f) + 1e-5f);
#pragma unroll
      for (int h = 0; h < 2; ++h) {
        float y[8];
#pragma unroll
        for (int j = 0; j < 8; ++j) y[j] = v[h * 8 + j] * rs * gg[h * 8 + j] + bb[h * 8 + j];
        *(u32x4*)(p.X + (size_t)(row + k * (T_ / 2)) * 1024 + h * 512 + lane * 8) = pack8(y);
      }
    }
  }
}

DI void rows_ple(PREF p, int l) {
  const int tid = tidx(), lane = tid & 63, w = tid >> 6;
  for (int row = vbid() * 4 + w; row < T_; row += vgrid() * 4) {
    const u16* src = (const u16*)p.fbuf + (size_t)row * 1024;
    float v[16];
    unpack8(*(const u32x4*)(src + lane * 8), v);
    unpack8(*(const u32x4*)(src + 512 + lane * 8), v + 8);
    float xv[16];
    unpack8(*(const u32x4*)(p.X + (size_t)row * 1024 + lane * 8), xv);
    unpack8(*(const u32x4*)(p.X + (size_t)row * 1024 + 512 + lane * 8), xv + 8);
    float sq = 0.f;
#pragma unroll
    for (int i = 0; i < 16; ++i) sq += v[i] * v[i];
    const float rs = rsqrtf(wsum(sq) * (1.f / 1024.f) + 1e-6f);
#pragma unroll
    for (int h = 0; h < 2; ++h) {
      const int c = h * 512 + lane * 8;
      const float4 g0 = *(const float4*)(p.ple_ng + l * 1024 + c), g1 = *(const float4*)(p.ple_ng + l * 1024 + c + 4);
      float y[8];
      y[0] = xv[h * 8 + 0] + v[h * 8 + 0] * rs * g0.x; y[1] = xv[h * 8 + 1] + v[h * 8 + 1] * rs * g0.y;
      y[2] = xv[h * 8 + 2] + v[h * 8 + 2] * rs * g0.z; y[3] = xv[h * 8 + 3] + v[h * 8 + 3] * rs * g0.w;
      y[4] = xv[h * 8 + 4] + v[h * 8 + 4] * rs * g1.x; y[5] = xv[h * 8 + 5] + v[h * 8 + 5] * rs * g1.y;
      y[6] = xv[h * 8 + 6] + v[h * 8 + 6] * rs * g1.z; y[7] = xv[h * 8 + 7] + v[h * 8 + 7] * rs * g1.w;
      if (l == NL - 1) {
        float4* od = (float4*)(p.out + (size_t)row * 1024 + c);
        od[0] = make_float4(y[0], y[1], y[2], y[3]); od[1] = make_float4(y[4], y[5], y[6], y[7]);
      } else {
        *(u32x4*)(p.X + (size_t)row * 1024 + c) = pack8(y);
      }
    }
  }
}

DI void phase_mix1(PREF p, int l, unsigned char* ldsb) {
  for (int it = vbid(); it < 1024; it += vgrid()) {
    int pi = it >> 1, b = pi >> 6, hq = ((pi >> 5) & 1) * 2 + (it & 1), qb = pi & 31;
    const u16* hbb = p.hb + (size_t)b * S_ * HW;
    attn_item<64, true>(hbb + OFF_SQ + hq * 64, HW, hbb + OFF_SK + (hq >> 1) * 64, HW,
                        p.Vst + (size_t)(b * 2 + (hq >> 1)) * 64 * S_, qb, 0.125f * LOG2E, p.sinks[l * 4 + hq] * 8.0f,
                        hbb + OFF_DZ + hq * 64, HW, p.ys + (size_t)b * S_ * 1024 + 768 + hq * 64, 1024, (u16*)ldsb);
  }
  for (int it = vbid(); it < 1024; it += vgrid()) kv_tile(p, l, it, ldsb);
  for (int it = vbid(); it < 768; it += vgrid()) q_tile(p, l, it, ldsb);
  for (int it = vbid(); it < 1024; it += vgrid()) conv_item(p, l, it, ldsb);
  for (int it = vbid(); it < 2048; it += vgrid()) ssm1_item(p, l, it, ldsb);
}
DI void phase_mix2(PREF p, int l, unsigned char* ldsb) {
  for (int it = vbid(); it < 1024; it += vgrid()) {
    int qb = (it < 512) ? 31 - (it >> 5) : ((it - 512) >> 5);
    int bh = it & 31, b = bh >> 2, head = bh & 3;
    attn_item<96, false>(p.Qm + (size_t)b * S_ * 384 + head * 96, 384, p.Km + (size_t)b * S_ * 384 + head * 96, 384,
                         p.Vmt + (size_t)(b * 4 + head) * 64 * S_, qb, 0.10206207261596577f * LOG2E, 0.f,
                         p.hb + (size_t)b * S_ * HW + OFF_BZ + head * 64, HW, p.ys + (size_t)b * S_ * 1024 + 256 + head * 64, 1024,
                         (u16*)ldsb);
  }
  for (int it = vbid(); it < 512; it += vgrid()) pw2_tile(p, l, it, ldsb);
  for (int it = vbid(); it < 2048; it += vgrid()) ssm2_item(p, l, it, ldsb);
}

DI void grid_barrier(unsigned* bar, unsigned gen) {
  asm volatile("s_waitcnt vmcnt(0)" ::: "memory");
  __syncthreads();
  if (threadIdx.x == 0) {
    __builtin_amdgcn_fence(__ATOMIC_RELEASE, "agent");
    const unsigned grp = blockIdx.x & 15u;
    const unsigned nblk = (gridDim.x + 15u - grp) >> 4;
    unsigned old = __hip_atomic_fetch_add(bar + 64 * (1 + grp), 1u, __ATOMIC_RELAXED, __HIP_MEMORY_SCOPE_AGENT);
    if (old + 1u == nblk * gen) {
      unsigned g = __hip_atomic_fetch_add(bar, 1u, __ATOMIC_RELAXED, __HIP_MEMORY_SCOPE_AGENT);
      if (g + 1u == 16u * gen) {
        for (int i = 0; i < 16; ++i) __hip_atomic_store(bar + 64 * (17 + i), gen, __ATOMIC_RELAXED, __HIP_MEMORY_SCOPE_AGENT);
      }
    }
    while (__hip_atomic_load(bar + 64 * (17 + grp), __ATOMIC_RELAXED, __HIP_MEMORY_SCOPE_AGENT) < gen) __builtin_amdgcn_s_sleep(4);
    __builtin_amdgcn_fence(__ATOMIC_ACQUIRE, "agent");
  }
  __syncthreads();
}

template <int J>
DI void run_phase(PREF p, int l, unsigned char* ldsb, unsigned char* lds_all) {
  if (J == 0) phase_in(p, l, lds_all);
  else if (J == 1) phase_mix1(p, l, ldsb);
  else if (J == 2) phase_mix2(p, l, ldsb);
  else if (J == 3) glu_phase(p, l, lds_all);
  else if (J == 4) merge_phase(p, l, lds_all);
  else if (J == 5) f1_phase(p, l, lds_all);
  else if (J == 6) rows_ln(p, l);
  else if (J == 7) f3_phase(p, l, lds_all);
  else if (J == 8) rows_ple(p, l);
  else phase_prep(p, ldsb);
}

#if MULTI_LAUNCH
template <int J>
__global__ void __launch_bounds__(256, 2) phk(Params p, int l) {
  __shared__ __attribute__((aligned(16))) unsigned char ldsb[LDS_BYTES];
  run_phase<J>(p, l, ldsb);
}
#else
__global__ void __launch_bounds__(512, 2) mega(Params p_unused, int ph0, int ph1) {
  __shared__ __attribute__((aligned(16))) unsigned char lds_all[LDS_BYTES];
  unsigned char* ldsb = lds_all + half_() * LDS_HALF;
  cg::grid_group grid = cg::this_grid();
  for (int ph = ph0; ph < ph1; ++ph) {
    const __attribute__((address_space(4))) Params* pp = (const __attribute__((address_space(4))) Params*)__builtin_amdgcn_kernarg_segment_ptr();
    asm volatile("" : "+s"(pp));
    PREF p = *pp;
    if (ph1 < 0) grid.sync();
    if (ph > ph0) grid_barrier(p.bar, (unsigned)(ph - ph0));
    if (ph == 0) { run_phase<9>(p, 0, ldsb, lds_all); continue; }
    int l = (ph - 1) / NPH_LAYER; const int j = (ph - 1) % NPH_LAYER;
    asm volatile("" : "+s"(l));
    if (j == 0) run_phase<0>(p, l, ldsb, lds_all);
    else if (j == 1) run_phase<1>(p, l, ldsb, lds_all);
    else if (j == 2) run_phase<2>(p, l, ldsb, lds_all);
    else if (j == 3) run_phase<3>(p, l, ldsb, lds_all);
    else if (j == 4) run_phase<4>(p, l, ldsb, lds_all);
    else if (j == 5) run_phase<5>(p, l, ldsb, lds_all);
    else if (j == 6) run_phase<6>(p, l, ldsb, lds_all);
    else if (j == 7) run_phase<7>(p, l, ldsb, lds_all);
    else run_phase<8>(p, l, ldsb, lds_all);
  }
}
#endif

extern "C" void kernel_launch(void* const* d_in, const int* in_sizes, int n_in, void* d_out, int out_size, void* d_ws,
                              size_t ws_size, hipStream_t stream) {
  static int grid_blocks = 0;
  if (!grid_blocks) {
    int dev = 0, cus = 0, per_cu = 2;
    (void)hipGetDevice(&dev);
    (void)hipDeviceGetAttribute(&cus, hipDeviceAttributeMultiprocessorCount, dev);
#if !MULTI_LAUNCH
    (void)hipOccupancyMaxActiveBlocksPerMultiprocessor(&per_cu, mega, 512, 0);
    per_cu = 1;
#endif
    if (cus < 1) cus = 256;
    grid_blocks = cus * per_cu;
  }
  Params p{};
  const float** f = (const float**)&p;
  for (int i = 0; i < 31; ++i) f[i] = (const float*)d_in[i];
  p.out = (float*)d_out;
  unsigned char* ws = (unsigned char*)d_ws;
  size_t off = 0;
  auto take = [&](size_t bytes) { unsigned char* r = ws + off; off += (bytes + 255) & ~(size_t)255; return r; };
  p.wts = (u16*)take(WL * NL * 2);
  p.lam = (float*)take((size_t)NL * 16 * 64 * 2 * 4);
  p.bbre = (float*)take((size_t)NL * 16 * 64 * 16 * 4);
  p.bbim = (float*)take((size_t)NL * 16 * 64 * 16 * 4);
  p.rcos = (float*)take((size_t)S_ * 16 * 4);
  p.rsin = (float*)take((size_t)S_ * 16 * 4);
  p.X = (u16*)take((size_t)T_ * 1024 * 2);
  p.pb = (u16*)take((size_t)T_ * 256 * 2);
  p.hb = (u16*)take((size_t)T_ * HW * 2);
  p.ys = (u16*)take((size_t)T_ * 1024 * 2);
  p.cA = (u16*)take((size_t)T_ * 256 * 2);
  p.Qm = (u16*)take((size_t)T_ * 384 * 2);
  p.Km = (u16*)take((size_t)T_ * 384 * 2);
  p.Vmt = (u16*)take((size_t)T_ * 256 * 2);
  p.Vst = (u16*)take((size_t)T_ * 128 * 2);
  p.yss = (u16*)take((size_t)T_ * 256 * 2);
  p.hend = (float*)take((size_t)8 * 16 * 64 * 64 * 2 * 4);
  p.bar = (unsigned*)take(16384);
  p.mg = p.cA;
  p.fbuf = (float*)p.hb;
  if (off > ws_size) fprintf(stderr, "workspace too small: need %zu have %zu\n", off, ws_size);
  const int NPH = 1 + NPH_LAYER * NL;
#if MULTI_LAUNCH
  (void)NPH;
  const dim3 g(grid_blocks), b(256);
  hipLaunchKernelGGL(phk<9>, g, b, 0, stream, p, 0);
  for (int l = 0; l < NL; ++l) {
    hipLaunchKernelGGL(phk<0>, g, b, 0, stream, p, l);
    hipLaunchKernelGGL(phk<1>, g, b, 0, stream, p, l);
    hipLaunchKernelGGL(phk<2>, g, b, 0, stream, p, l);
    hipLaunchKernelGGL(phk<3>, g, b, 0, stream, p, l);
    hipLaunchKernelGGL(phk<4>, g, b, 0, stream, p, l);
    hipLaunchKernelGGL(phk<5>, g, b, 0, stream, p, l);
    hipLaunchKernelGGL(phk<6>, g, b, 0, stream, p, l);
    hipLaunchKernelGGL(phk<7>, g, b, 0, stream, p, l);
    hipLaunchKernelGGL(phk<8>, g, b, 0, stream, p, l);
  }
#else
  int ph0 = 0, ph1 = NPH;
  (void)hipMemsetAsync(p.bar, 0, 16384, stream);
  void* args[] = {&p, &ph0, &ph1};
  hipError_t e = hipLaunchCooperativeKernel((void*)mega, dim3(grid_blocks), dim3(512), args, 0, stream);
  if (e != hipSuccess) fprintf(stderr, "cooperative launch failed: %s (grid %d)\n", hipGetErrorString(e), grid_blocks);
#endif
}
```
